# Optimizing an MI355X kernel written in HIP

```python
import jax, jax.numpy as jnp
from jax import lax
import numpy as np

D_MODEL = 1024
BATCH = 32
SEQ = 2048
DEPTH = 1
DEC_BATCH = 32
DEC_SEQ = 64
PAST_LEN = 4096

CHUNK = 64
MIX_DIM = D_MODEL
POOL_DIM = MIX_DIM // 4
POOL_WINDOWS = (2, 4, 8, 16)
POOL_GROUPS = len(POOL_WINDOWS)
POOL_GC = POOL_DIM // POOL_GROUPS
POOL_HIST = max(POOL_WINDOWS) - 1
ATTN_DIM = MIX_DIM - POOL_DIM
HEAD_DIM = 64
N_HEADS = ATTN_DIM // HEAD_DIM
GQA = 4
N_KV = N_HEADS // GQA
KV_DIM = N_KV * HEAD_DIM
IN_DIM = POOL_DIM + ATTN_DIM + 2 * KV_DIM
WINDOW = 128
N_BAND = WINDOW // CHUNK + 1
ALIBI_MAX = 8.0
D_FF = -(-8 * D_MODEL // (3 * 256)) * 256
EPS = 1e-6
NEG = -1e30

kernel_name = 'hybrid_pool_swa_stream_step'


def rms_norm(x, g):
    xf = x.astype(jnp.float32)
    y = xf * lax.rsqrt(jnp.mean(xf * xf, axis=-1, keepdims=True) + EPS)
    return (y * g.astype(jnp.float32)).astype(x.dtype)


def alibi_slopes():
    h = jnp.arange(N_HEADS, dtype=jnp.float32) + 1.0
    return (2.0 ** (-ALIBI_MAX * h / N_HEADS)).reshape(N_KV, GQA)


def mixer_inputs(x, norm_g, w_in, q_norm, k_norm):
    B, L, _ = x.shape
    z = rms_norm(x, norm_g) @ w_in
    u = z[..., :POOL_DIM]
    q = z[..., POOL_DIM:POOL_DIM + ATTN_DIM].reshape(B, L, N_KV, GQA, HEAD_DIM)
    k = z[..., POOL_DIM + ATTN_DIM:POOL_DIM + ATTN_DIM + KV_DIM].reshape(B, L, N_KV, HEAD_DIM)
    v = z[..., POOL_DIM + ATTN_DIM + KV_DIM:].reshape(B, L, N_KV, HEAD_DIM)
    return u, rms_norm(q, q_norm), rms_norm(k, k_norm), v


def pool_mix(u, prev, pos0, w_pool, pool_scale):
    B, L, C = u.shape
    ext = jnp.concatenate([prev.astype(u.dtype), u], axis=1)
    pos_ext = pos0 - POOL_HIST + jnp.arange(L + POOL_HIST)
    ext_f = ext.astype(jnp.float32) * (pos_ext >= 0).astype(jnp.float32)[None, :, None]
    cs = jnp.concatenate([jnp.zeros((B, 1, C), jnp.float32), jnp.cumsum(ext_f, axis=1)], axis=1)
    pos = pos0 + jnp.arange(L)
    base = POOL_HIST + 1
    parts = []
    for g, w in enumerate(POOL_WINDOWS):
        sl = slice(g * POOL_GC, (g + 1) * POOL_GC)
        win = cs[:, base:base + L, sl] - cs[:, base - w:base - w + L, sl]
        cnt = jnp.minimum(pos + 1, w).astype(jnp.float32)
        parts.append(win / cnt[None, :, None])
    d = (jnp.concatenate(parts, axis=-1) - u.astype(jnp.float32)).reshape(B, L, POOL_GROUPS, POOL_GC)
    out = jnp.einsum('blgc,gce->blge', d, w_pool.astype(jnp.float32)).reshape(B, L, C)
    out = out * pool_scale.astype(jnp.float32)
    return out.astype(u.dtype), ext[:, -POOL_HIST:]


def band_attention(q, k, v, q_pos, k_pos, sinks):
    s = jnp.einsum('bnqkgd,bnskd->bnkgqs', q.astype(jnp.float32), k.astype(jnp.float32)) * (HEAD_DIM ** -0.5)
    dist = jnp.abs(q_pos[:, :, None] - k_pos[:, None, :]).astype(jnp.float32)
    s = s - alibi_slopes()[None, None, :, :, None, None] * dist[None, :, None, None]
    q_start = (q_pos // CHUNK) * CHUNK
    kp = k_pos[:, None, :]
    valid = (kp >= 0) & (kp >= q_start[:, :, None] - WINDOW) & (kp < q_start[:, :, None] + CHUNK)
    s = jnp.where(valid[None, :, None, None], s, NEG)
    sink = sinks.astype(jnp.float32).reshape(N_KV, GQA)[None, None, :, :, None, None]
    m = jnp.maximum(jnp.max(s, axis=-1, keepdims=True), sink)
    p = jnp.exp(s - m)
    denom = jnp.sum(p, axis=-1, keepdims=True) + jnp.exp(sink - m)
    o = jnp.einsum('bnkgqs,bnskd->bnqkgd', p / denom, v.astype(jnp.float32))
    return o.astype(q.dtype)


def attn_prompt(q, k, v, sinks):
    B, L = q.shape[:2]
    nc = L // CHUNK
    qb = q.reshape(B, nc, CHUNK, N_KV, GQA, HEAD_DIM)
    pad = jnp.zeros((B, WINDOW, N_KV, HEAD_DIM), k.dtype)
    kc = jnp.concatenate([pad, k], axis=1).reshape(B, nc + N_BAND - 1, CHUNK, N_KV, HEAD_DIM)
    vc = jnp.concatenate([pad.astype(v.dtype), v], axis=1).reshape(B, nc + N_BAND - 1, CHUNK, N_KV, HEAD_DIM)
    kb = jnp.concatenate([kc[:, i:i + nc] for i in range(N_BAND)], axis=2)
    vb = jnp.concatenate([vc[:, i:i + nc] for i in range(N_BAND)], axis=2)
    starts = jnp.arange(nc)[:, None] * CHUNK
    q_pos = starts + jnp.arange(CHUNK)[None, :]
    k_pos = starts - WINDOW + jnp.arange(N_BAND * CHUNK)[None, :]
    o = band_attention(qb, kb, vb, q_pos, k_pos, sinks).reshape(B, L, ATTN_DIM)
    return o, k[:, -WINDOW:], v[:, -WINDOW:]


def attn_sample(q, k, v, cache_k, cache_v, sinks):
    B, L = q.shape[:2]
    kall = jnp.concatenate([cache_k.astype(k.dtype), k], axis=1)
    vall = jnp.concatenate([cache_v.astype(v.dtype), v], axis=1)
    q_pos = PAST_LEN + jnp.arange(L)
    k_pos = jnp.concatenate([PAST_LEN - WINDOW + jnp.arange(WINDOW), q_pos])
    o = band_attention(q[:, None], kall[:, None], vall[:, None], q_pos[None], k_pos[None], sinks)
    return o.reshape(B, L, ATTN_DIM), kall[:, -WINDOW:], vall[:, -WINDOW:]


def block_out(x, pool_o, attn_o, w_out, norm_ffn, w_gate, w_up, w_down):
    h = x + jnp.concatenate([pool_o, attn_o], axis=-1) @ w_out
    hn = rms_norm(h, norm_ffn)
    return h + (jax.nn.silu(hn @ w_gate) * (hn @ w_up)) @ w_down


def setup_inputs(seed: int = 0) -> dict:
    key = jax.random.key(seed)
    ks = jax.random.split(key, 20)
    n = jax.random.normal
    f = jnp.float32
    return {
        'x_prompt': n(ks[0], (BATCH, SEQ, D_MODEL), f),
        'x_sample': n(ks[1], (DEC_BATCH, DEC_SEQ, D_MODEL), f),
        'cache_pool': n(ks[2], (DEPTH, DEC_BATCH, POOL_HIST, POOL_DIM), f),
        'cache_k': n(ks[3], (DEPTH, DEC_BATCH, WINDOW, N_KV, HEAD_DIM), f),
        'cache_v': n(ks[4], (DEPTH, DEC_BATCH, WINDOW, N_KV, HEAD_DIM), f),
        'norm_mix': 1.0 + 0.05 * n(ks[5], (DEPTH, D_MODEL), f),
        'w_in': n(ks[6], (DEPTH, D_MODEL, IN_DIM), f) * D_MODEL ** -0.5,
        'w_pool': n(ks[7], (DEPTH, POOL_GROUPS, POOL_GC, POOL_GC), f) * POOL_GC ** -0.5,
        'pool_scale': 1.0 + 0.05 * n(ks[8], (DEPTH, POOL_DIM), f),
        'q_norm': 1.0 + 0.05 * n(ks[9], (DEPTH, HEAD_DIM), f),
        'k_norm': 1.0 + 0.05 * n(ks[10], (DEPTH, HEAD_DIM), f),
        'sinks': 0.5 * n(ks[11], (DEPTH, N_HEADS), f),
        'w_out': n(ks[12], (DEPTH, MIX_DIM, D_MODEL), f) * MIX_DIM ** -0.5,
        'norm_ffn': 1.0 + 0.05 * n(ks[13], (DEPTH, D_MODEL), f),
        'w_gate': n(ks[14], (DEPTH, D_MODEL, D_FF), f) * D_MODEL ** -0.5,
        'w_up': n(ks[15], (DEPTH, D_MODEL, D_FF), f) * D_MODEL ** -0.5,
        'w_down': n(ks[16], (DEPTH, D_FF, D_MODEL), f) * D_FF ** -0.5,
    }


def reference(x_prompt, x_sample, cache_pool, cache_k, cache_v, norm_mix, w_in, w_pool, pool_scale,
              q_norm, k_norm, sinks, w_out, norm_ffn, w_gate, w_up, w_down):
    hp, hs = x_prompt, x_sample
    pp_l, kp_l, vp_l, ps_l, ks_l, vs_l = [], [], [], [], [], []
    for l in range(DEPTH):
        u, q, k, v = mixer_inputs(hp, norm_mix[l], w_in[l], q_norm[l], k_norm[l])
        prev0 = jnp.zeros((hp.shape[0], POOL_HIST, POOL_DIM), u.dtype)
        pool_o, pool_st = pool_mix(u, prev0, 0, w_pool[l], pool_scale[l])
        attn_o, k_st, v_st = attn_prompt(q, k, v, sinks[l])
        hp = block_out(hp, pool_o, attn_o, w_out[l], norm_ffn[l], w_gate[l], w_up[l], w_down[l])
        pp_l.append(pool_st); kp_l.append(k_st); vp_l.append(v_st)
        u, q, k, v = mixer_inputs(hs, norm_mix[l], w_in[l], q_norm[l], k_norm[l])
        pool_o, pool_st = pool_mix(u, cache_pool[l], PAST_LEN, w_pool[l], pool_scale[l])
        attn_o, k_st, v_st = attn_sample(q, k, v, cache_k[l], cache_v[l], sinks[l])
        hs = block_out(hs, pool_o, attn_o, w_out[l], norm_ffn[l], w_gate[l], w_up[l], w_down[l])
        ps_l.append(pool_st); ks_l.append(k_st); vs_l.append(v_st)
    return (hp, hs, jnp.stack(pp_l), jnp.stack(kp_l), jnp.stack(vp_l),
            jnp.stack(ps_l), jnp.stack(ks_l), jnp.stack(vs_l))
```

```cpp
#include <hip/hip_runtime.h>
#include <cstdio>
#include <cstdint>
namespace pg8 {
#define PG8_LAS __attribute__((address_space(3)))
typedef unsigned short bf16_t;
typedef short bf16x8 __attribute__((ext_vector_type(8)));
typedef float f32x4 __attribute__((ext_vector_type(4)));
typedef unsigned u32x4 __attribute__((ext_vector_type(4)));
constexpr int BM = 256, BK = 64, HALF = 128, HTB = HALF * BK * 2  , STAGE_BYTES = 8 * HTB, NXCD = 8, WGM = 8;

__host__ __device__ __forceinline__ int lds_byte(int r, int c) { const int st = (r >> 4) * 2 + (c >> 5), rr = r & 15, cc = c & 31, ob = rr * 64 + cc * 2; return st * 1024 + (ob ^ (((ob >> 9) & 1) << 5)); }
__host__ __device__ __forceinline__ void stage_rc(int b, int& R, int& C) { const int st = b / 1024, sb = b % 1024, swz = sb ^ (((sb >> 9) & 1) << 5); R = (st >> 1) * 16 + swz / 64; C = (st & 1) * 32 + (swz % 64) / 2; }
__host__ __device__ __forceinline__ int perm32(int rho) { const int n = rho >> 4, i = rho & 15; return 8 * (i >> 2) + 4 * n + (i & 3); }

struct Unit { int pm, pn; };
struct Gemm { const bf16_t* A; const bf16_t* Bt; int M, N, K; };

struct StaticOrder {
    int nM, nN, nwg, G, c;
    __host__ __device__ void init(int M, int N, int G_, int c_) { nM = M / BM; nN = N / BM; nwg = nM * nN; G = G_; c = c_; }
    __host__ __device__ bool next(int i, Unit& u) const {
        const long L = (long)i * G + c; if (L >= nwg) return false;
        int wgid = (int)L; { const int q = nwg / NXCD, r = nwg % NXCD, xcd = wgid % NXCD, off = wgid / NXCD; wgid = (xcd < r ? xcd * (q + 1) : r * (q + 1) + (xcd - r) * q) + off; }
        const int nig = WGM * nN, gid = wgid / nig, fm = gid * WGM, gsz = (nM - fm) < WGM ? (nM - fm) : WGM;
        u.pm = fm + ((wgid % nig) % gsz); u.pn = (wgid % nig) / gsz; return true;
    }
    __device__ __forceinline__ void a_ready(const Unit&) const {}
    __device__ __forceinline__ void done(const Unit&) const {}
};
__device__ __forceinline__ unsigned cvt_pk_bf16(float lo, float hi) { unsigned r; asm volatile("v_cvt_pk_bf16_f32 %0, %1, %2" : "=v"(r) : "v"(lo), "v"(hi)); return r; }
typedef float f32x2 __attribute__((ext_vector_type(2)));
typedef unsigned u32x2 __attribute__((ext_vector_type(2)));
constexpr float LOG2E = 1.4426950408889634f;
constexpr float C2 = 0.125f * LOG2E;
constexpr float EPS = 1e-6f;
constexpr int DM = 1024, ZP = 1408, FF = 2816;
constexpr int MP = 65536, MS = 2048, MT = MP + MS;
constexpr size_t O_POOL_P = 69206016, O_K_P = 69328896, O_V_P = 70115328, O_POOL_S = 70901760, O_K_S = 71024640, O_V_S = 71811072, O_END = 72597504;

struct EpiZ {
    static constexpr bool PERM = true, AFTER_DRAIN = false;
    bf16_t* Z; const float* qn; const float* kn; float* out;
    __device__ __forceinline__ void operator()(const f32x4 (&acc)[2][2][4][2], const Unit& u, int wr, int wc, int fr, int fq) const {
        const int zcol = u.pn * 256 + wc * 64;
        if (zcol >= ZP) return;
        const int kind = (zcol >= 256 && zcol < 1024) ? 1 : ((zcol >= 1024 && zcol < 1216) ? 2 : 0);
        f32x4 sc[2][2];
#pragma unroll
        for (int bj = 0; bj < 2; ++bj)
#pragma unroll
            for (int n = 0; n < 2; ++n) {
                if (kind == 1) sc[bj][n] = *(const f32x4*)(qn + 32 * bj + 8 * fq + 4 * n) * C2;
                else if (kind == 2) sc[bj][n] = *(const f32x4*)(kn + 32 * bj + 8 * fq + 4 * n);
                else sc[bj][n] = (f32x4){1.f, 1.f, 1.f, 1.f};
            }
        const bool samp = u.pm >= 256;
        const int cm = (!samp && (u.pm & 7) != 7) ? 0 : (zcol < 256 ? 1 : (zcol >= 1216 ? 3 : (zcol >= 1024 ? 2 : 0)));
        const int rowbase = u.pm * BM + wr * 64 + fr;
#pragma unroll
        for (int ai = 0; ai < 2; ++ai)
#pragma unroll
            for (int m = 0; m < 4; ++m) {
                const int row = rowbase + ai * HALF + m * 16;
                float rs = 1.f;
                if (kind) {
                    float ss = 0.f;
#pragma unroll
                    for (int bj = 0; bj < 2; ++bj)
#pragma unroll
                        for (int n = 0; n < 2; ++n) { const f32x4 x = acc[ai][bj][m][n]; ss += (x[0] * x[0] + x[1] * x[1]) + (x[2] * x[2] + x[3] * x[3]); }
                    ss += __shfl_xor(ss, 16); ss += __shfl_xor(ss, 32);
                    rs = 1.0f / sqrtf(ss * (1.0f / 64.0f) + EPS);
                }
                f32x4 v[2][2];
#pragma unroll
                for (int bj = 0; bj < 2; ++bj)
#pragma unroll
                    for (int n = 0; n < 2; ++n) v[bj][n] = acc[ai][bj][m][n] * rs * sc[bj][n];
                bf16_t* zp = Z + (size_t)row * ZP + zcol + 8 * fq;
#pragma unroll
                for (int bj = 0; bj < 2; ++bj) { u32x4 w; w.x = cvt_pk_bf16(v[bj][0][0], v[bj][0][1]); w.y = cvt_pk_bf16(v[bj][0][2], v[bj][0][3]); w.z = cvt_pk_bf16(v[bj][1][0], v[bj][1][1]); w.w = cvt_pk_bf16(v[bj][1][2], v[bj][1][3]);
                    *(u32x4*)(zp + 32 * bj) = w; }
                if (cm) {
                    int b, t, T; if (samp) { const int r2 = row - MP; b = r2 >> 6; t = r2 & 63; T = 64; } else { b = row >> 11; t = row & 2047; T = 2048; }
                    float* dst = nullptr;
                    if (cm == 1) { const int i = t - (T - 15); if (i >= 0) dst = out + (samp ? O_POOL_S : O_POOL_P) + ((size_t)(b * 15 + i) * 256 + zcol); }
                    else { const int i = samp ? 64 + t : t - (T - 128); if (i >= 0) dst = out + (cm == 2 ? (samp ? O_K_S : O_K_P) : (samp ? O_V_S : O_V_P)) + ((size_t)(b * 128 + i) * 192 + (zcol - (cm == 2 ? 1024 : 1216))); }
                    if (dst) {
#pragma unroll
                        for (int bj = 0; bj < 2; ++bj)
#pragma unroll
                            for (int n = 0; n < 2; ++n) *(f32x4*)(dst + 32 * bj + 8 * fq + 4 * n) = v[bj][n];
                    }
                }
            }
    }
};

struct EpiH {
    static constexpr bool PERM = false, AFTER_DRAIN = false;
    const float* xp; const float* xs; float* H; bf16_t* HB; float* SS;
    __device__ __forceinline__ void operator()(const f32x4 (&acc)[2][2][4][2], const Unit& u, int wr, int wc, int fr, int fq) const {
        const float* xsrc = (u.pm < 256) ? xp + (size_t)u.pm * BM * DM : xs + (size_t)(u.pm - 256) * BM * DM;
        const int col0 = u.pn * BM + wc * 32 + 4 * fq;
#pragma unroll
        for (int ai = 0; ai < 2; ++ai)
#pragma unroll
            for (int m = 0; m < 4; ++m) {
                const int rl = ai * HALF + wr * 64 + m * 16 + fr; const size_t grow = (size_t)u.pm * BM + rl;
                float ss = 0.f;
#pragma unroll
                for (int bj = 0; bj < 2; ++bj)
#pragma unroll
                    for (int n = 0; n < 2; ++n) { const int c = col0 + bj * HALF + n * 16;
                        const f32x4 h = *(const f32x4*)(xsrc + (size_t)rl * DM + c) + acc[ai][bj][m][n];
                        *(f32x4*)(H + grow * DM + c) = h; ss += (h[0] * h[0] + h[1] * h[1]) + (h[2] * h[2] + h[3] * h[3]);
                        u32x2 w; w.x = cvt_pk_bf16(h[0], h[1]); w.y = cvt_pk_bf16(h[2], h[3]); *(u32x2*)(HB + grow * DM + c) = w; }
                ss += __shfl_xor(ss, 16); ss += __shfl_xor(ss, 32);
                if (fq == 0) atomicAdd(SS + grow, ss);
            }
    }
};

struct EpiAct {
    static constexpr bool PERM = true, AFTER_DRAIN = false;
    const float* SS; bf16_t* ACT;
    __device__ __forceinline__ void operator()(const f32x4 (&acc)[2][2][4][2], const Unit& u, int wr, int wc, int fr, int fq) const {
        const int col0 = u.pn * HALF + wc * 32 + 8 * fq;
#pragma unroll
        for (int ai = 0; ai < 2; ++ai)
#pragma unroll
            for (int m = 0; m < 4; ++m) {
                const size_t grow = (size_t)u.pm * BM + ai * HALF + wr * 64 + m * 16 + fr;
                const float rs = 1.0f / sqrtf(SS[grow] * (1.0f / DM) + EPS);
                float a[8];
#pragma unroll
                for (int n = 0; n < 2; ++n)
#pragma unroll
                    for (int e = 0; e < 4; ++e) { const float g = acc[ai][0][m][n][e] * rs, uu = acc[ai][1][m][n][e] * rs;
                        a[4 * n + e] = g * uu * __builtin_amdgcn_rcpf(1.0f + __builtin_amdgcn_exp2f(-LOG2E * g)); }
                u32x4 w; w.x = cvt_pk_bf16(a[0], a[1]); w.y = cvt_pk_bf16(a[2], a[3]); w.z = cvt_pk_bf16(a[4], a[5]); w.w = cvt_pk_bf16(a[6], a[7]);
                *(u32x4*)(ACT + grow * FF + col0) = w;
            }
    }
};

struct EpiY {
    static constexpr bool PERM = false, AFTER_DRAIN = false;
    float* Y;
    __device__ __forceinline__ void operator()(const f32x4 (&acc)[2][2][4][2], const Unit& u, int wr, int wc, int fr, int fq) const {
        const int col0 = u.pn * BM + wc * 32 + 4 * fq;
#pragma unroll
        for (int ai = 0; ai < 2; ++ai)
#pragma unroll
            for (int m = 0; m < 4; ++m) {
                float* rowp = Y + ((size_t)u.pm * BM + ai * HALF + wr * 64 + m * 16 + fr) * DM + col0;
#pragma unroll
                for (int bj = 0; bj < 2; ++bj)
#pragma unroll
                    for (int n = 0; n < 2; ++n) { float* p = rowp + bj * HALF + n * 16; *(f32x4*)p = *(const f32x4*)p + acc[ai][bj][m][n]; }
            }
    }
};

template <class Epi, class Sched, bool ALIGN_EPI = false, bool SP2 = false>
__device__ __forceinline__ void gemm_phase(PG8_LAS unsigned char* lds, const Gemm g, const Sched& S, const Epi& E) {
    const int tid = threadIdx.x, wid = __builtin_amdgcn_readfirstlane(tid >> 6), lane = tid & 63, wr = wid >> 2, wc = wid & 3, fr = lane & 15, fq = lane >> 4;
    const int K = g.K, nt = K / BK;
    unsigned voffA[2], voffB[2];
#pragma unroll
    for (int i = 0; i < 2; ++i) { int R, C; stage_rc(tid * 16 + i * 8192, R, C); const int Rb = Epi::PERM ? ((R & ~31) + perm32(R & 31)) : R;
        voffA[i] = (unsigned)(R * K + C) * 2u; voffB[i] = (unsigned)(Rb * K + C) * 2u; }
    const size_t kstep = (size_t)(BK * 2);
    const size_t hstep = (size_t)HALF * K * 2;
    const size_t tstep = 2 * hstep;
    const unsigned ldsw = (unsigned)wid * 1024u;
    const int aoff = lds_byte(wr * 64 + fr, fq * 8), boff = lds_byte(wc * 32 + fr, fq * 8);
#define PG8_SA(b, h) (((b) * 2 + (h)) * HTB)
#define PG8_SB(b, h) ((4 + (b) * 2 + (h)) * HTB)
#define PG8_STAGE(bufoff, gbase, voff) do { _Pragma("unroll") for (int _i = 0; _i < 2; ++_i) \
        __builtin_amdgcn_global_load_lds((const unsigned*)((const char*)(gbase) + (voff)[_i]), (PG8_LAS unsigned*)(lds + (bufoff) + ldsw + _i * 8192), 16, 0, 0); } while (0)
#define PG8_LDA(dst, b, h) do { _Pragma("unroll") for (int m = 0; m < 4; ++m) _Pragma("unroll") for (int k = 0; k < 2; ++k) dst[m][k] = *(const PG8_LAS bf16x8*)(lds + PG8_SA(b, h) + aoff + m * 2048 + k * 1024); } while (0)
#define PG8_LDB(dst, b, h) do { _Pragma("unroll") for (int n = 0; n < 2; ++n) _Pragma("unroll") for (int k = 0; k < 2; ++k) dst[n][k] = *(const PG8_LAS bf16x8*)(lds + PG8_SB(b, h) + boff + n * 2048 + k * 1024); } while (0)
#define PG8_MMA(ai, bj, At, Bt) do { __builtin_amdgcn_s_setprio(1); _Pragma("unroll") for (int m = 0; m < 4; ++m) _Pragma("unroll") for (int n = 0; n < 2; ++n) _Pragma("unroll") for (int k = 0; k < 2; ++k) \
        acc[ai][bj][m][n] = __builtin_amdgcn_mfma_f32_16x16x32_bf16(Bt[n][k], At[m][k], acc[ai][bj][m][n], 0, 0, 0); __builtin_amdgcn_s_setprio(0); } while (0)
#define PG8_WAIT_V(n) asm volatile("s_waitcnt vmcnt(" #n ")" ::: "memory")
#define PG8_WAIT_L(n) asm volatile("s_waitcnt lgkmcnt(" #n ")" ::: "memory")
#define PG8_BAR __builtin_amdgcn_s_barrier()
#define PG8_SCHED __builtin_amdgcn_sched_barrier(0)
    Unit cur, nxt; int ui = 0;
    if (!S.next(0, cur)) return;
    f32x4 acc[2][2][4][2];
#pragma unroll
    for (int a = 0; a < 2; ++a)
#pragma unroll
        for (int b = 0; b < 2; ++b)
#pragma unroll
            for (int m = 0; m < 4; ++m)
#pragma unroll
                for (int n = 0; n < 2; ++n) acc[a][b][m][n] = (f32x4){0.f, 0.f, 0.f, 0.f};
    bf16x8 At[4][2], B0[2][2], B1[2][2];
    const char* cA = (const char*)g.A + (size_t)cur.pm * tstep; const char* cB = (const char*)g.Bt + (size_t)cur.pn * tstep;
    S.a_ready(cur);
    if constexpr (SP2) {
        PG8_STAGE(PG8_SB(0, 0), cB, voffB); PG8_STAGE(PG8_SB(0, 1), cB + hstep, voffB); PG8_STAGE(PG8_SA(0, 0), cA, voffA); PG8_STAGE(PG8_SA(0, 1), cA + hstep, voffA);
        if (wr == 1) PG8_BAR;
        PG8_WAIT_V(2); PG8_BAR;
        PG8_STAGE(PG8_SB(1, 0), cB + kstep, voffB); PG8_STAGE(PG8_SA(1, 0), cA + kstep, voffA); PG8_STAGE(PG8_SB(1, 1), cB + hstep + kstep, voffB);
        PG8_WAIT_V(6); PG8_BAR;
    } else {
        PG8_STAGE(PG8_SB(0, 0), cB, voffB); PG8_STAGE(PG8_SA(0, 0), cA, voffA); PG8_STAGE(PG8_SB(0, 1), cB + hstep, voffB); PG8_STAGE(PG8_SA(0, 1), cA + hstep, voffA);
        if (wr == 1) PG8_BAR;
        PG8_WAIT_V(4); PG8_BAR;
        PG8_STAGE(PG8_SB(1, 0), cB + kstep, voffB); PG8_STAGE(PG8_SA(1, 0), cA + kstep, voffA); PG8_STAGE(PG8_SB(1, 1), cB + hstep + kstep, voffB);
        PG8_WAIT_V(6); PG8_BAR;
    }
    for (;;) {
        const bool has_next = S.next(ui + 1, nxt);
        const char* nA = has_next ? (const char*)g.A + (size_t)nxt.pm * tstep : cA; const char* nB = has_next ? (const char*)g.Bt + (size_t)nxt.pn * tstep : cB;
        for (int t = 0; t < nt; t += 2) {
            const bool last = (t == nt - 2);
            const char* a1 = cA + (size_t)(t + 1) * kstep;
            const char* a2 = last ? nA : cA + (size_t)(t + 2) * kstep; const char* b2 = last ? nB : cB + (size_t)(t + 2) * kstep;
            const char* a3 = a2 + kstep; const char* b3 = b2 + kstep;
            if (last && has_next) S.a_ready(nxt);
            if constexpr (SP2) {
            PG8_LDB(B0, 0, 0); PG8_LDB(B1, 0, 1); PG8_SCHED; PG8_LDA(At, 0, 0); PG8_STAGE(PG8_SA(1, 1), a1 + hstep, voffA);
            PG8_WAIT_V(8); PG8_WAIT_L(0); PG8_BAR; PG8_MMA(0, 0, At, B0); PG8_MMA(0, 1, At, B1); PG8_BAR; PG8_SCHED;
            PG8_LDA(At, 0, 1); PG8_STAGE(PG8_SB(0, 0), b2, voffB); PG8_STAGE(PG8_SB(0, 1), b2 + hstep, voffB); PG8_STAGE(PG8_SA(0, 0), a2, voffA);
            PG8_WAIT_V(8); PG8_WAIT_L(0); PG8_BAR; PG8_MMA(1, 0, At, B0); PG8_MMA(1, 1, At, B1); PG8_BAR; PG8_SCHED;
            PG8_LDB(B0, 1, 0); PG8_LDB(B1, 1, 1); PG8_SCHED; PG8_LDA(At, 1, 0); PG8_STAGE(PG8_SA(0, 1), a2 + hstep, voffA);
            PG8_WAIT_V(8); PG8_WAIT_L(0); PG8_BAR; PG8_MMA(0, 0, At, B0); PG8_MMA(0, 1, At, B1); PG8_BAR; PG8_SCHED;
            PG8_LDA(At, 1, 1); PG8_STAGE(PG8_SB(1, 0), b3, voffB); PG8_STAGE(PG8_SB(1, 1), b3 + hstep, voffB); PG8_STAGE(PG8_SA(1, 0), a3, voffA);
            PG8_WAIT_V(8); PG8_WAIT_L(0); PG8_BAR; PG8_MMA(1, 0, At, B0); PG8_MMA(1, 1, At, B1); PG8_BAR; PG8_SCHED;
            } else {
            PG8_LDB(B0, 0, 0); PG8_SCHED; PG8_LDA(At, 0, 0); PG8_STAGE(PG8_SA(1, 1), a1 + hstep, voffA);
            PG8_WAIT_L(8); PG8_BAR; PG8_WAIT_L(0); PG8_MMA(0, 0, At, B0); PG8_BAR; PG8_SCHED;
            PG8_LDB(B1, 0, 1); PG8_STAGE(PG8_SB(0, 0), b2, voffB);
            PG8_BAR; PG8_WAIT_L(0); PG8_MMA(0, 1, At, B1); PG8_BAR;
            PG8_LDA(At, 0, 1); PG8_STAGE(PG8_SA(0, 0), a2, voffA);
            PG8_BAR; PG8_WAIT_L(0); PG8_MMA(1, 0, At, B0); PG8_BAR; PG8_SCHED;
            PG8_STAGE(PG8_SB(0, 1), b2 + hstep, voffB);
            PG8_WAIT_V(6); PG8_BAR; PG8_MMA(1, 1, At, B1); PG8_BAR;
            PG8_LDB(B0, 1, 0); PG8_SCHED; PG8_LDA(At, 1, 0); PG8_STAGE(PG8_SA(0, 1), a2 + hstep, voffA);
            PG8_WAIT_L(8); PG8_BAR; PG8_WAIT_L(0); PG8_MMA(0, 0, At, B0); PG8_BAR; PG8_SCHED;
            PG8_LDB(B1, 1, 1); PG8_STAGE(PG8_SB(1, 0), b3, voffB);
            PG8_BAR; PG8_WAIT_L(0); PG8_MMA(0, 1, At, B1); PG8_BAR;
            PG8_LDA(At, 1, 1); PG8_STAGE(PG8_SA(1, 0), a3, voffA);
            PG8_BAR; PG8_WAIT_L(0); PG8_MMA(1, 0, At, B0); PG8_BAR; PG8_SCHED;
            PG8_STAGE(PG8_SB(1, 1), b3 + hstep, voffB);
            PG8_WAIT_V(6); PG8_BAR; PG8_MMA(1, 1, At, B1); PG8_BAR;
            }
        }
        if constexpr (ALIGN_EPI) { if (wr == 0) PG8_BAR; }
        if constexpr (!Epi::AFTER_DRAIN) { E(acc, cur, wr, wc, fr, fq); S.done(cur); }
        if (!has_next) break;
#pragma unroll
        for (int a = 0; a < 2; ++a)
#pragma unroll
            for (int b = 0; b < 2; ++b)
#pragma unroll
                for (int m = 0; m < 4; ++m)
#pragma unroll
                    for (int n = 0; n < 2; ++n) acc[a][b][m][n] = (f32x4){0.f, 0.f, 0.f, 0.f};
        cur = nxt; cA = nA; cB = nB; ++ui;
        if constexpr (ALIGN_EPI) { if (wr == 1) PG8_BAR; }
    }
    PG8_WAIT_V(0);
    if constexpr (!ALIGN_EPI) { if (wr == 0) PG8_BAR; }
    PG8_BAR;
    if constexpr (Epi::AFTER_DRAIN) { E.fused(acc, cur, wr, wc, fr, fq, lds, wid, lane); S.done(cur); }
#undef PG8_SA
#undef PG8_SB
#undef PG8_STAGE
#undef PG8_LDA
#undef PG8_LDB
#undef PG8_MMA
#undef PG8_WAIT_V
#undef PG8_WAIT_L
#undef PG8_BAR
#undef PG8_SCHED
}
}
#ifndef PG8_SP2
#define PG8_SP2 true
#endif
#ifndef PG8_ALIGN
#define PG8_ALIGN true
#endif
namespace mixp {
using pg8::bf16_t; using pg8::bf16x8; using pg8::u32x4; using pg8::u32x2; using pg8::ZP; using pg8::MP; using pg8::LOG2E;
typedef float f32x16 __attribute__((ext_vector_type(16)));
typedef short v4i16_t __attribute__((ext_vector_type(4)));
#define MX_LAS __attribute__((address_space(3)))
typedef MX_LAS unsigned char* lptr;
constexpr int KL_OFF = 0, VL_OFF = 24576, UL_OFF = 49152;
constexpr int N_ATT_P = 32 * 3 * 32, N_ATT = N_ATT_P + 32 * 3, N_POOL_P = 32 * 32, N_UNITS = N_ATT + N_POOL_P + 32;
typedef float f32x2_t __attribute__((ext_vector_type(2))); typedef __bf16 bf16x2_t __attribute__((ext_vector_type(2)));
__device__ __forceinline__ unsigned pk_bf16(float lo, float hi) { f32x2_t v = {lo, hi}; bf16x2_t b = __builtin_convertvector(v, bf16x2_t); return __builtin_bit_cast(unsigned, b); }
__device__ __forceinline__ float bf_lo(unsigned w) { return __uint_as_float(w << 16); }
__device__ __forceinline__ float bf_hi(unsigned w) { return __uint_as_float(w & 0xffff0000u); }
__device__ __forceinline__ v4i16_t vtr(lptr p) { return __builtin_amdgcn_ds_read_tr16_b64_v4i16((MX_LAS v4i16_t*)p); }

__device__ __forceinline__ void attn_unit(lptr lds, const bf16_t* Z, const bf16_t* CK, const bf16_t* CV, bf16_t* MIX, const float* sinks, bool samp, int b, int c, int kvh) {
    const int tid = threadIdx.x, lane = tid & 63, r32 = lane & 31, hi = lane >> 5;
    const int wid = __builtin_amdgcn_readfirstlane(tid >> 6);
    const int g = wid >> 1, qh = wid & 1, hq = 4 * kvh + g;
    const int row0 = samp ? MP + b * 64 : b * 2048 + 64 * c;
#pragma unroll
    for (int j = 0; j < 3; ++j) {
        const int idx = tid + 512 * j, key = idx >> 3, ch = idx & 7, kk = key & 63;
        const bf16_t *ks, *vs;
        if (samp && j < 2) { const size_t o = (size_t)(b * 128 + 64 * j + kk) * 192 + 64 * kvh + 8 * ch; ks = CK + o; vs = CV + o; }
        else { const bool valid = samp || (c - 2 + j >= 0); const int rb = valid ? row0 - 128 + 64 * j : row0; const size_t o = (size_t)(rb + kk) * ZP + 64 * kvh + 8 * ch; ks = Z + o + 1024; vs = Z + o + 1216; }
        const u32x4 kv = *(const u32x4*)ks, vv = *(const u32x4*)vs;
        *(MX_LAS u32x4*)(lds + KL_OFF + key * 128 + ((ch ^ (key & 7)) << 4)) = kv;
        *(MX_LAS u32x4*)(lds + VL_OFF + (ch >> 2) * 12288 + key * 64 + ((ch & 3) << 4)) = vv;
    }
    bf16x8 qr[4];
    const bf16_t* qp = Z + (size_t)(row0 + 32 * qh + r32) * ZP + 256 + 64 * hq + 8 * hi;
#pragma unroll
    for (int ks = 0; ks < 4; ++ks) qr[ks] = *(const bf16x8*)(qp + 16 * ks);
    const float slope2 = __builtin_amdgcn_exp2f(-8.0f * (float)(hq + 1) * (1.0f / 12.0f)) * LOG2E;
    const float sink2 = sinks[hq] * LOG2E;
    __syncthreads();
    const float qb = (float)(32 * qh + r32 + 128 - 4 * hi);
    f32x16 p[6];
#pragma unroll
    for (int kb = 0; kb < 6; ++kb) {
        const bool valid = samp || (c - 2 + (kb >> 1) >= 0);
#pragma unroll
        for (int r = 0; r < 16; ++r) { const float d = qb - (float)(32 * kb + (r & 3) + 8 * (r >> 2)); p[kb][r] = valid ? -slope2 * __builtin_fabsf(d) : -1e30f; }
#pragma unroll
        for (int ks = 0; ks < 4; ++ks) {
            const bf16x8 kf = *(const MX_LAS bf16x8*)(lds + KL_OFF + (32 * kb + r32) * 128 + (((2 * ks + hi) ^ (r32 & 7)) << 4));
            p[kb] = __builtin_amdgcn_mfma_f32_32x32x16_bf16(kf, qr[ks], p[kb], 0, 0, 0);
        }
    }
    float mx = sink2;
#pragma unroll
    for (int kb = 0; kb < 6; ++kb)
#pragma unroll
        for (int r = 0; r < 16; ++r) mx = __builtin_fmaxf(mx, p[kb][r]);
    mx = __builtin_fmaxf(mx, __shfl_xor(mx, 32));
    float sum = 0.f;
#pragma unroll
    for (int kb = 0; kb < 6; ++kb)
#pragma unroll
        for (int r = 0; r < 16; ++r) { p[kb][r] = __builtin_amdgcn_exp2f(p[kb][r] - mx); sum += p[kb][r]; }
    sum += __shfl_xor(sum, 32);
    sum += __builtin_amdgcn_exp2f(sink2 - mx);
    const float inv = 1.0f / sum;
    f32x16 o[2];
#pragma unroll
    for (int r = 0; r < 16; ++r) { o[0][r] = 0.f; o[1][r] = 0.f; }
    const lptr vb = lds + VL_OFF + ((lane >> 4) & 1) * 32 + (lane & 3) * 8 + (4 * hi + ((lane & 15) >> 2)) * 64;
#pragma unroll
    for (int kb = 0; kb < 6; ++kb)
#pragma unroll
        for (int s = 0; s < 2; ++s) {
            u32x4 pw;
            pw.x = pk_bf16(p[kb][8 * s + 0] * inv, p[kb][8 * s + 1] * inv); pw.y = pk_bf16(p[kb][8 * s + 2] * inv, p[kb][8 * s + 3] * inv);
            pw.z = pk_bf16(p[kb][8 * s + 4] * inv, p[kb][8 * s + 5] * inv); pw.w = pk_bf16(p[kb][8 * s + 6] * inv, p[kb][8 * s + 7] * inv);
            const bf16x8 pf = __builtin_bit_cast(bf16x8, pw);
#pragma unroll
            for (int db = 0; db < 2; ++db) {
                const v4i16_t lo = vtr(vb + db * 12288 + (32 * kb + 16 * s) * 64), hh = vtr(vb + db * 12288 + (32 * kb + 16 * s + 8) * 64);
                const bf16x8 vf = (bf16x8){lo[0], lo[1], lo[2], lo[3], hh[0], hh[1], hh[2], hh[3]};
                o[db] = __builtin_amdgcn_mfma_f32_32x32x16_bf16(vf, pf, o[db], 0, 0, 0);
            }
        }
    bf16_t* op = MIX + (size_t)(row0 + 32 * qh + r32) * 1024 + 256 + 64 * hq + 4 * hi;
#pragma unroll
    for (int db = 0; db < 2; ++db)
#pragma unroll
        for (int rg = 0; rg < 4; ++rg) { u32x2 w; w.x = pk_bf16(o[db][4 * rg], o[db][4 * rg + 1]); w.y = pk_bf16(o[db][4 * rg + 2], o[db][4 * rg + 3]); *(u32x2*)(op + 32 * db + 8 * rg) = w; }
    __syncthreads();
}

__device__ __forceinline__ void pool_unit(lptr lds, const bf16_t* Z, const bf16_t* CP, const bf16_t* WPt, bf16_t* MIX, bool samp, int b, int c) {
    const int tid = threadIdx.x, lane = tid & 63, r32 = lane & 31, hi = lane >> 5;
    const int wid = __builtin_amdgcn_readfirstlane(tid >> 6);
    const int row0 = samp ? MP + b * 64 : b * 2048 + 64 * c;
#pragma unroll
    for (int j = 0; j < 5; ++j) {
        const int idx = tid + 512 * j;
        if (idx < 79 * 32) {
            const int ri = idx >> 5, ch = idx & 31; u32x4 v = (u32x4){0u, 0u, 0u, 0u};
            if (ri >= 15 || (!samp && c > 0)) v = *(const u32x4*)(Z + (size_t)(row0 + ri - 15) * ZP + 8 * ch);
            else if (samp) v = *(const u32x4*)(CP + (size_t)(b * 15 + ri) * 256 + 8 * ch);
            *(MX_LAS u32x4*)(lds + UL_OFF + ri * 512 + ((ch ^ (ri & 15)) << 4)) = v;
        }
    }
    __syncthreads();
    const int g = wid >> 1, hh = wid & 1, W = 2 << g, t = 32 * hh + r32;
    const int pos = samp ? 4096 + t : 64 * c + t;
    const float icnt = 1.0f / (float)((pos + 1 < W) ? pos + 1 : W);
    bf16x8 df[4];
#pragma unroll
    for (int ks = 0; ks < 4; ++ks) {
        const int chunk = 8 * g + 2 * ks + hi;
        float a[8]; u32x4 cur = (u32x4){0u, 0u, 0u, 0u};
#pragma unroll
        for (int e = 0; e < 8; ++e) a[e] = 0.f;
        for (int i = 0; i < W; ++i) {
            const int ri = t + 15 - i;
            const u32x4 v = *(const MX_LAS u32x4*)(lds + UL_OFF + ri * 512 + ((chunk ^ (ri & 15)) << 4));
            a[0] += bf_lo(v.x); a[1] += bf_hi(v.x); a[2] += bf_lo(v.y); a[3] += bf_hi(v.y); a[4] += bf_lo(v.z); a[5] += bf_hi(v.z); a[6] += bf_lo(v.w); a[7] += bf_hi(v.w);
            if (i == 0) cur = v;
        }
        u32x4 dw;
        dw.x = pk_bf16(a[0] * icnt - bf_lo(cur.x), a[1] * icnt - bf_hi(cur.x)); dw.y = pk_bf16(a[2] * icnt - bf_lo(cur.y), a[3] * icnt - bf_hi(cur.y));
        dw.z = pk_bf16(a[4] * icnt - bf_lo(cur.z), a[5] * icnt - bf_hi(cur.z)); dw.w = pk_bf16(a[6] * icnt - bf_lo(cur.w), a[7] * icnt - bf_hi(cur.w));
        df[ks] = __builtin_bit_cast(bf16x8, dw);
    }
    bf16_t* op = MIX + (size_t)(row0 + t) * 1024 + 64 * g + 4 * hi;
#pragma unroll
    for (int eb = 0; eb < 2; ++eb) {
        f32x16 o;
#pragma unroll
        for (int r = 0; r < 16; ++r) o[r] = 0.f;
#pragma unroll
        for (int ks = 0; ks < 4; ++ks) {
            const bf16x8 wf = *(const bf16x8*)(WPt + (size_t)((g * 64 + 32 * eb + r32) * 64 + 16 * ks + 8 * hi));
            o = __builtin_amdgcn_mfma_f32_32x32x16_bf16(wf, df[ks], o, 0, 0, 0);
        }
#pragma unroll
        for (int rg = 0; rg < 4; ++rg) { u32x2 w; w.x = pk_bf16(o[4 * rg], o[4 * rg + 1]); w.y = pk_bf16(o[4 * rg + 2], o[4 * rg + 3]); *(u32x2*)(op + 32 * eb + 8 * rg) = w; }
    }
    __syncthreads();
}

__device__ __forceinline__ void mix_phase(lptr lds, const bf16_t* Z, const bf16_t* CK, const bf16_t* CV, const bf16_t* CP, const bf16_t* WPt, bf16_t* MIX, const float* sinks, int first, int stride) {
    for (int ui = first; ui < N_UNITS; ui += stride) {
        if (ui < N_ATT) {
            const bool samp = ui >= N_ATT_P; const int a = samp ? ui - N_ATT_P : ui >> 5;
            attn_unit(lds, Z, CK, CV, MIX, sinks, samp, a / 3, samp ? 0 : (ui & 31), a % 3);
        } else {
            const int j = ui - N_ATT; const bool samp = j >= N_POOL_P;
            pool_unit(lds, Z, CP, WPt, MIX, samp, samp ? j - N_POOL_P : j >> 5, samp ? 0 : (j & 31));
        }
    }
}
#undef MX_LAS
}
constexpr int NWAVES = 8;
#ifndef MK_N_LAUNCHES
#define MK_N_LAUNCHES 6
#endif
constexpr int N_LAUNCHES = MK_N_LAUNCHES;
constexpr int PER_PHASE = 6;

constexpr size_t MiB = 1u << 20;
constexpr size_t WS_CTL = 0, WS_SS = 1 * MiB, CTL_ZERO_BYTES = 2 * MiB;
constexpr size_t WS_WIN = 2 * MiB, WS_WOUT = 5 * MiB, WS_WGU = 7 * MiB, WS_WD = 18 * MiB;
constexpr size_t WS_WP = 24 * MiB, WS_CK = 25 * MiB, WS_CV = 27 * MiB, WS_CP = 29 * MiB;
constexpr size_t WS_XN = 32 * MiB;
constexpr size_t WS_Z = 164 * MiB;
constexpr size_t WS_MIX = 346 * MiB;
constexpr size_t WS_ACT = 478 * MiB;
constexpr size_t WS_END = 842 * MiB;
static_assert(WS_SS + (size_t)67584 * 4 <= CTL_ZERO_BYTES && WS_WD + (size_t)1024 * 2816 * 2 <= WS_WP && WS_XN + (size_t)67584 * 1024 * 2 <= WS_Z && WS_Z + (size_t)67584 * 1408 * 2 <= WS_MIX &&
              WS_MIX + (size_t)67584 * 1024 * 2 <= WS_ACT && WS_ACT + (size_t)67584 * 2816 * 2 <= WS_END, "d_ws map");
constexpr int CW_TMO = 0, CW_CODE = 1;
constexpr int CW_BAR = 4096;
constexpr int RING_OFF = 0, RING_BYTES = 131072;
constexpr int LDSCTL_OFF = RING_BYTES, MISC_OFF = LDSCTL_OFF + 320;
constexpr int LDS_BYTES = 147456;
static_assert(MISC_OFF + 128 <= LDS_BYTES, "LDS map");

#define GAS __attribute__((address_space(1)))
#define LAS __attribute__((address_space(3)))
typedef unsigned short bf16;
typedef unsigned v4u __attribute__((ext_vector_type(4)));
typedef float f32x4 __attribute__((ext_vector_type(4)));
typedef short bf16x8 __attribute__((ext_vector_type(8)));
typedef GAS unsigned gu32;
typedef GAS unsigned long long gu64;
#define RLX_AGENT __ATOMIC_RELAXED, __HIP_MEMORY_SCOPE_AGENT
#define LDS_WAIT() asm volatile("s_waitcnt lgkmcnt(0)" ::: "memory")
#define VM_WAIT() asm volatile("s_waitcnt vmcnt(0)" ::: "memory")
__device__ __forceinline__ unsigned long long rt() { return __builtin_amdgcn_s_memrealtime(); }
__device__ __forceinline__ unsigned f2bf(float f) { unsigned u = __builtin_bit_cast(unsigned, f); return (u + 0x7fffu + ((u >> 16) & 1u)) >> 16; }
__device__ __forceinline__ unsigned pk2(float lo, float hi) { return f2bf(lo) | (f2bf(hi) << 16); }

#define XB_TMO      128
#define XB_XCNT(j)  (256  + 64 * (j))
#define XB_XSUB(j)  (1280 + 64 * (j))
#define XB_XGEN(j)  (2304 + 64 * (j))
#define XB_TOP      3328
#define XB_TOPGEN   3392
#define XCD_BAR_WORDS 3456
#define XB_SPIN_CAP (1u << 18)

__device__ __forceinline__ unsigned xb_ld(unsigned* p)              { return __hip_atomic_load(p, __ATOMIC_RELAXED, __HIP_MEMORY_SCOPE_AGENT); }
__device__ __forceinline__ unsigned xb_add(unsigned* p, unsigned v) { return __hip_atomic_fetch_add(p, v, __ATOMIC_RELAXED, __HIP_MEMORY_SCOPE_AGENT); }
__device__ __forceinline__ unsigned xb_xcc_id() { return (unsigned)__builtin_amdgcn_s_getreg((3 << 11) | 20) & 0xFu; }
#define XB_SPIN(cond, bar) do { unsigned _sp = 0; while (cond) { __builtin_amdgcn_s_sleep(1); \
    if ((++_sp & 255u) == 0u) { if (xb_ld(&(bar)[XB_TMO])) break; if (_sp > XB_SPIN_CAP) { atomicAdd(&(bar)[XB_TMO], 1u); break; } } } } while (0)

struct XcdBarrier {
    unsigned* bar; unsigned x;
    volatile LAS unsigned* st;
};

__device__ __forceinline__ XcdBarrier xcd_barrier_post(unsigned* bar, volatile LAS unsigned* st) {
    XcdBarrier b; b.bar = bar; b.x = xb_xcc_id(); b.st = st;
    if (threadIdx.x == 0) (void)xb_add(&bar[XB_XCNT(b.x)], 1u);
    return b;
}
__device__ __forceinline__ void xcd_barrier_complete(unsigned* bar, unsigned x, unsigned& nloc, unsigned& nx) {
    const unsigned G = gridDim.x * gridDim.y * gridDim.z;
    unsigned sum, cnt, mine, sp = 0u;
    for (;;) {
        sum = 0u; cnt = 0u; mine = 0u;
#pragma unroll
        for (unsigned j = 0; j < 16; ++j) { const unsigned c = xb_ld(&bar[XB_XCNT(j)]); sum += c; cnt += (c > 0u) ? 1u : 0u; mine = (j == x) ? c : mine; }
        if (sum == G) break;
        __builtin_amdgcn_s_sleep(1);
        if ((++sp & 255u) == 0u) { if (xb_ld(&bar[XB_TMO])) break; if (sp > XB_SPIN_CAP) { atomicAdd(&bar[XB_TMO], 1u); break; } }
    }
    nloc = mine > 0u ? mine : 1u; nx = cnt > 0u ? cnt : 1u;
}

__device__ __forceinline__ void xcd_barrier(const XcdBarrier& b) {
    asm volatile("s_waitcnt vmcnt(0)" ::: "memory");
    __syncthreads();
    if (threadIdx.x == 0) {
        unsigned* bar = b.bar;
        __builtin_amdgcn_s_waitcnt(0);
        unsigned nloc = b.st[0], nx = b.st[1];
        if (nloc == 0u) { xcd_barrier_complete(bar, b.x, nloc, nx); b.st[0] = nloc; b.st[1] = nx; }
        const unsigned old = xb_add(&bar[XB_XSUB(b.x)], 1u);
        const unsigned gen = old / nloc;
        if (old + 1u == (gen + 1u) * nloc) {
            __builtin_amdgcn_fence(__ATOMIC_RELEASE, "agent");
            asm volatile("s_waitcnt vmcnt(0)" ::: "memory");
            const unsigned og = xb_add(&bar[XB_TOP], 1u);
            const unsigned tg = og / nx;
            if (og + 1u == (tg + 1u) * nx) xb_add(&bar[XB_TOPGEN], 1u);
            else XB_SPIN(xb_ld(&bar[XB_TOPGEN]) == tg, bar);
            __builtin_amdgcn_fence(__ATOMIC_ACQUIRE, "agent");
            xb_add(&bar[XB_XGEN(b.x)], 1u);
            asm volatile("s_waitcnt vmcnt(0)" ::: "memory");
        } else {
            XB_SPIN(xb_ld(&bar[XB_XGEN(b.x)]) == gen, bar);
            __builtin_amdgcn_fence(__ATOMIC_ACQUIRE, "agent");
            asm volatile("s_waitcnt vmcnt(0)" ::: "memory");
        }
    }
    __syncthreads();
}
struct Frame {
    LAS unsigned char* lds;
    volatile LAS unsigned* MISC;
    gu32* ctl;
    int tid, lane, wave;
    int vcu, G;
};

__device__ __forceinline__ float wave_sum(float v) {
#pragma unroll
    for (int o = 1; o < 64; o <<= 1) v += __shfl_xor(v, o);
    return v;
}
__device__ __forceinline__ void p0_transpose_item(const float* W, const float* gain, int K, int N, bf16* WT, int k0, int n0, int drow0, LAS float* scr, int lane) {
#pragma unroll 8
    for (int i = 0; i < 32; ++i) { const int kk = 2 * i + (lane >> 5); float w = W[(size_t)(k0 + kk) * N + n0 + (lane & 31)]; if (gain) w *= gain[k0 + kk]; scr[kk * 33 + (lane & 31)] = w; }
    LDS_WAIT(); asm volatile("" ::: "memory");
    const int c = lane & 7;
#pragma unroll
    for (int j = 0; j < 4; ++j) { const int n = (lane >> 3) + 8 * j; const LAS float* s = scr + (8 * c) * 33 + n;
        v4u o; o.x = pk2(s[0 * 33], s[1 * 33]); o.y = pk2(s[2 * 33], s[3 * 33]); o.z = pk2(s[4 * 33], s[5 * 33]); o.w = pk2(s[6 * 33], s[7 * 33]);
        *(GAS v4u*)(WT + (size_t)(drow0 + n) * K + k0 + 8 * c) = o; }
    LDS_WAIT(); asm volatile("" ::: "memory");
}
__device__ __forceinline__ void rms_row_to_bf16(const float* xrow, bf16* orow, int lane) {
    const GAS f32x4* xr = (const GAS f32x4*)xrow + lane;
    f32x4 v[4]; float s = 0.f;
#pragma unroll
    for (int j = 0; j < 4; ++j) { v[j] = xr[64 * j]; s += (v[j].x * v[j].x + v[j].y * v[j].y) + (v[j].z * v[j].z + v[j].w * v[j].w); }
    const float rstd = 1.f / sqrtf(wave_sum(s) * (1.f / 1024.f) + 1e-6f);
    GAS unsigned long long* o8 = (GAS unsigned long long*)orow + lane;
#pragma unroll
    for (int j = 0; j < 4; ++j) o8[64 * j] = (unsigned long long)pk2(v[j].x * rstd, v[j].y * rstd) | ((unsigned long long)pk2(v[j].z * rstd, v[j].w * rstd) << 32);
}
struct P0Args { const float *xp, *xs, *cpool, *ck, *cv, *norm_mix, *w_in, *w_pool, *pool_scale, *w_out, *norm_ffn, *w_gate, *w_up, *w_down; float* out;
                bf16 *Win_t, *Wout_t, *Wgu_t, *Wd_t, *WPt, *CK, *CV, *CP, *XN; };
__device__ __forceinline__ void p0_prologue(Frame& F, const P0Args& A) {
    LAS float* scr = (LAS float*)(F.lds + RING_OFF + F.wave * 16384);
    const int gw = F.vcu * NWAVES + F.wave, NGW = F.G * NWAVES;
    constexpr int I_IN = 16 * 44, I_OUT = 16 * 32, I_G = 16 * 88, I_D = 44 * 32, NITEMS = I_IN + I_OUT + 2 * I_G + I_D;
    for (int it = gw; it < NITEMS; it += NGW) {
        int r = it;
        if (r < I_IN) { const int kb = r / 44, nb = r % 44, n0 = 32 * nb, lc = n0 & 255, dd = lc & 63;
            p0_transpose_item(A.w_in, A.norm_mix, 1024, 1408, A.Win_t, 64 * kb, n0, (n0 & ~255) + 128 * (dd >> 5) + 32 * (lc >> 6), scr, F.lane); continue; } r -= I_IN;
        if (r < I_OUT) { const int kb = r / 32, nb = r % 32; p0_transpose_item(A.w_out, nullptr, 1024, 1024, A.Wout_t, 64 * kb, 32 * nb, 32 * nb, scr, F.lane); continue; } r -= I_OUT;
        if (r < I_G) { const int kb = r / 88, nb = r % 88, n0 = 32 * nb;
            p0_transpose_item(A.w_gate, A.norm_ffn, 1024, 2816, A.Wgu_t, 64 * kb, n0, 256 * (n0 >> 7) + (n0 & 127), scr, F.lane); continue; } r -= I_G;
        if (r < I_G) { const int kb = r / 88, nb = r % 88, n0 = 32 * nb;
            p0_transpose_item(A.w_up, A.norm_ffn, 1024, 2816, A.Wgu_t, 64 * kb, n0, 256 * (n0 >> 7) + 128 + (n0 & 127), scr, F.lane); continue; } r -= I_G;
        { const int kb = r / 32, nb = r % 32; p0_transpose_item(A.w_down, nullptr, 2816, 1024, A.Wd_t, 64 * kb, 32 * nb, 32 * nb, scr, F.lane); }
    }
    for (int m = gw; m < pg8::MT; m += NGW) rms_row_to_bf16(m < pg8::MP ? A.xp + (size_t)m * 1024 : A.xs + (size_t)(m - pg8::MP) * 1024, A.XN + (size_t)m * 1024, F.lane);
    const int gt = gw * 64 + F.lane, NGT = NGW * 64;
    for (int i = gt; i < 4 * 64 * 64; i += NGT) { const int g = i >> 12, e = (i >> 6) & 63, c = i & 63;
        A.WPt[i] = (bf16)f2bf(A.w_pool[(g * 64 + c) * 64 + e] * A.pool_scale[64 * g + e]); }
    for (int i = gt; i < 32 * 128 * 192 / 4; i += NGT) {
        const f32x4 k4 = ((const GAS f32x4*)A.ck)[i], v4 = ((const GAS f32x4*)A.cv)[i];
        ((GAS unsigned long long*)A.CK)[i] = (unsigned long long)pk2(k4.x, k4.y) | ((unsigned long long)pk2(k4.z, k4.w) << 32);
        ((GAS unsigned long long*)A.CV)[i] = (unsigned long long)pk2(v4.x, v4.y) | ((unsigned long long)pk2(v4.z, v4.w) << 32);
        const int b = i / (128 * 48), rr = (i / 48) & 127, q = i % 48;
        if (rr >= 64) { const size_t o = ((size_t)(b * 128 + rr - 64) * 192) / 4 + q; ((GAS f32x4*)(A.out + pg8::O_K_S))[o] = k4; ((GAS f32x4*)(A.out + pg8::O_V_S))[o] = v4; }
    }
    for (int i = gt; i < 32 * 15 * 256 / 4; i += NGT) { const f32x4 p4 = ((const GAS f32x4*)A.cpool)[i]; ((GAS unsigned long long*)A.CP)[i] = (unsigned long long)pk2(p4.x, p4.y) | ((unsigned long long)pk2(p4.z, p4.w) << 32); }
}

struct Args { const float* in[17]; float* out; unsigned char* ws; int ph_lo, ph_hi, li, pad; };
__global__ void __launch_bounds__(NWAVES * 64, 2) mk_fwd(Args args) {
    extern __shared__ __attribute__((aligned(16))) unsigned char lds[];
    Frame F;
    F.lds = (LAS unsigned char*)lds;
    F.MISC = (volatile LAS unsigned*)(F.lds + MISC_OFF);
    F.tid = threadIdx.x; F.lane = F.tid & 63; F.wave = __builtin_amdgcn_readfirstlane(F.tid >> 6);
    F.G = gridDim.x; { const int bx = blockIdx.x; F.vcu = (F.G % 8 == 0) ? (bx % 8) * (F.G / 8) + bx / 8 : bx; }
#define GRID_BAR(seam) do { if (N_LAUNCHES == PER_PHASE) { if (F.tid == 0) __hip_atomic_store(F.ctl + CW_TMO, 0xBADBA0u | (unsigned)(seam), RLX_AGENT); } \
    else { xcd_barrier(bar); } } while (0)
    unsigned char* ws = args.ws;
    F.ctl = (gu32*)(ws + WS_CTL);
    float* const out = args.out;
    bf16* const Win_t = (bf16*)(ws + WS_WIN); bf16* const Wout_t = (bf16*)(ws + WS_WOUT); bf16* const Wgu_t = (bf16*)(ws + WS_WGU); bf16* const Wd_t = (bf16*)(ws + WS_WD);
    bf16* const WPt = (bf16*)(ws + WS_WP); bf16* const CKb = (bf16*)(ws + WS_CK); bf16* const CVb = (bf16*)(ws + WS_CV); bf16* const CPb = (bf16*)(ws + WS_CP);
    bf16* const XN = (bf16*)(ws + WS_XN); bf16* const HB = (bf16*)(ws + WS_XN); bf16* const Z = (bf16*)(ws + WS_Z); bf16* const MIX = (bf16*)(ws + WS_MIX); bf16* const ACT = (bf16*)(ws + WS_ACT);
    float* const SS = (float*)(ws + WS_SS);
    for (int u = F.tid; u < (LDS_BYTES - LDSCTL_OFF) / 4; u += NWAVES * 64) ((LAS unsigned*)(F.lds + LDSCTL_OFF))[u] = 0u;
    __syncthreads();
    const int bli = (N_LAUNCHES == PER_PHASE) ? 0 : args.li;
    XcdBarrier bar; bar.bar = (unsigned*)(F.ctl + CW_BAR) + bli * XCD_BAR_WORDS; bar.x = 0; bar.st = nullptr;
    if (N_LAUNCHES != PER_PHASE)
        bar = xcd_barrier_post((unsigned*)(F.ctl + CW_BAR) + bli * XCD_BAR_WORDS, F.MISC + 8);

    const int lo = args.ph_lo, hi = args.ph_hi;
#define IN(k) (lo <= (k) && (k) < hi)
#define BOTH(k) (IN(k) && IN((k) + 1))

    if (IN(0)) {
        P0Args A{args.in[0], args.in[1], args.in[2], args.in[3], args.in[4], args.in[5], args.in[6], args.in[7], args.in[8], args.in[12], args.in[13], args.in[14], args.in[15], args.in[16], out,
                 Win_t, Wout_t, Wgu_t, Wd_t, WPt, CKb, CVb, CPb, XN};
        p0_prologue(F, A);
        if (BOTH(0)) GRID_BAR(0);
    }
    if (IN(1)) {
        pg8::Gemm g{XN, Win_t, pg8::MT, 1536, 1024}; pg8::StaticOrder S; S.init(pg8::MT, 1536, F.G, (int)blockIdx.x);
        pg8::EpiZ E{Z, args.in[9], args.in[10], out};
        pg8::gemm_phase<pg8::EpiZ, pg8::StaticOrder, PG8_ALIGN, PG8_SP2>(F.lds + RING_OFF, g, S, E);
        if (BOTH(1)) GRID_BAR(1);
    }
    if (IN(2)) {
        mixp::mix_phase(F.lds + RING_OFF, Z, CKb, CVb, CPb, WPt, MIX, args.in[11], (int)blockIdx.x, F.G);
        if (BOTH(2)) GRID_BAR(2);
    }
    if (IN(3)) {
        pg8::Gemm g{MIX, Wout_t, pg8::MT, 1024, 1024}; pg8::StaticOrder S; S.init(pg8::MT, 1024, F.G, (int)blockIdx.x);
        pg8::EpiH E{args.in[0], args.in[1], out, HB, SS};
        pg8::gemm_phase<pg8::EpiH, pg8::StaticOrder, PG8_ALIGN, PG8_SP2>(F.lds + RING_OFF, g, S, E);
        if (BOTH(3)) GRID_BAR(3);
    }
    if (IN(4)) {
        pg8::Gemm g{HB, Wgu_t, pg8::MT, 5632, 1024}; pg8::StaticOrder S; S.init(pg8::MT, 5632, F.G, (int)blockIdx.x);
        pg8::EpiAct E{SS, ACT};
        pg8::gemm_phase<pg8::EpiAct, pg8::StaticOrder, PG8_ALIGN, PG8_SP2>(F.lds + RING_OFF, g, S, E);
        if (BOTH(4)) GRID_BAR(4);
    }
    if (IN(5)) {
        pg8::Gemm g{ACT, Wd_t, pg8::MT, 1024, 2816}; pg8::StaticOrder S; S.init(pg8::MT, 1024, F.G, (int)blockIdx.x);
        pg8::EpiY E{out};
        pg8::gemm_phase<pg8::EpiY, pg8::StaticOrder, PG8_ALIGN, PG8_SP2>(F.lds + RING_OFF, g, S, E);
    }
#undef IN
#undef BOTH
}

extern "C" void kernel_launch(void* const* d_in, const int* in_sizes, int n_in, void* d_out, int out_size, void* d_ws, size_t ws_size, hipStream_t stream) {
    static int grid = 0;
    if (grid == 0) {
        if (n_in != 17 || in_sizes[0] != 65536 * 1024 || out_size != (int)pg8::O_END || ws_size < WS_END) { fprintf(stderr, "kernel_launch: shape mismatch: n_in %d, in0 %d, out %d, ws %zu (need >= %zu); nothing launched\n", n_in, n_in > 0 ? in_sizes[0] : -1, out_size, ws_size, (size_t)WS_END); grid = -1; return; }
        int dev = 0, cus = 0, per_cu = 0;
        if (hipGetDevice(&dev) != hipSuccess || hipDeviceGetAttribute(&cus, hipDeviceAttributeMultiprocessorCount, dev) != hipSuccess) { fprintf(stderr, "kernel_launch: hipGetDevice / hipDeviceGetAttribute failed; nothing launched\n"); grid = -1; return; }
        if (hipFuncSetAttribute((const void*)mk_fwd, hipFuncAttributeMaxDynamicSharedMemorySize, LDS_BYTES) != hipSuccess) { fprintf(stderr, "kernel_launch: hipFuncSetAttribute failed; nothing launched\n"); grid = -1; return; }
        if (hipOccupancyMaxActiveBlocksPerMultiprocessor(&per_cu, (const void*)mk_fwd, NWAVES * 64, LDS_BYTES) != hipSuccess || per_cu < 1)
            fprintf(stderr, "kernel_launch: note: the occupancy query reports %d workgroups per CU\n", per_cu);
        (void)hipGetLastError();
        grid = cus;
    }
    if (grid < 0) return;
    if (hipMemsetAsync((char*)d_ws + WS_CTL, 0, CTL_ZERO_BYTES, stream) != hipSuccess) { fprintf(stderr, "kernel_launch: hipMemsetAsync of the control words failed; nothing launched\n"); return; }
    Args a{};
    for (int i = 0; i < 17; ++i) a.in[i] = (const float*)d_in[i];
    a.out = (float*)d_out; a.ws = (unsigned char*)d_ws;
    static_assert(((N_LAUNCHES >= 1 && N_LAUNCHES <= 3) || N_LAUNCHES == PER_PHASE) && (CW_BAR + 3 * XCD_BAR_WORDS) * 4 <= (int)(1u << 20), "-DMK_N_LAUNCHES must be 1, 2, 3 or 6");
    const int cuts3[4] = {0, N_LAUNCHES == 3 ? 1 : (N_LAUNCHES == 2 ? 4 : PER_PHASE), N_LAUNCHES == 3 ? 4 : PER_PHASE, PER_PHASE};
    for (int li = 0; li < N_LAUNCHES; ++li) {
        a.ph_lo = (N_LAUNCHES == PER_PHASE) ? li : cuts3[li]; a.ph_hi = (N_LAUNCHES == PER_PHASE) ? li + 1 : cuts3[li + 1]; a.li = li;
        hipLaunchKernelGGL(mk_fwd, dim3(grid), dim3(NWAVES * 64), LDS_BYTES, stream, a);
        const hipError_t le = hipPeekAtLastError();
        if (le != hipSuccess) { fprintf(stderr, "kernel_launch: launch %d failed: %s (grid %d x %d threads, %d B LDS)\n", li, hipGetErrorName(le), grid, NWAVES * 64, LDS_BYTES); break; }
    }
}
```

```cpp
#include <hip/hip_runtime.h>
#include <cstdio>
#include <cstdint>
namespace pg8 {
#define PG8_LAS __attribute__((address_space(3)))
typedef unsigned short bf16_t;
typedef short bf16x8 __attribute__((ext_vector_type(8)));
typedef float f32x4 __attribute__((ext_vector_type(4)));
typedef unsigned u32x4 __attribute__((ext_vector_type(4)));
constexpr int BM = 256, BK = 64, HALF = 128, HTB = HALF * BK * 2  , STAGE_BYTES = 8 * HTB, NXCD = 8, WGM = 8;

__host__ __device__ __forceinline__ int lds_byte(int r, int c) { const int st = (r >> 4) * 2 + (c >> 5), rr = r & 15, cc = c & 31, ob = rr * 64 + cc * 2; return st * 1024 + (ob ^ (((ob >> 9) & 1) << 5)); }
__host__ __device__ __forceinline__ int img_off(int r, int c) { return ((r >> 7) * HTB + lds_byte(r & 127, c)) >> 1; }
__host__ __device__ __forceinline__ void stage_rc(int b, int& R, int& C) { const int st = b / 1024, sb = b % 1024, swz = sb ^ (((sb >> 9) & 1) << 5); R = (st >> 1) * 16 + swz / 64; C = (st & 1) * 32 + (swz % 64) / 2; }
__host__ __device__ __forceinline__ int inv_perm32(int x) { return 16 * ((x >> 2) & 1) + 4 * (x >> 3) + (x & 3); }
__host__ __device__ __forceinline__ int perm32(int rho) { const int n = rho >> 4, i = rho & 15; return 8 * (i >> 2) + 4 * n + (i & 3); }

struct Unit { int pm, pn, hb, hm; };
struct Gemm { const bf16_t* A; const bf16_t* Bt; int M, N, K; };

struct StaticOrder {
    int nM, nN, nwg, G, c, lo, hi, rev, wgm;
    __host__ __device__ void init(int M, int N, int G_, int c_) { nM = M / BM; nN = N / BM; nwg = nM * nN; G = G_; c = c_; lo = 0; hi = nwg; rev = 0; wgm = WGM; }
    __host__ __device__ bool next(int i, Unit& u) const {
        const long L = (long)lo + (long)i * G + c; if (L >= hi) return false;
        int wgid = (int)L; { const int q = nwg / NXCD, r = nwg % NXCD, xcd = wgid % NXCD, off = wgid / NXCD; wgid = (xcd < r ? xcd * (q + 1) : r * (q + 1) + (xcd - r) * q) + off; }
        const int nig = wgm * nN, gid = wgid / nig, fm = gid * wgm, gsz = (nM - fm) < wgm ? (nM - fm) : wgm;
        u.pm = fm + ((wgid % nig) % gsz); u.pn = (wgid % nig) / gsz; u.hb = 0; u.hm = 0; if (rev) u.pm = nM - 1 - u.pm; return true;
    }
    __host__ __device__ void tile_of(int L, Unit& u) const { StaticOrder t = *this; t.lo = L; t.hi = L + 1; t.c = 0; (void)t.next(0, u); }
    __device__ __forceinline__ void a_ready(const Unit&) const {}
    __device__ __forceinline__ void done(const Unit&) const {}
};
struct BalancedFullOrder : StaticOrder {
    __host__ __device__ bool next(int i, Unit& u) const {
        if (G != 256 || nwg != 1320) return StaticOrder::next(i, u);
        int L; if (i < 4) L = i * G + c; else if (i == 4 && c < 208) L = 4 * G + c; else if (i == 5 && c < 88) L = 4 * G + 208 + c; else return false;
        StaticOrder t = *this; t.lo = L; t.hi = L + 1; t.c = 0; return t.StaticOrder::next(0, u);
    }
};
struct BalancedHalfOrder {
    int pn, hb, c, G, nM, busy;
    __host__ __device__ bool next(int i, Unit& u) const { int j;
        if (G != 256 || nM != 264) { if (c < busy) return false; j = (c - busy) + (G - busy) * i; if (j >= nM) return false; u.pm = j; u.pn = pn; u.hb = hb; u.hm = 0; return true; }
        if (c < 88) return false; if (c < 208) { if (i > 0) return false; j = c - 88; } else { if (i > 2) return false; j = 120 + 3 * (c - 208) + i; }
        u.pm = j; u.pn = pn; u.hb = hb; u.hm = 0; return true; }
    __device__ __forceinline__ void a_ready(const Unit&) const {}
    __device__ __forceinline__ void done(const Unit&) const {}
};
struct TailHalfOrder {
    StaticOrder S; int lo, c;
    __host__ __device__ bool next(int i, Unit& u) const { if (i > 0) return false; const int L = lo + (c >> 1); if (L >= S.nwg) return false; S.tile_of(L, u); u.hb = c & 1; return true; }
    __device__ __forceinline__ void a_ready(const Unit&) const {}
    __device__ __forceinline__ void done(const Unit&) const {}
};
struct TailQuarterOrder {
    StaticOrder S; int lo, c;
    __host__ __device__ bool next(int i, Unit& u) const { if (i > 0) return false; const int L = lo + (c >> 2); if (L >= S.nwg) return false; S.tile_of(L, u); u.hb = c & 1; u.hm = (c >> 1) & 1; return true; }
    __device__ __forceinline__ void a_ready(const Unit&) const {}
    __device__ __forceinline__ void done(const Unit&) const {}
};
typedef float f32x2 __attribute__((ext_vector_type(2))); typedef __bf16 bf16x2_t __attribute__((ext_vector_type(2)));
__device__ __forceinline__ unsigned cvt_pk_bf16(float lo, float hi) { f32x2 v = {lo, hi}; bf16x2_t b = __builtin_convertvector(v, bf16x2_t); return __builtin_bit_cast(unsigned, b); }
typedef unsigned u32x2 __attribute__((ext_vector_type(2)));
constexpr float LOG2E = 1.4426950408889634f;
constexpr float C2 = 0.125f * LOG2E;
constexpr float EPS = 1e-6f;
constexpr int HALF_COLS = 128;
constexpr int DM = 1024, ZP = 1408, FF = 2816;
constexpr int MP = 65536, MS = 2048, MT = MP + MS;
constexpr size_t O_POOL_P = 69206016, O_K_P = 69328896, O_V_P = 70115328, O_POOL_S = 70901760, O_K_S = 71024640, O_V_S = 71811072, O_END = 72597504;

__device__ __forceinline__ void acc_zero(f32x4 (&acc)[2][2][4][2]) {
#pragma unroll
    for (int a = 0; a < 2; ++a)
#pragma unroll
        for (int b = 0; b < 2; ++b)
#pragma unroll
            for (int m = 0; m < 4; ++m)
#pragma unroll
                for (int n = 0; n < 2; ++n) acc[a][b][m][n] = (f32x4){0.f, 0.f, 0.f, 0.f};
}
__device__ __forceinline__ float bf_lo(unsigned w) { return __uint_as_float(w << 16); }
__device__ __forceinline__ float bf_hi(unsigned w) { return __uint_as_float(w & 0xffff0000u); }
template <bool HN = false, bool HM = false, bool BLK = false>
__device__ __forceinline__ void acc_from_bf16(f32x4 (&acc)[2][2][4][2], const bf16_t* R, const Unit& u, int wr, int wc, int fr, int fq) {
    const int r0 = (HM ? u.hm * HALF : 0) + wr * 64 + fr, c0 = u.pn * BM + (HN ? u.hb * HALF_COLS : 0) + wc * 32 + 8 * fq;
    const bf16_t* rp = BLK ? R + (size_t)u.pm * (1024 / BK) * (BM * BK) : R + ((size_t)u.pm * BM + r0) * 1024 + c0;
#pragma unroll
    for (int ai = 0; ai < (HM ? 1 : 2); ++ai)
#pragma unroll
        for (int m = 0; m < 4; ++m)
#pragma unroll
            for (int bj = 0; bj < (HN ? 1 : 2); ++bj) { const int c = c0 + bj * HALF;
                const u32x4 w = BLK ? *(const u32x4*)(rp + (size_t)(c >> 6) * (BM * BK) + img_off(r0 + ai * HALF + m * 16, c & 63)) : *(const u32x4*)(rp + (size_t)(ai * HALF + m * 16) * 1024 + bj * HALF);
                acc[ai][bj][m][0] = (f32x4){bf_lo(w.x), bf_hi(w.x), bf_lo(w.y), bf_hi(w.y)}; acc[ai][bj][m][1] = (f32x4){bf_lo(w.z), bf_hi(w.z), bf_lo(w.w), bf_hi(w.w)}; }
}

struct EpiZ {
    static constexpr bool PERM = true, AFTER_DRAIN = false, INIT_LOADS = false; static constexpr int RELAX = 0, B_AUX = 0, A_BLK = 0;
    bf16_t* Z; const float* qn; const float* kn; float* out; const float* RX;
    struct Aux {};
    __device__ __forceinline__ void init(f32x4 (&acc)[2][2][4][2], const Unit&, int, int, int, int) const { acc_zero(acc); }
    __device__ __forceinline__ void aux_load(Aux&, const Unit&, int, int, int, int) const {}
    __device__ __forceinline__ void operator()(const f32x4 (&acc)[2][2][4][2], const Aux&, const Unit& u, int wr, int wc, int fr, int fq) const {
        const int zcol = u.pn * 256 + wc * 64;
        if (zcol >= ZP) return;
        const int kind = (zcol >= 256 && zcol < 1024) ? 1 : ((zcol >= 1024 && zcol < 1216) ? 2 : 0);
        f32x4 sc[2][2];
#pragma unroll
        for (int bj = 0; bj < 2; ++bj)
#pragma unroll
            for (int n = 0; n < 2; ++n) {
                if (kind == 1) sc[bj][n] = *(const f32x4*)(qn + 32 * bj + 8 * fq + 4 * n) * C2;
                else if (kind == 2) sc[bj][n] = *(const f32x4*)(kn + 32 * bj + 8 * fq + 4 * n);
                else sc[bj][n] = (f32x4){1.f, 1.f, 1.f, 1.f};
            }
        const bool samp = u.pm >= 256;
        const int cm = (!samp && (u.pm & 7) != 7) ? 0 : (zcol < 256 ? 1 : (zcol >= 1216 ? 3 : (zcol >= 1024 ? 2 : 0)));
        const int rowbase = u.pm * BM + wr * 64 + fr;
#pragma unroll
        for (int ai = 0; ai < 2; ++ai)
#pragma unroll
            for (int m = 0; m < 4; ++m) {
                const int row = rowbase + ai * HALF + m * 16;
                const float rx = RX[row];
                float rs = rx;
                if (kind) {
                    float ss = 0.f;
#pragma unroll
                    for (int bj = 0; bj < 2; ++bj)
#pragma unroll
                        for (int n = 0; n < 2; ++n) { const f32x4 x = acc[ai][bj][m][n]; ss += (x[0] * x[0] + x[1] * x[1]) + (x[2] * x[2] + x[3] * x[3]); }
                    ss += __shfl_xor(ss, 16); ss += __shfl_xor(ss, 32);
                    rs = rx / sqrtf(ss * (rx * rx) * (1.0f / 64.0f) + EPS);
                }
                f32x4 v[2][2];
#pragma unroll
                for (int bj = 0; bj < 2; ++bj)
#pragma unroll
                    for (int n = 0; n < 2; ++n) v[bj][n] = acc[ai][bj][m][n] * rs * sc[bj][n];
                bf16_t* zp = Z + ((size_t)(zcol >> 6) * MT + row) * 64 + 8 * fq;
#pragma unroll
                for (int bj = 0; bj < 2; ++bj) { u32x4 w; w.x = cvt_pk_bf16(v[bj][0][0], v[bj][0][1]); w.y = cvt_pk_bf16(v[bj][0][2], v[bj][0][3]); w.z = cvt_pk_bf16(v[bj][1][0], v[bj][1][1]); w.w = cvt_pk_bf16(v[bj][1][2], v[bj][1][3]);
                    *(u32x4*)(zp + 32 * bj) = w; }
                if (cm) {
                    int b, t, T; if (samp) { const int r2 = row - MP; b = r2 >> 6; t = r2 & 63; T = 64; } else { b = row >> 11; t = row & 2047; T = 2048; }
                    float* dst = nullptr;
                    if (cm == 1) { const int i = t - (T - 15); if (i >= 0) dst = out + (samp ? O_POOL_S : O_POOL_P) + ((size_t)(b * 15 + i) * 256 + zcol); }
                    else { const int i = samp ? 64 + t : t - (T - 128); if (i >= 0) dst = out + (cm == 2 ? (samp ? O_K_S : O_K_P) : (samp ? O_V_S : O_V_P)) + ((size_t)(b * 128 + i) * 192 + (zcol - (cm == 2 ? 1024 : 1216))); }
                    if (dst) {
#pragma unroll
                        for (int bj = 0; bj < 2; ++bj)
#pragma unroll
                            for (int n = 0; n < 2; ++n) *(f32x4*)(dst + 32 * bj + 8 * fq + 4 * n) = v[bj][n];
                    }
                }
            }
    }
};

struct EpiZv {
    static constexpr bool PERM = true, AFTER_DRAIN = false, INIT_LOADS = false; static constexpr int RELAX = 0, B_AUX = 0, A_BLK = 0;
    bf16_t* Z; float* out; const float* RX;
    struct Aux {};
    __device__ __forceinline__ void init(f32x4 (&acc)[2][2][4][2], const Unit&, int, int, int, int) const { acc_zero(acc); }
    __device__ __forceinline__ void aux_load(Aux&, const Unit&, int, int, int, int) const {}
    __device__ __forceinline__ void operator()(const f32x4 (&acc)[2][2][4][2], const Aux&, const Unit& u, int wr, int wc, int fr, int fq) const {
        const int zcol = 1280 + 32 * wc + 8 * fq;
        const bool samp = u.pm >= 256, cache = samp || (u.pm & 7) == 7;
        const int rowbase = u.pm * BM + wr * 64 + fr;
#pragma unroll
        for (int ai = 0; ai < 2; ++ai)
#pragma unroll
            for (int m = 0; m < 4; ++m) {
                const int row = rowbase + ai * HALF + m * 16;
                const float rx = RX[row];
                const f32x4 v0 = acc[ai][0][m][0] * rx, v1 = acc[ai][0][m][1] * rx;
                u32x4 w; w.x = cvt_pk_bf16(v0[0], v0[1]); w.y = cvt_pk_bf16(v0[2], v0[3]); w.z = cvt_pk_bf16(v1[0], v1[1]); w.w = cvt_pk_bf16(v1[2], v1[3]);
                *(u32x4*)(Z + ((size_t)(zcol >> 6) * MT + row) * 64 + (zcol & 63)) = w;
                if (cache) {
                    int b, i; if (samp) { const int r2 = row - MP; b = r2 >> 6; i = 64 + (r2 & 63); } else { b = row >> 11; i = (row & 2047) - 1920; }
                    if (i >= 0) { float* dst = out + (samp ? O_V_S : O_V_P) + ((size_t)(b * 128 + i) * 192 + (zcol - 1216)); *(f32x4*)dst = v0; *(f32x4*)(dst + 4) = v1; }
                }
            }
    }
};

template <bool HN = false, bool HM = false> struct EpiH {
    static constexpr bool PERM = true, AFTER_DRAIN = false, INIT_LOADS = true; static constexpr int RELAX = 0, B_AUX = 0, A_BLK = 1;
    const bf16_t* XB; bf16_t* HB; float* SS;
    struct Aux {};
    __device__ __forceinline__ void init(f32x4 (&acc)[2][2][4][2], const Unit& u, int wr, int wc, int fr, int fq) const { acc_from_bf16<HN, HM>(acc, XB, u, wr, wc, fr, fq); }
    __device__ __forceinline__ void aux_load(Aux&, const Unit&, int, int, int, int) const {}
    __device__ __forceinline__ void operator()(const f32x4 (&acc)[2][2][4][2], const Aux&, const Unit& u, int wr, int wc, int fr, int fq) const {
        const int col0 = u.pn * BM + (HN ? u.hb * HALF_COLS : 0) + wc * 32 + 8 * fq;
#pragma unroll
        for (int ai = 0; ai < (HM ? 1 : 2); ++ai) {
#pragma unroll
            for (int m = 0; m < 4; ++m) {
                const size_t grow = (size_t)u.pm * BM + (HM ? u.hm : ai) * HALF + wr * 64 + m * 16 + fr;
                float ss = 0.f;
#pragma unroll
                for (int bj = 0; bj < (HN ? 1 : 2); ++bj) { const f32x4 h0 = acc[ai][bj][m][0], h1 = acc[ai][bj][m][1];
                    ss += ((h0[0] * h0[0] + h0[1] * h0[1]) + (h0[2] * h0[2] + h0[3] * h0[3])) + ((h1[0] * h1[0] + h1[1] * h1[1]) + (h1[2] * h1[2] + h1[3] * h1[3]));
                    u32x4 w; w.x = cvt_pk_bf16(h0[0], h0[1]); w.y = cvt_pk_bf16(h0[2], h0[3]); w.z = cvt_pk_bf16(h1[0], h1[1]); w.w = cvt_pk_bf16(h1[2], h1[3]);
                    { const int c = col0 + bj * HALF; *(u32x4*)(HB + ((size_t)u.pm * (DM / BK) + (c >> 6)) * (BM * BK) + img_off((int)(grow & 255), c & 63)) = w; } }
                ss += __shfl_xor(ss, 16); ss += __shfl_xor(ss, 32);
                if (fq == 0) atomicAdd(SS + grow, ss);
            }
        }
    }
};

struct EpiAct {
    static constexpr bool PERM = true, AFTER_DRAIN = false, INIT_LOADS = false; static constexpr int RELAX = 0, B_AUX = 0, A_BLK = 1;
    const float* SS; bf16_t* ACT; PG8_LAS unsigned char* stage;
    struct Aux {};
    __device__ __forceinline__ void init(f32x4 (&acc)[2][2][4][2], const Unit&, int, int, int, int) const { acc_zero(acc); }
    __device__ __forceinline__ void aux_load(Aux&, const Unit& u, int wr, int wc, int fr, int fq) const {
        __builtin_amdgcn_global_load_lds((const unsigned*)(SS + (size_t)u.pm * BM + 4 * (fr + 16 * fq)), (PG8_LAS unsigned*)(stage + (wr * 4 + wc) * 1024), 16, 0, 0);
    }
    __device__ __forceinline__ void operator()(const f32x4 (&acc)[2][2][4][2], const Aux&, const Unit& u, int wr, int wc, int fr, int fq) const {
        const int col0 = u.pn * HALF + wc * 32 + 8 * fq;
        const PG8_LAS float* sl = (const PG8_LAS float*)(stage + (wr * 4 + wc) * 1024) + wr * 64 + fr;
#pragma unroll
        for (int ai = 0; ai < 2; ++ai)
#pragma unroll
            for (int m = 0; m < 4; ++m) {
                const size_t grow = (size_t)u.pm * BM + ai * HALF + wr * 64 + m * 16 + fr;
                const float r2 = __builtin_amdgcn_rcpf(sl[ai * HALF + m * 16] * (1.0f / DM) + EPS), rs = __builtin_amdgcn_sqrtf(r2), c1 = -LOG2E * rs;
                float o[8];
#pragma unroll
                for (int n = 0; n < 2; ++n)
#pragma unroll
                    for (int e = 0; e < 4; ++e) { const float g = acc[ai][0][m][n][e], uu = acc[ai][1][m][n][e];
                        o[4 * n + e] = (g * uu) * (r2 * __builtin_amdgcn_rcpf(1.0f + __builtin_amdgcn_exp2f(c1 * g))); }
                u32x4 w; w.x = cvt_pk_bf16(o[0], o[1]); w.y = cvt_pk_bf16(o[2], o[3]); w.z = cvt_pk_bf16(o[4], o[5]); w.w = cvt_pk_bf16(o[6], o[7]);
                *(u32x4*)(ACT + ((size_t)u.pm * (FF / BK) + (col0 >> 6)) * (BM * BK) + img_off((int)(grow & 255), col0 & 63)) = w;
            }
    }
};

template <bool HN = false, bool HM = false> struct EpiY {
    static constexpr bool PERM = true, AFTER_DRAIN = false, INIT_LOADS = true; static constexpr int RELAX = 0, B_AUX = 0, A_BLK = 1;
    const bf16_t* HB; float* Y; PG8_LAS unsigned char* stage;
    struct Aux {};
    __device__ __forceinline__ void init(f32x4 (&acc)[2][2][4][2], const Unit& u, int wr, int wc, int fr, int fq) const { acc_from_bf16<HN, HM, true>(acc, HB, u, wr, wc, fr, fq); }
    __device__ __forceinline__ void aux_load(Aux&, const Unit&, int, int, int, int) const {}
    __device__ __forceinline__ void operator()(const f32x4 (&acc)[2][2][4][2], const Aux&, const Unit& u, int wr, int wc, int fr, int fq) const {
        const int lane = fr + 16 * fq; PG8_LAS unsigned char* st = stage + (wr * 4 + wc) * 2048;
#pragma unroll
        for (int ai = 0; ai < (HM ? 1 : 2); ++ai) {
#pragma unroll
            for (int m = 0; m < 4; ++m) {
                float* tp = Y + ((size_t)u.pm * BM + (HM ? u.hm : ai) * HALF + wr * 64 + m * 16 + (lane >> 3)) * DM + u.pn * BM + (HN ? u.hb * HALF_COLS : 0) + wc * 32 + 4 * (lane & 7);
#pragma unroll
                for (int bj = 0; bj < (HN ? 1 : 2); ++bj) {
                    *(PG8_LAS f32x4*)(st + fr * 128 + (((2 * fq) ^ (fr & 7)) << 4)) = acc[ai][bj][m][0]; *(PG8_LAS f32x4*)(st + fr * 128 + (((2 * fq + 1) ^ (fr & 7)) << 4)) = acc[ai][bj][m][1];
                    asm volatile("s_waitcnt lgkmcnt(0)" ::: "memory");
#pragma unroll
                    for (int ps = 0; ps < 2; ++ps) { const int r = 8 * ps + (lane >> 3); const f32x4 v = *(const PG8_LAS f32x4*)(st + r * 128 + (((lane & 7) ^ (r & 7)) << 4)); *(f32x4*)(tp + (size_t)(8 * ps) * DM + bj * HALF) = v; }
                    asm volatile("s_waitcnt lgkmcnt(0)" ::: "memory");
                }
            }
        }
    }
};

template <class Epi, class Sched, bool ALIGN_EPI = false, bool SP2 = false, bool HALF_N = false>
__device__ __forceinline__ void gemm_phase(PG8_LAS unsigned char* lds, const Gemm g, const Sched& S, const Epi& E) {
    const int tid = threadIdx.x, wid = __builtin_amdgcn_readfirstlane(tid >> 6), lane = tid & 63, wr = wid >> 2, wc = wid & 3, fr = lane & 15, fq = lane >> 4;
    static_assert(SP2 || !HALF_N, "HALF_N needs the SP2 loop");
    const int K = g.K, nt = K / BK;
    unsigned voffA[2], voffB[2];
#pragma unroll
    for (int i = 0; i < 2; ++i) { int R, C; stage_rc(tid * 16 + i * 8192, R, C); const int Rb = Epi::PERM ? ((R & ~31) + perm32(R & 31)) : R;
        voffA[i] = Epi::A_BLK ? (unsigned)(tid * 16 + i * 8192) : (unsigned)(R * K + C) * 2u; voffB[i] = (unsigned)(tid * 16 + i * 8192); (void)Rb; }
    const size_t kstep = (size_t)(BK * 2);
    const size_t hstep = (size_t)HALF * K * 2;
    const size_t tstep = 2 * hstep;
    const size_t kstepA = Epi::A_BLK ? (size_t)BM * BK * 2 : kstep, hstepA = Epi::A_BLK ? (size_t)HALF * BK * 2 : hstep;
    const size_t kstepB = (size_t)BM * BK * 2, hstepB = (size_t)HALF * BK * 2;
    const unsigned ldsw = (unsigned)wid * 1024u;
    const int aoff = lds_byte(wr * 64 + fr, fq * 8), boff = lds_byte(wc * 32 + fr, fq * 8);
#define PG8_SA(b, h) (((b) * 2 + (h)) * HTB)
#define PG8_SB(b, h) ((4 + (b) * 2 + (h)) * HTB)
#define PG8_STAGE(bufoff, gbase, voff) do { _Pragma("unroll") for (int _i = 0; _i < 2; ++_i) \
        __builtin_amdgcn_global_load_lds((const unsigned*)((const char*)(gbase) + (voff)[_i]), (PG8_LAS unsigned*)(lds + (bufoff) + ldsw + _i * 8192), 16, 0, 0); } while (0)
#define PG8_STAGEB(bufoff, gbase) do { _Pragma("unroll") for (int _i = 0; _i < 2; ++_i) \
        __builtin_amdgcn_global_load_lds((const unsigned*)((const char*)(gbase) + voffB[_i]), (PG8_LAS unsigned*)(lds + (bufoff) + ldsw + _i * 8192), 16, 0, Epi::B_AUX); } while (0)
#define PG8_LDA(dst, b, h) do { _Pragma("unroll") for (int m = 0; m < 4; ++m) _Pragma("unroll") for (int k = 0; k < 2; ++k) dst[m][k] = *(const PG8_LAS bf16x8*)(lds + PG8_SA(b, h) + aoff + m * 2048 + k * 1024); } while (0)
#define PG8_LDB(dst, b, h) do { _Pragma("unroll") for (int n = 0; n < 2; ++n) _Pragma("unroll") for (int k = 0; k < 2; ++k) dst[n][k] = *(const PG8_LAS bf16x8*)(lds + PG8_SB(b, h) + boff + n * 2048 + k * 1024); } while (0)
#define PG8_MMA(ai, bj, At, Bt) do { __builtin_amdgcn_s_setprio(1); _Pragma("unroll") for (int m = 0; m < 4; ++m) _Pragma("unroll") for (int n = 0; n < 2; ++n) _Pragma("unroll") for (int k = 0; k < 2; ++k) \
        acc[ai][bj][m][n] = __builtin_amdgcn_mfma_f32_16x16x32_bf16(Bt[n][k], At[m][k], acc[ai][bj][m][n], 0, 0, 0); __builtin_amdgcn_s_setprio(0); } while (0)
#define PG8_WAIT_V(n) asm volatile("s_waitcnt vmcnt(" #n ")" ::: "memory")
#define PG8_WAIT_VK do { if constexpr (HALF_N) asm volatile("s_waitcnt vmcnt(6)" ::: "memory"); else asm volatile("s_waitcnt vmcnt(8)" ::: "memory"); } while (0)
#define PG8_STAGE_B1(bufoff, gbase) do { if constexpr (!HALF_N) PG8_STAGEB(bufoff, gbase); } while (0)
#define PG8_LDB1(dst, b) do { if constexpr (!HALF_N) PG8_LDB(dst, b, 1); } while (0)
#define PG8_MMA1(ai, At, Bt) do { if constexpr (!HALF_N) PG8_MMA(ai, 1, At, Bt); } while (0)
#define PG8_WAIT_V1 do { if (!HALF_N && Epi::RELAX == 9 && rl) asm volatile("s_waitcnt vmcnt(17)" ::: "memory"); else PG8_WAIT_VK; } while (0)
#define PG8_WAIT_L(n) asm volatile("s_waitcnt lgkmcnt(" #n ")" ::: "memory")
#define PG8_BAR __builtin_amdgcn_s_barrier()
#define PG8_SCHED __builtin_amdgcn_sched_barrier(0)
    Unit cur, nxt; int ui = 0;
    if (!S.next(0, cur)) return;
    f32x4 acc[2][2][4][2];
    typename Epi::Aux aux;
    E.init(acc, cur, wr, wc, fr, fq);
    bf16x8 At[4][2], B0[2][2], B1[2][2];
    const char* cA = (const char*)g.A + (size_t)cur.pm * tstep; const char* cB = (const char*)g.Bt + (size_t)cur.pn * tstep + (HALF_N ? (size_t)cur.hb * hstepB : (size_t)0);
    S.a_ready(cur);
    if constexpr (SP2) {
        PG8_STAGEB(PG8_SB(0, 0), cB); PG8_STAGE_B1(PG8_SB(0, 1), cB + hstepB); PG8_STAGE(PG8_SA(0, 0), cA, voffA); PG8_STAGE(PG8_SA(0, 1), cA + hstepA, voffA);
        if (wr == 1) PG8_BAR;
        PG8_WAIT_V(2); PG8_BAR;
        PG8_STAGEB(PG8_SB(1, 0), cB + kstepB); PG8_STAGE(PG8_SA(1, 0), cA + kstepA, voffA); PG8_STAGE_B1(PG8_SB(1, 1), cB + hstepB + kstepB);
        if constexpr (HALF_N) PG8_WAIT_V(4); else PG8_WAIT_V(6);
        PG8_BAR;
    } else {
        PG8_STAGEB(PG8_SB(0, 0), cB); PG8_STAGE(PG8_SA(0, 0), cA, voffA); PG8_STAGEB(PG8_SB(0, 1), cB + hstepB); PG8_STAGE(PG8_SA(0, 1), cA + hstepA, voffA);
        if (wr == 1) PG8_BAR;
        PG8_WAIT_V(4); PG8_BAR;
        PG8_STAGEB(PG8_SB(1, 0), cB + kstepB); PG8_STAGE(PG8_SA(1, 0), cA + kstepA, voffA); PG8_STAGEB(PG8_SB(1, 1), cB + hstepB + kstepB);
        PG8_WAIT_V(6); PG8_BAR;
    }
    for (;;) {
        if constexpr (Epi::INIT_LOADS) {
#pragma unroll
            for (int a = 0; a < 2; ++a)
#pragma unroll
                for (int b = 0; b < (HALF_N ? 1 : 2); ++b)
#pragma unroll
                    for (int m = 0; m < 4; ++m) asm volatile("" : "+v"(acc[a][b][m][0]), "+v"(acc[a][b][m][1]));
        }
        E.aux_load(aux, cur, wr, wc, fr, fq);
        const bool has_next = S.next(ui + 1, nxt);
        const char* nA = has_next ? (const char*)g.A + (size_t)nxt.pm * tstep : cA; const char* nB = has_next ? (const char*)g.Bt + (size_t)nxt.pn * tstep + (HALF_N ? (size_t)nxt.hb * hstepB : (size_t)0) : cB;
        for (int t = 0; t < nt; t += 2) {
            const bool last = (t == nt - 2);
            const char* a1 = cA + (size_t)(t + 1) * kstepA;
            const char* a2 = last ? nA : cA + (size_t)(t + 2) * kstepA; const char* b2 = last ? nB : cB + (size_t)(t + 2) * kstepB;
            const char* a3 = a2 + kstepA; const char* b3 = b2 + kstepB;
            if (last && has_next) S.a_ready(nxt);
            int rl = __builtin_amdgcn_readfirstlane((int)((t == 0) & (ui > 0))); asm volatile("" : "+s"(rl));
            if constexpr (SP2) {
            PG8_LDB(B0, 0, 0); PG8_LDB1(B1, 0); PG8_SCHED; PG8_LDA(At, 0, 0); PG8_STAGE(PG8_SA(1, 1), a1 + hstepA, voffA);
            PG8_WAIT_V1; PG8_WAIT_L(0); PG8_BAR; PG8_MMA(0, 0, At, B0); PG8_MMA1(0, At, B1); PG8_BAR; PG8_SCHED;
            PG8_LDA(At, 0, 1); PG8_STAGEB(PG8_SB(0, 0), b2); PG8_STAGE_B1(PG8_SB(0, 1), b2 + hstepB); PG8_STAGE(PG8_SA(0, 0), a2, voffA);
            PG8_WAIT_V1; PG8_WAIT_L(0); PG8_BAR; PG8_MMA(1, 0, At, B0); PG8_MMA1(1, At, B1); PG8_BAR; PG8_SCHED;
            PG8_LDB(B0, 1, 0); PG8_LDB1(B1, 1); PG8_SCHED; PG8_LDA(At, 1, 0); PG8_STAGE(PG8_SA(0, 1), a2 + hstepA, voffA);
            PG8_WAIT_VK; PG8_WAIT_L(0); PG8_BAR; PG8_MMA(0, 0, At, B0); PG8_MMA1(0, At, B1); PG8_BAR; PG8_SCHED;
            PG8_LDA(At, 1, 1); PG8_STAGEB(PG8_SB(1, 0), b3); PG8_STAGE_B1(PG8_SB(1, 1), b3 + hstepB); PG8_STAGE(PG8_SA(1, 0), a3, voffA);
            PG8_WAIT_VK; PG8_WAIT_L(0); PG8_BAR; PG8_MMA(1, 0, At, B0); PG8_MMA1(1, At, B1); PG8_BAR; PG8_SCHED;
            } else {
            PG8_LDB(B0, 0, 0); PG8_SCHED; PG8_LDA(At, 0, 0); PG8_STAGE(PG8_SA(1, 1), a1 + hstepA, voffA);
            PG8_WAIT_L(8); PG8_BAR; PG8_WAIT_L(0); PG8_MMA(0, 0, At, B0); PG8_BAR; PG8_SCHED;
            PG8_LDB(B1, 0, 1); PG8_STAGEB(PG8_SB(0, 0), b2);
            PG8_BAR; PG8_WAIT_L(0); PG8_MMA(0, 1, At, B1); PG8_BAR;
            PG8_LDA(At, 0, 1); PG8_STAGE(PG8_SA(0, 0), a2, voffA);
            PG8_BAR; PG8_WAIT_L(0); PG8_MMA(1, 0, At, B0); PG8_BAR; PG8_SCHED;
            PG8_STAGEB(PG8_SB(0, 1), b2 + hstepB);
            PG8_WAIT_V(6); PG8_BAR; PG8_MMA(1, 1, At, B1); PG8_BAR;
            PG8_LDB(B0, 1, 0); PG8_SCHED; PG8_LDA(At, 1, 0); PG8_STAGE(PG8_SA(0, 1), a2 + hstepA, voffA);
            PG8_WAIT_L(8); PG8_BAR; PG8_WAIT_L(0); PG8_MMA(0, 0, At, B0); PG8_BAR; PG8_SCHED;
            PG8_LDB(B1, 1, 1); PG8_STAGEB(PG8_SB(1, 0), b3);
            PG8_BAR; PG8_WAIT_L(0); PG8_MMA(0, 1, At, B1); PG8_BAR;
            PG8_LDA(At, 1, 1); PG8_STAGE(PG8_SA(1, 0), a3, voffA);
            PG8_BAR; PG8_WAIT_L(0); PG8_MMA(1, 0, At, B0); PG8_BAR; PG8_SCHED;
            PG8_STAGEB(PG8_SB(1, 1), b3 + hstepB);
            PG8_WAIT_V(6); PG8_BAR; PG8_MMA(1, 1, At, B1); PG8_BAR;
            }
        }
        if constexpr (ALIGN_EPI) { if (wr == 0) PG8_BAR; }
        if constexpr (!Epi::AFTER_DRAIN) { E(acc, aux, cur, wr, wc, fr, fq); S.done(cur); }
        if (!has_next) break;
        E.init(acc, nxt, wr, wc, fr, fq);
        cur = nxt; cA = nA; cB = nB; ++ui;
        if constexpr (ALIGN_EPI) { if (wr == 1) PG8_BAR; }
    }
    PG8_WAIT_V(0);
    if constexpr (!ALIGN_EPI) { if (wr == 0) PG8_BAR; }
    PG8_BAR;
    if constexpr (Epi::AFTER_DRAIN) { E.fused(acc, cur, wr, wc, fr, fq, lds, wid, lane); S.done(cur); }
}
template <class Epi, class Sched>
__device__ __forceinline__ void gemm_phase_q(PG8_LAS unsigned char* lds, const Gemm g, const Sched& S, const Epi& E) {
    const int tid = threadIdx.x, wid = __builtin_amdgcn_readfirstlane(tid >> 6), lane = tid & 63, wr = wid >> 2, wc = wid & 3, fr = lane & 15, fq = lane >> 4;
    const int K = g.K, nt = K / BK;
    unsigned voffA[2], voffB[2];
#pragma unroll
    for (int i = 0; i < 2; ++i) { int R, C; stage_rc(tid * 16 + i * 8192, R, C); const int Rb = Epi::PERM ? ((R & ~31) + perm32(R & 31)) : R;
        voffA[i] = (unsigned)(R * K + C) * 2u; voffB[i] = (unsigned)(Rb * K + C) * 2u; }
    const size_t kstep = (size_t)(BK * 2), hstep = (size_t)HALF * K * 2, tstep = 2 * hstep;
    const unsigned ldsw = (unsigned)wid * 1024u;
    const int aoff = lds_byte(wr * 64 + fr, fq * 8), boff = lds_byte(wc * 32 + fr, fq * 8);
    Unit cur;
    if (!S.next(0, cur)) return;
    f32x4 acc[2][2][4][2];
    typename Epi::Aux aux;
    E.init(acc, cur, wr, wc, fr, fq);
    bf16x8 At[4][2], B0[2][2];
    const char* cA = (const char*)g.A + (size_t)cur.pm * tstep + (size_t)cur.hm * hstep; const char* cB = (const char*)g.Bt + (size_t)cur.pn * tstep + (size_t)cur.hb * hstep;
    S.a_ready(cur);
    PG8_STAGEB(PG8_SB(0, 0), cB); PG8_STAGE(PG8_SA(0, 0), cA, voffA);
    PG8_STAGEB(PG8_SB(0, 1), cB + kstep); PG8_STAGE(PG8_SA(0, 1), cA + kstep, voffA);
    PG8_STAGEB(PG8_SB(1, 0), cB + 2 * kstep); PG8_STAGE(PG8_SA(1, 0), cA + 2 * kstep, voffA);
    if (wr == 1) PG8_BAR;
    PG8_WAIT_V(8); PG8_BAR;
    PG8_BAR;
    if constexpr (Epi::INIT_LOADS) {
#pragma unroll
        for (int m = 0; m < 4; ++m) asm volatile("" : "+v"(acc[0][0][m][0]), "+v"(acc[0][0][m][1]));
    }
    E.aux_load(aux, cur, wr, wc, fr, fq);
#define PG8_SPQ(s, kt) do { const int _k = (kt) < nt ? (kt) : (kt) - nt; \
        PG8_LDB(B0, (s) >> 1, (s) & 1); PG8_SCHED; PG8_LDA(At, (s) >> 1, (s) & 1); \
        PG8_STAGE(PG8_SB((((s) + 3) & 3) >> 1, ((s) + 3) & 1), cB + (size_t)_k * kstep, voffB); PG8_STAGE(PG8_SA((((s) + 3) & 3) >> 1, ((s) + 3) & 1), cA + (size_t)_k * kstep, voffA); \
        PG8_WAIT_V(8); PG8_WAIT_L(0); PG8_BAR; PG8_MMA(0, 0, At, B0); PG8_BAR; PG8_SCHED; } while (0)
    for (int t = 0; t < nt; t += 4) { PG8_SPQ(0, t + 3); PG8_SPQ(1, t + 4); PG8_SPQ(2, t + 5); PG8_SPQ(3, t + 6); }
#undef PG8_SPQ
    if (wr == 0) PG8_BAR;
    E(acc, aux, cur, wr, wc, fr, fq); S.done(cur);
    PG8_WAIT_V(0);
    PG8_BAR;
#undef PG8_SA
#undef PG8_SB
#undef PG8_STAGE
#undef PG8_STAGEB
#undef PG8_LDA
#undef PG8_LDB
#undef PG8_MMA
#undef PG8_WAIT_V
#undef PG8_WAIT_V1
#undef PG8_WAIT_VK
#undef PG8_STAGE_B1
#undef PG8_LDB1
#undef PG8_MMA1
#undef PG8_WAIT_L
#undef PG8_BAR
#undef PG8_SCHED
}
}
#ifndef PG8_SP2
#define PG8_SP2 true
#endif
#ifndef PG8_ALIGN
#define PG8_ALIGN true
#endif
namespace mixp {
using pg8::bf16_t; using pg8::bf16x8; using pg8::u32x4; using pg8::u32x2; using pg8::ZP; using pg8::MP; using pg8::MT; using pg8::LOG2E;
typedef float f32x16 __attribute__((ext_vector_type(16)));
typedef short v4i16_t __attribute__((ext_vector_type(4)));
#define MX_LAS __attribute__((address_space(3)))
typedef MX_LAS unsigned char* lptr;
constexpr int KR_OFF = 0, VR_OFF = 49152, OST_OFF = 98304;
constexpr int N_ATT_P = 32 * 3 * 32, N_ATT = N_ATT_P + 32 * 3, N_POOL_P = 32 * 32, N_UNITS = N_ATT + N_POOL_P + 32;
typedef float f32x2_t __attribute__((ext_vector_type(2))); typedef __bf16 bf16x2_t __attribute__((ext_vector_type(2)));
__device__ __forceinline__ unsigned pk_bf16(float lo, float hi) { f32x2_t v = {lo, hi}; bf16x2_t b = __builtin_convertvector(v, bf16x2_t); return __builtin_bit_cast(unsigned, b); }
__device__ __forceinline__ float bf_lo(unsigned w) { return __uint_as_float(w << 16); }
__device__ __forceinline__ float bf_hi(unsigned w) { return __uint_as_float(w & 0xffff0000u); }
__device__ __forceinline__ v4i16_t vtr(lptr p) { return __builtin_amdgcn_ds_read_tr16_b64_v4i16((MX_LAS v4i16_t*)p); }

struct AUnit { bool samp; int b, c, kvh, row0; };
__device__ __forceinline__ AUnit pool_decode(int j) { AUnit u; u.samp = j >= N_POOL_P; u.b = u.samp ? j - N_POOL_P : j >> 5; u.c = u.samp ? 0 : (j & 31); u.kvh = 0; u.row0 = u.samp ? MP + u.b * 64 : u.b * 2048 + 64 * u.c; return u; }
__device__ __forceinline__ void glds16(const void* gsrc, unsigned lds_dst) { unsigned keep;
    asm volatile("s_mov_b32 %0, m0\n\ts_mov_b32 m0, %2\n\ts_nop 0\n\tglobal_load_lds_dwordx4 %1, off\n\ts_mov_b32 m0, %0" : "=&s"(keep) : "v"(gsrc), "s"(lds_dst) : "memory"); }
#define MX_GLDS(src, dst) glds16((src), (unsigned)__builtin_amdgcn_readfirstlane((int)(unsigned)(uintptr_t)(dst)))

__device__ __forceinline__ void attn_issue_chunk(lptr ring, int slot, int j, const bf16_t* Z, const bf16_t* CK, const bf16_t* CV, const AUnit& u, int wid, int lane) {
    const int kkey = 8 * wid + (lane >> 3), kch = (lane & 7) ^ ((lane >> 3) & 7);
    const int vdh = wid >> 2, vkey = 16 * (wid & 3) + (lane >> 2), vch = 4 * vdh + (lane & 3);
    const bf16_t *ks, *vs;
    if (u.samp && j < 2) { const size_t o = (size_t)(u.b * 128 + 64 * j) * 192 + 64 * u.kvh; ks = CK + o + (size_t)kkey * 192 + 8 * kch; vs = CV + o + (size_t)vkey * 192 + 8 * vch; }
    else { const bool valid = u.samp || (u.c - 2 + j >= 0); const int rb = valid ? u.row0 - 128 + 64 * j : u.row0;
        ks = Z + ((size_t)(16 + u.kvh) * MT + rb + kkey) * 64 + 8 * kch; vs = Z + ((size_t)(19 + u.kvh) * MT + rb + vkey) * 64 + 8 * vch; }
    MX_GLDS(ks, ring + KR_OFF + slot * 8192 + wid * 1024);
    MX_GLDS(vs, ring + VR_OFF + slot * 8192 + wid * 1024);
}
__device__ __forceinline__ void attn_qload(bf16x8 (&q)[4], const bf16_t* Z, const AUnit& u, int wid, int lane) {
    const bf16_t* qp = Z + ((size_t)(4 + 4 * u.kvh + (wid >> 1)) * MT + u.row0 + 32 * (wid & 1) + (lane & 31)) * 64 + 8 * (lane >> 5);
#pragma unroll
    for (int ks = 0; ks < 4; ++ks) q[ks] = __builtin_nontemporal_load((const bf16x8*)(qp + 16 * ks));
}
__device__ __forceinline__ void attn_compute(lptr ring, int sl0, int sl1, int sl2, const bf16x8 (&qr)[4], bf16_t* MIX, float sink2, const AUnit& u, int wid, int lane) {
    const int slb[3] = {sl0 * 8192, sl1 * 8192, sl2 * 8192};
    const int r32 = lane & 31, hi = lane >> 5, g = wid >> 1, qh = wid & 1, hq = 4 * u.kvh + g;
    const float slope2 = __builtin_amdgcn_exp2f(-8.0f * (float)(hq + 1) * (1.0f / 12.0f)) * LOG2E;
    const float qb = (float)(32 * qh + r32 + 128 - 4 * hi);
    const float nsq = -slope2 * qb;
    f32x16 p[6];
#pragma unroll
    for (int kb = 0; kb < 6; ++kb) {
        const bool valid = u.samp || (u.c - 2 + (kb >> 1) >= 0);
#pragma unroll
        for (int r = 0; r < 16; ++r) { const float cst = (float)(32 * kb + (r & 3) + 8 * (r >> 2));
            const float bias = kb < 4 ? __builtin_fmaf(slope2, cst, nsq) : -slope2 * __builtin_fabsf(qb - cst);
            p[kb][r] = valid ? bias : -1e30f; }
#pragma unroll
        for (int ks = 0; ks < 4; ++ks) {
            const bf16x8 kf = *(const MX_LAS bf16x8*)(ring + KR_OFF + slb[kb >> 1] + (32 * (kb & 1) + r32) * 128 + (((2 * ks + hi) ^ (r32 & 7)) << 4));
            p[kb] = __builtin_amdgcn_mfma_f32_32x32x16_bf16(kf, qr[ks], p[kb], 0, 0, 0);
        }
    }
    float sum = 0.f;
#pragma unroll
    for (int kb = 0; kb < 6; ++kb)
#pragma unroll
        for (int r = 0; r < 16; ++r) { p[kb][r] = __builtin_amdgcn_exp2f(p[kb][r]); sum += p[kb][r]; }
    sum += __shfl_xor(sum, 32);
    sum += __builtin_amdgcn_exp2f(sink2);
    const float inv = 1.0f / sum;
    f32x16 o[2];
#pragma unroll
    for (int r = 0; r < 16; ++r) { o[0][r] = 0.f; o[1][r] = 0.f; }
    const lptr vb = ring + VR_OFF + ((lane >> 4) & 1) * 32 + (lane & 3) * 8 + (4 * hi + ((lane & 15) >> 2)) * 64;
#pragma unroll
    for (int kb = 0; kb < 6; ++kb)
#pragma unroll
        for (int s = 0; s < 2; ++s) {
            u32x4 pw;
            pw.x = pk_bf16(p[kb][8 * s + 0], p[kb][8 * s + 1]); pw.y = pk_bf16(p[kb][8 * s + 2], p[kb][8 * s + 3]);
            pw.z = pk_bf16(p[kb][8 * s + 4], p[kb][8 * s + 5]); pw.w = pk_bf16(p[kb][8 * s + 6], p[kb][8 * s + 7]);
            const bf16x8 pf = __builtin_bit_cast(bf16x8, pw);
#pragma unroll
            for (int db = 0; db < 2; ++db) {
                const v4i16_t lo = vtr(vb + slb[kb >> 1] + db * 4096 + (32 * (kb & 1) + 16 * s) * 64), hh = vtr(vb + slb[kb >> 1] + db * 4096 + (32 * (kb & 1) + 16 * s + 8) * 64);
                const bf16x8 vf = (bf16x8){lo[0], lo[1], lo[2], lo[3], hh[0], hh[1], hh[2], hh[3]};
                o[db] = __builtin_amdgcn_mfma_f32_32x32x16_bf16(vf, pf, o[db], 0, 0, 0);
            }
        }
    const lptr st = ring + OST_OFF + wid * 4096;
#pragma unroll
    for (int db = 0; db < 2; ++db)
#pragma unroll
        for (int rg = 0; rg < 4; ++rg) { u32x2 w; w.x = pk_bf16(o[db][4 * rg] * inv, o[db][4 * rg + 1] * inv); w.y = pk_bf16(o[db][4 * rg + 2] * inv, o[db][4 * rg + 3] * inv);
            *(MX_LAS u32x2*)(st + r32 * 128 + (((4 * db + rg) ^ (r32 & 7)) << 4) + 8 * hi) = w; }
    asm volatile("s_waitcnt lgkmcnt(0)" ::: "memory");
    bf16_t* op = MIX + ((size_t)(u.row0 >> 8) * 16 + 4 + hq) * (256 * 64);
#pragma unroll
    for (int i = 0; i < 4; ++i) { const int row = 8 * i + (lane >> 3); const u32x4 v = *(const MX_LAS u32x4*)(st + row * 128 + (((lane & 7) ^ (row & 7)) << 4)); *(u32x4*)(op + pg8::img_off((u.row0 & 255) + 32 * qh + row, 8 * (lane & 7))) = v; }
}

__device__ __forceinline__ void pool_issue(lptr buf, const bf16_t* Z, const bf16_t* CP, const bf16_t* ZERO, const AUnit& u, int wid, int lane) {
#pragma unroll
    for (int j = 0; j < 5; ++j) {
        const int p = wid + 8 * j, ri = 2 * p + (lane >> 5), rc = ri > 78 ? 78 : ri, ch = (lane & 31) ^ (ri & 15);
        const bf16_t* src = Z + ((size_t)(ch >> 3) * MT + (u.row0 + rc - 15)) * 64 + 8 * (ch & 7);
        if (ri < 15) { if (u.samp) src = CP + (size_t)(u.b * 15 + ri) * 256 + 8 * ch; else if (u.c == 0) src = ZERO + 8 * (lane & 31); }
        MX_GLDS(src, buf + p * 1024);
    }
}
__device__ __forceinline__ void pool_compute(lptr buf, const bf16x8 (&wf)[2][4], bf16_t* MIX, const AUnit& u, int wid, int lane) {
    const int r32 = lane & 31, hi = lane >> 5;
    const int g = wid >> 1, hh = wid & 1, W = 2 << g, t = 32 * hh + r32;
    const int pos = u.samp ? 4096 + t : 64 * u.c + t;
    const float icnt = 1.0f / (float)((pos + 1 < W) ? pos + 1 : W);
    bf16x8 df[4];
#pragma unroll
    for (int ks = 0; ks < 4; ++ks) {
        const int chunk = 8 * g + 2 * ks + hi;
        float a[8]; u32x4 cur = (u32x4){0u, 0u, 0u, 0u};
#pragma unroll
        for (int e = 0; e < 8; ++e) a[e] = 0.f;
        for (int i = 0; i < W; ++i) {
            const int ri = t + 15 - i;
            const u32x4 v = *(const MX_LAS u32x4*)(buf + ri * 512 + ((chunk ^ (ri & 15)) << 4));
            a[0] += bf_lo(v.x); a[1] += bf_hi(v.x); a[2] += bf_lo(v.y); a[3] += bf_hi(v.y); a[4] += bf_lo(v.z); a[5] += bf_hi(v.z); a[6] += bf_lo(v.w); a[7] += bf_hi(v.w);
            if (i == 0) cur = v;
        }
        u32x4 dw;
        dw.x = pk_bf16(a[0] * icnt - bf_lo(cur.x), a[1] * icnt - bf_hi(cur.x)); dw.y = pk_bf16(a[2] * icnt - bf_lo(cur.y), a[3] * icnt - bf_hi(cur.y));
        dw.z = pk_bf16(a[4] * icnt - bf_lo(cur.z), a[5] * icnt - bf_hi(cur.z)); dw.w = pk_bf16(a[6] * icnt - bf_lo(cur.w), a[7] * icnt - bf_hi(cur.w));
        df[ks] = __builtin_bit_cast(bf16x8, dw);
    }
    bf16_t* op = MIX + ((size_t)(u.row0 >> 8) * 16 + g) * (256 * 64);
#pragma unroll
    for (int eb = 0; eb < 2; ++eb) {
        f32x16 o;
#pragma unroll
        for (int r = 0; r < 16; ++r) o[r] = 0.f;
#pragma unroll
        for (int ks = 0; ks < 4; ++ks) o = __builtin_amdgcn_mfma_f32_32x32x16_bf16(wf[eb][ks], df[ks], o, 0, 0, 0);
#pragma unroll
        for (int rg = 0; rg < 4; ++rg) { u32x2 w; w.x = pk_bf16(o[4 * rg], o[4 * rg + 1]); w.y = pk_bf16(o[4 * rg + 2], o[4 * rg + 3]); *(u32x2*)(op + pg8::img_off((u.row0 & 255) + t, 32 * eb + 8 * rg + 4 * hi)) = w; }
    }
}

#define MX_SYNC() do { asm volatile("s_waitcnt vmcnt(0) lgkmcnt(0)" ::: "memory"); __builtin_amdgcn_s_barrier(); asm volatile("" ::: "memory"); } while (0)
__device__ __forceinline__ void mix_phase(lptr lds, const bf16_t* Z, const bf16_t* CK, const bf16_t* CV, const bf16_t* CP, const bf16_t* WPt, const bf16_t* ZERO, bf16_t* MIX, const float* sinks, int first, int stride) {
    const int tid = threadIdx.x, lane = tid & 63, wid = __builtin_amdgcn_readfirstlane(tid >> 6);
    constexpr int PBUF = 40960;
    constexpr int NRUN_P = 32 * 3 * 8, NRUN = NRUN_P + 32 * 3;
    int par = 0;
    if (first < NRUN) {
        const int g = wid >> 1;
        float sk0 = sinks[g] * LOG2E, sk1 = sinks[4 + g] * LOG2E, sk2 = sinks[8 + g] * LOG2E;
        asm volatile("" : "+v"(sk0), "+v"(sk1), "+v"(sk2));
        int run = first, st = 0, head = 0;
        auto unit_of = [](int run, int st) { AUnit u; u.samp = run >= NRUN_P; const int rr = u.samp ? run : NRUN_P - 1 - run;     const int a = u.samp ? run - NRUN_P : rr >> 3; u.b = a / 3; u.kvh = a % 3; u.c = u.samp ? 0 : 4 * (rr & 7) + st;
                                              u.row0 = u.samp ? MP + u.b * 64 : u.b * 2048 + 64 * u.c; return u; };
        bf16x8 qn[4];
        AUnit u = unit_of(run, 0);
        int s0 = 0, s1 = 1, s2 = 2; head = 3;
        attn_issue_chunk(lds, 0, 0, Z, CK, CV, u, wid, lane); attn_issue_chunk(lds, 1, 1, Z, CK, CV, u, wid, lane); attn_issue_chunk(lds, 2, 2, Z, CK, CV, u, wid, lane);
        attn_qload(qn, Z, u, wid, lane);
        for (;;) {
            MX_SYNC();
            bf16x8 qr[4];
#pragma unroll
            for (int ks = 0; ks < 4; ++ks) qr[ks] = qn[ks];
            asm volatile("" : "+v"(qr[0]), "+v"(qr[1]), "+v"(qr[2]), "+v"(qr[3]));
            int nrun = run, nst = st + 1; const int len = (run >= NRUN_P) ? 1 : 4;
            if (nst == len) { nrun = run + stride; nst = 0; }
            const bool more = nrun < NRUN;
            int n0 = s1, n1 = s2, n2 = head;
            AUnit un = u;
            if (more) {
                un = unit_of(nrun, nst);
                if (nst == 0) { n0 = head; n1 = head + 1 >= 6 ? head - 5 : head + 1; n2 = head + 2 >= 6 ? head - 4 : head + 2;
                    attn_issue_chunk(lds, n0, 0, Z, CK, CV, un, wid, lane); attn_issue_chunk(lds, n1, 1, Z, CK, CV, un, wid, lane); attn_issue_chunk(lds, n2, 2, Z, CK, CV, un, wid, lane);
                    head = head + 3 >= 6 ? head - 3 : head + 3; }
                else { attn_issue_chunk(lds, n2, 2, Z, CK, CV, un, wid, lane); head = head + 1 >= 6 ? 0 : head + 1; }
                attn_qload(qn, Z, un, wid, lane);
            }
            attn_compute(lds, s0, s1, s2, qr, MIX, u.kvh == 0 ? sk0 : (u.kvh == 1 ? sk1 : sk2), u, wid, lane);
            if (!more) break;
            run = nrun; st = nst; u = un; s0 = n0; s1 = n1; s2 = n2;
        }
    }
    MX_SYNC();
    int pj = first >= 96 ? first - 96 : first + stride - 96; par = 0;
    if (pj < N_POOL_P + 32) {
        bf16x8 wf[2][4];
#pragma unroll
        for (int eb = 0; eb < 2; ++eb)
#pragma unroll
            for (int ks = 0; ks < 4; ++ks) wf[eb][ks] = *(const bf16x8*)(WPt + (size_t)(((wid >> 1) * 64 + 32 * eb + (lane & 31)) * 64 + 16 * ks + 8 * (lane >> 5)));
        pool_issue(lds, Z, CP, ZERO, pool_decode(pj), wid, lane);
        for (; pj < N_POOL_P + 32; pj += stride, par ^= 1) {
            const AUnit u = pool_decode(pj);
            MX_SYNC();
            if (pj + stride < N_POOL_P + 32) pool_issue(lds + (par ^ 1) * PBUF, Z, CP, ZERO, pool_decode(pj + stride), wid, lane);
            pool_compute(lds + par * PBUF, wf, MIX, u, wid, lane);
        }
    }
    MX_SYNC();
}
#undef MX_SYNC
#undef MX_GLDS
#undef MX_LAS
}
constexpr int NWAVES = 8;
#ifndef MK_N_LAUNCHES
#define MK_N_LAUNCHES 1
#endif
constexpr int N_LAUNCHES = MK_N_LAUNCHES;
constexpr int PER_PHASE = 6;
#ifndef MK_P5_LAG
#define MK_P5_LAG 900
#endif
constexpr int P5_LAG = MK_P5_LAG;

constexpr size_t MiB = 1u << 20;
constexpr size_t WS_CTL = 0, CTL_ZERO_BYTES = 64 * 1024, WS_ZERO = 512 * 1024, WS_SS = 1 * MiB;
constexpr size_t WS_WIN = 2 * MiB, WS_WOUT = 5 * MiB, WS_WGU = 7 * MiB, WS_WD = 18 * MiB;
constexpr size_t WS_WP = 24 * MiB, WS_CK = 25 * MiB, WS_CV = 27 * MiB, WS_CP = 29 * MiB;
constexpr size_t WS_RX = 30 * MiB;
constexpr size_t WS_XB = 32 * MiB;
constexpr size_t WS_Z = 164 * MiB;
constexpr size_t WS_MIX = 346 * MiB;
constexpr size_t WS_ACT = 478 * MiB;
constexpr size_t WS_HB = 842 * MiB;
constexpr size_t WS_END = 974 * MiB;
static_assert(WS_SS + (size_t)67584 * 4 <= WS_WIN && WS_WD + (size_t)1024 * 2816 * 2 <= WS_WP && WS_XB + (size_t)67584 * 1024 * 2 <= WS_Z && WS_Z + (size_t)67584 * 1408 * 2 <= WS_MIX &&
              WS_MIX + (size_t)67584 * 1024 * 2 <= WS_ACT && WS_ACT + (size_t)67584 * 2816 * 2 <= WS_HB && WS_HB + (size_t)67584 * 1024 * 2 <= WS_END && WS_RX + (size_t)67584 * 4 <= WS_XB, "d_ws map");
constexpr int CW_TMO = 0, CW_CODE = 1;
constexpr int CW_BAR = 4096;
constexpr int RING_OFF = 0, RING_BYTES = 131072;
constexpr int LDSCTL_OFF = RING_BYTES, MISC_OFF = LDSCTL_OFF + 320;
constexpr int STAGE_OFF = LDSCTL_OFF + 1024;
constexpr int JUNK_OFF = STAGE_OFF + 16384;
constexpr int LDS_BYTES = STAGE_OFF + 16384;
static_assert(MISC_OFF + 128 <= LDS_BYTES, "LDS map");

#define GAS __attribute__((address_space(1)))
#define LAS __attribute__((address_space(3)))
typedef unsigned short bf16;
typedef unsigned v4u __attribute__((ext_vector_type(4)));
typedef float f32x4 __attribute__((ext_vector_type(4)));
typedef short bf16x8 __attribute__((ext_vector_type(8)));
typedef GAS unsigned gu32;
typedef GAS unsigned long long gu64;
#define RLX_AGENT __ATOMIC_RELAXED, __HIP_MEMORY_SCOPE_AGENT
#define LDS_WAIT() asm volatile("s_waitcnt lgkmcnt(0)" ::: "memory")
#define VM_WAIT() asm volatile("s_waitcnt vmcnt(0)" ::: "memory")
__device__ __forceinline__ unsigned long long rt() { return __builtin_amdgcn_s_memrealtime(); }
__device__ __forceinline__ unsigned f2bf(float f) { unsigned u = __builtin_bit_cast(unsigned, f); return (u + 0x7fffu + ((u >> 16) & 1u)) >> 16; }
__device__ __forceinline__ unsigned pk2(float lo, float hi) { return f2bf(lo) | (f2bf(hi) << 16); }

#define XB_TMO      128
#define XB_XCNT(j)  (256  + 64 * (j))
#define XB_XSUB(j)  (1280 + 64 * (j))
#define XB_XGEN(j)  (2304 + 64 * (j))
#define XB_TOP      3328
#define XB_TOPGEN   3392
#define XCD_BAR_WORDS 3456
#define XB_SPIN_CAP (1u << 18)

__device__ __forceinline__ unsigned xb_ld(unsigned* p)              { return __hip_atomic_load(p, __ATOMIC_RELAXED, __HIP_MEMORY_SCOPE_AGENT); }
__device__ __forceinline__ unsigned xb_add(unsigned* p, unsigned v) { return __hip_atomic_fetch_add(p, v, __ATOMIC_RELAXED, __HIP_MEMORY_SCOPE_AGENT); }
__device__ __forceinline__ unsigned xb_xcc_id() { return (unsigned)__builtin_amdgcn_s_getreg((3 << 11) | 20) & 0xFu; }
#define XB_SPIN(cond, bar) do { unsigned _sp = 0; while (cond) { __builtin_amdgcn_s_sleep(1); \
    if ((++_sp & 255u) == 0u) { if (xb_ld(&(bar)[XB_TMO])) break; if (_sp > XB_SPIN_CAP) { atomicAdd(&(bar)[XB_TMO], 1u); break; } } } } while (0)

struct XcdBarrier {
    unsigned* bar; unsigned x;
    volatile LAS unsigned* st;
};

__device__ __forceinline__ XcdBarrier xcd_barrier_post(unsigned* bar, volatile LAS unsigned* st) {
    XcdBarrier b; b.bar = bar; b.x = xb_xcc_id(); b.st = st;
    if (threadIdx.x == 0) (void)xb_add(&bar[XB_XCNT(b.x)], 1u);
    return b;
}
__device__ __forceinline__ void xcd_barrier_complete(unsigned* bar, unsigned x, unsigned& nloc, unsigned& nx) {
    const unsigned G = gridDim.x * gridDim.y * gridDim.z;
    unsigned sum, cnt, mine, sp = 0u;
    for (;;) {
        sum = 0u; cnt = 0u; mine = 0u;
#pragma unroll
        for (unsigned j = 0; j < 16; ++j) { const unsigned c = xb_ld(&bar[XB_XCNT(j)]); sum += c; cnt += (c > 0u) ? 1u : 0u; mine = (j == x) ? c : mine; }
        if (sum == G) break;
        __builtin_amdgcn_s_sleep(1);
        if ((++sp & 255u) == 0u) { if (xb_ld(&bar[XB_TMO])) break; if (sp > XB_SPIN_CAP) { atomicAdd(&bar[XB_TMO], 1u); break; } }
    }
    nloc = mine > 0u ? mine : 1u; nx = cnt > 0u ? cnt : 1u;
}

__device__ __forceinline__ void xcd_barrier(const XcdBarrier& b) {
    asm volatile("s_waitcnt vmcnt(0)" ::: "memory");
    __syncthreads();
    if (threadIdx.x == 0) {
        unsigned* bar = b.bar;
        __builtin_amdgcn_s_waitcnt(0);
        unsigned nloc = b.st[0], nx = b.st[1];
        if (nloc == 0u) { xcd_barrier_complete(bar, b.x, nloc, nx); b.st[0] = nloc; b.st[1] = nx; }
        const unsigned old = xb_add(&bar[XB_XSUB(b.x)], 1u);
        const unsigned gen = old / nloc;
        if (old + 1u == (gen + 1u) * nloc) {
            __builtin_amdgcn_fence(__ATOMIC_RELEASE, "agent");
            asm volatile("s_waitcnt vmcnt(0)" ::: "memory");
            const unsigned og = xb_add(&bar[XB_TOP], 1u);
            const unsigned tg = og / nx;
            if (og + 1u == (tg + 1u) * nx) xb_add(&bar[XB_TOPGEN], 1u);
            else XB_SPIN(xb_ld(&bar[XB_TOPGEN]) == tg, bar);
            __builtin_amdgcn_fence(__ATOMIC_ACQUIRE, "agent");
            xb_add(&bar[XB_XGEN(b.x)], 1u);
            asm volatile("s_waitcnt vmcnt(0)" ::: "memory");
        } else {
            XB_SPIN(xb_ld(&bar[XB_XGEN(b.x)]) == gen, bar);
            __builtin_amdgcn_fence(__ATOMIC_ACQUIRE, "agent");
            asm volatile("s_waitcnt vmcnt(0)" ::: "memory");
        }
    }
    __syncthreads();
}
struct Frame {
    LAS unsigned char* lds;
    volatile LAS unsigned* MISC;
    gu32* ctl;
    int tid, lane, wave;
    int vcu, G;
};

__device__ __forceinline__ float wave_sum(float v) {
#pragma unroll
    for (int o = 1; o < 64; o <<= 1) v += __shfl_xor(v, o);
    return v;
}
__device__ __forceinline__ void p0_transpose_item(const float* W, const float* gain, int K, int N, bf16* WT, int k0, int n0, int drow0, LAS float* scr, int lane) {
#pragma unroll 8
    for (int i = 0; i < 32; ++i) { const int kk = 2 * i + (lane >> 5); float w = __builtin_nontemporal_load(W + (size_t)(k0 + kk) * N + n0 + (lane & 31)); if (gain) w *= gain[k0 + kk]; scr[kk * 33 + (lane & 31)] = w; }
    LDS_WAIT(); asm volatile("" ::: "memory");
    const int c = lane & 7;
#pragma unroll
    for (int j = 0; j < 4; ++j) { const int n = (lane >> 3) + 8 * j; const LAS float* s = scr + (8 * c) * 33 + n;
        v4u o; o.x = pk2(s[0 * 33], s[1 * 33]); o.y = pk2(s[2 * 33], s[3 * 33]); o.z = pk2(s[4 * 33], s[5 * 33]); o.w = pk2(s[6 * 33], s[7 * 33]);
        const int row = drow0 + n, wr7 = row & 127, slot = (wr7 & ~31) + pg8::inv_perm32(wr7 & 31);
        *(GAS v4u*)((GAS char*)WT + ((size_t)((row >> 8) * (K >> 6) + (k0 >> 6)) * 2 + ((row >> 7) & 1)) * pg8::HTB + pg8::lds_byte(slot, 8 * c)) = o; }
    LDS_WAIT(); asm volatile("" ::: "memory");
}
__device__ __forceinline__ void x_rows2_to_bf16(const float* xa, const float* xb, bf16* oa, bf16* ob, float* ra, float* rb, int lane) {
    const GAS f32x4* pa = (const GAS f32x4*)xa + lane; const GAS f32x4* pb = (const GAS f32x4*)xb + lane;
    f32x4 va[4], vb[4]; float sa = 0.f, sb = 0.f;
#pragma unroll
    for (int j = 0; j < 4; ++j) { va[j] = __builtin_nontemporal_load(pa + 64 * j); vb[j] = __builtin_nontemporal_load(pb + 64 * j); }
#pragma unroll
    for (int j = 0; j < 4; ++j) { sa += (va[j].x * va[j].x + va[j].y * va[j].y) + (va[j].z * va[j].z + va[j].w * va[j].w); sb += (vb[j].x * vb[j].x + vb[j].y * vb[j].y) + (vb[j].z * vb[j].z + vb[j].w * vb[j].w); }
    GAS unsigned long long* qa = (GAS unsigned long long*)oa + lane; GAS unsigned long long* qb = (GAS unsigned long long*)ob + lane;
#pragma unroll
    for (int j = 0; j < 4; ++j) { qa[64 * j] = (unsigned long long)pk2(va[j].x, va[j].y) | ((unsigned long long)pk2(va[j].z, va[j].w) << 32);
                                  qb[64 * j] = (unsigned long long)pk2(vb[j].x, vb[j].y) | ((unsigned long long)pk2(vb[j].z, vb[j].w) << 32); }
    const float r1 = 1.f / sqrtf(wave_sum(sa) * (1.f / 1024.f) + 1e-6f), r2 = 1.f / sqrtf(wave_sum(sb) * (1.f / 1024.f) + 1e-6f);
    if (lane == 0) { *ra = r1; *rb = r2; }
}
struct P0Args { const float *xp, *xs, *cpool, *ck, *cv, *norm_mix, *w_in, *w_pool, *pool_scale, *w_out, *norm_ffn, *w_gate, *w_up, *w_down; float* out;
                bf16 *Win_t, *Wout_t, *Wgu_t, *Wd_t, *WPt, *CK, *CV, *CP, *XB; float* RX; float* SS; float* ZERO; };
__device__ __forceinline__ void p0_prologue(Frame& F, const P0Args& A) {
    LAS float* scr = (LAS float*)(F.lds + RING_OFF + F.wave * 16384);
    const int gw = F.vcu * NWAVES + F.wave, NGW = F.G * NWAVES;
    constexpr int I_IN = 16 * 44, I_OUT = 16 * 32, I_G = 16 * 88, I_D = 44 * 32, NITEMS = I_IN + I_OUT + 2 * I_G + I_D;
    for (int it = gw; it < NITEMS; it += NGW) {
        int r = it;
        if (r < I_IN) { const int kb = r / 44, nb = r % 44, n0 = 32 * nb, lc = n0 & 255, dd = lc & 63;
            p0_transpose_item(A.w_in, A.norm_mix, 1024, 1408, A.Win_t, 64 * kb, n0, n0 >= 1280 ? n0 : (n0 & ~255) + 128 * (dd >> 5) + 32 * (lc >> 6), scr, F.lane); continue; } r -= I_IN;
        if (r < I_OUT) { const int kb = r / 32, nb = r % 32; p0_transpose_item(A.w_out, nullptr, 1024, 1024, A.Wout_t, 64 * kb, 32 * nb, 32 * nb, scr, F.lane); continue; } r -= I_OUT;
        if (r < I_G) { const int kb = r / 88, nb = r % 88, n0 = 32 * nb;
            p0_transpose_item(A.w_gate, A.norm_ffn, 1024, 2816, A.Wgu_t, 64 * kb, n0, 256 * (n0 >> 7) + (n0 & 127), scr, F.lane); continue; } r -= I_G;
        if (r < I_G) { const int kb = r / 88, nb = r % 88, n0 = 32 * nb;
            p0_transpose_item(A.w_up, A.norm_ffn, 1024, 2816, A.Wgu_t, 64 * kb, n0, 256 * (n0 >> 7) + 128 + (n0 & 127), scr, F.lane); continue; } r -= I_G;
        { const int kb = r / 32, nb = r % 32; p0_transpose_item(A.w_down, nullptr, 2816, 1024, A.Wd_t, 64 * kb, 32 * nb, 32 * nb, scr, F.lane); }
    }
    for (int m = gw; m < pg8::MT / 2; m += NGW) { const int m2 = m + pg8::MT / 2;
        x_rows2_to_bf16(A.xp + (size_t)m * 1024, m2 < pg8::MP ? A.xp + (size_t)m2 * 1024 : A.xs + (size_t)(m2 - pg8::MP) * 1024, A.XB + (size_t)m * 1024, A.XB + (size_t)m2 * 1024, A.RX + m, A.RX + m2, F.lane); }
    const int gt = gw * 64 + F.lane, NGT = NGW * 64;
    for (int i = gt; i < 4 * 64 * 64; i += NGT) { const int g = i >> 12, e = (i >> 6) & 63, c = i & 63;
        A.WPt[i] = (bf16)f2bf(A.w_pool[(g * 64 + c) * 64 + e] * A.pool_scale[64 * g + e]); }
    for (int i = gt; i < 32 * 128 * 192 / 4; i += NGT) {
        const f32x4 k4 = ((const GAS f32x4*)A.ck)[i], v4 = ((const GAS f32x4*)A.cv)[i];
        ((GAS unsigned long long*)A.CK)[i] = (unsigned long long)pk2(k4.x, k4.y) | ((unsigned long long)pk2(k4.z, k4.w) << 32);
        ((GAS unsigned long long*)A.CV)[i] = (unsigned long long)pk2(v4.x, v4.y) | ((unsigned long long)pk2(v4.z, v4.w) << 32);
        const int b = i / (128 * 48), rr = (i / 48) & 127, q = i % 48;
        if (rr >= 64) { const size_t o = ((size_t)(b * 128 + rr - 64) * 192) / 4 + q; ((GAS f32x4*)(A.out + pg8::O_K_S))[o] = k4; ((GAS f32x4*)(A.out + pg8::O_V_S))[o] = v4; }
    }
    for (int i = gt; i < 67584 / 4; i += NGT) ((GAS f32x4*)A.SS)[i] = (f32x4){0.f, 0.f, 0.f, 0.f};
    if (gt < 64) ((GAS f32x4*)A.ZERO)[gt] = (f32x4){0.f, 0.f, 0.f, 0.f};
    for (int i = gt; i < 32 * 15 * 256 / 4; i += NGT) { const f32x4 p4 = ((const GAS f32x4*)A.cpool)[i]; ((GAS unsigned long long*)A.CP)[i] = (unsigned long long)pk2(p4.x, p4.y) | ((unsigned long long)pk2(p4.z, p4.w) << 32); }
}

struct Args { const float* in[17]; float* out; unsigned char* ws; int ph_lo, ph_hi, li, pad; };
__global__ void __launch_bounds__(NWAVES * 64, 2) mk_fwd(Args args) {
    extern __shared__ __attribute__((aligned(16))) unsigned char lds[];
    Frame F;
    F.lds = (LAS unsigned char*)lds;
    F.MISC = (volatile LAS unsigned*)(F.lds + MISC_OFF);
    F.tid = threadIdx.x; F.lane = F.tid & 63; F.wave = __builtin_amdgcn_readfirstlane(F.tid >> 6);
    F.G = gridDim.x; { const int bx = blockIdx.x; F.vcu = (F.G % 8 == 0) ? (bx % 8) * (F.G / 8) + bx / 8 : bx; }
#define GRID_BAR(seam) do { if (N_LAUNCHES == PER_PHASE) { if (F.tid == 0) __hip_atomic_store(F.ctl + CW_TMO, 0xBADBA0u | (unsigned)(seam), RLX_AGENT); } \
    else { xcd_barrier(bar); } } while (0)
    unsigned char* ws = args.ws;
    F.ctl = (gu32*)(ws + WS_CTL);
    float* const out = args.out;
    bf16* const Win_t = (bf16*)(ws + WS_WIN); bf16* const Wout_t = (bf16*)(ws + WS_WOUT); bf16* const Wgu_t = (bf16*)(ws + WS_WGU); bf16* const Wd_t = (bf16*)(ws + WS_WD);
    bf16* const WPt = (bf16*)(ws + WS_WP); bf16* const CKb = (bf16*)(ws + WS_CK); bf16* const CVb = (bf16*)(ws + WS_CV); bf16* const CPb = (bf16*)(ws + WS_CP);
    bf16* const XB = (bf16*)(ws + WS_XB); bf16* const HB = (bf16*)(ws + WS_HB); bf16* const Z = (bf16*)(ws + WS_Z); bf16* const MIX = (bf16*)(ws + WS_MIX); bf16* const ACT = (bf16*)(ws + WS_ACT);
    float* const SS = (float*)(ws + WS_SS); float* const RX = (float*)(ws + WS_RX);
    for (int u = F.tid; u < (LDS_BYTES - LDSCTL_OFF) / 4; u += NWAVES * 64) ((LAS unsigned*)(F.lds + LDSCTL_OFF))[u] = 0u;
    __syncthreads();
    const int bli = (N_LAUNCHES == PER_PHASE) ? 0 : args.li;
    XcdBarrier bar; bar.bar = (unsigned*)(F.ctl + CW_BAR) + bli * XCD_BAR_WORDS; bar.x = 0; bar.st = nullptr;
    if (N_LAUNCHES != PER_PHASE)
        bar = xcd_barrier_post((unsigned*)(F.ctl + CW_BAR) + bli * XCD_BAR_WORDS, F.MISC + 8);

    const int lo = args.ph_lo, hi = args.ph_hi;
#define IN(k) (lo <= (k) && (k) < hi)
#define BOTH(k) (IN(k) && IN((k) + 1))

    if (IN(0)) {
        P0Args A{args.in[0], args.in[1], args.in[2], args.in[3], args.in[4], args.in[5], args.in[6], args.in[7], args.in[8], args.in[12], args.in[13], args.in[14], args.in[15], args.in[16], out,
                 Win_t, Wout_t, Wgu_t, Wd_t, WPt, CKb, CVb, CPb, XB, RX, SS, (float*)(ws + WS_ZERO)};
        p0_prologue(F, A);
        if (BOTH(0)) GRID_BAR(0);
    }
    if (IN(1)) {
        pg8::Gemm g{XB, Win_t, pg8::MT, 1536, 1024};
        pg8::StaticOrder S; S.init(pg8::MT, 1280, F.G, (int)blockIdx.x);
        { pg8::BalancedFullOrder Sb; Sb.init(pg8::MT, 1280, F.G, (int)blockIdx.x); pg8::EpiZ E{Z, args.in[9], args.in[10], out, RX};
          pg8::gemm_phase<pg8::EpiZ, pg8::BalancedFullOrder, PG8_ALIGN, PG8_SP2>(F.lds + RING_OFF, g, Sb, E); }
        { pg8::BalancedHalfOrder T{5, 0, (int)blockIdx.x, F.G, S.nM, S.nwg % F.G}; pg8::EpiZv E{Z, out, RX};
          pg8::gemm_phase<pg8::EpiZv, pg8::BalancedHalfOrder, PG8_ALIGN, PG8_SP2, true>(F.lds + RING_OFF, g, T, E); }
        if (BOTH(1)) GRID_BAR(1);
    }
    if (IN(2)) {
        mixp::mix_phase(F.lds + RING_OFF, Z, CKb, CVb, CPb, WPt, (const bf16*)(ws + WS_ZERO), MIX, args.in[11], (int)blockIdx.x, F.G);
        if (BOTH(2)) GRID_BAR(2);
    }
    if (IN(3)) {
        pg8::Gemm g{MIX, Wout_t, pg8::MT, 1024, 1024}; pg8::StaticOrder S; S.init(pg8::MT, 1024, F.G, (int)blockIdx.x);
        const int full = (S.nwg / F.G) * F.G;
        { pg8::StaticOrder Sa = S; Sa.hi = full; pg8::EpiH<false> E{XB, HB, SS};
          pg8::gemm_phase<pg8::EpiH<false>, pg8::StaticOrder, PG8_ALIGN, PG8_SP2>(F.lds + RING_OFF, g, Sa, E); }
        { pg8::TailHalfOrder T{S, full, (int)blockIdx.x}; pg8::EpiH<true> E{XB, HB, SS};
          pg8::gemm_phase<pg8::EpiH<true>, pg8::TailHalfOrder, PG8_ALIGN, PG8_SP2, true>(F.lds + RING_OFF, g, T, E); }
        if (BOTH(3)) GRID_BAR(3);
    }
    if (IN(4)) {
        pg8::Gemm g{HB, Wgu_t, pg8::MT, 5632, 1024}; pg8::StaticOrder S; S.init(pg8::MT, 5632, F.G, (int)blockIdx.x);
        S.rev = 1;
        pg8::EpiAct E{SS, ACT, F.lds + STAGE_OFF};
        pg8::gemm_phase<pg8::EpiAct, pg8::StaticOrder, PG8_ALIGN, PG8_SP2>(F.lds + RING_OFF, g, S, E);
        if (BOTH(4)) GRID_BAR(4);
    }
    if (IN(5)) {
        pg8::Gemm g{ACT, Wd_t, pg8::MT, 1024, 2816}; pg8::StaticOrder S; S.init(pg8::MT, 1024, F.G, (int)blockIdx.x);
        const int full = (S.nwg / F.G) * F.G;
        { pg8::StaticOrder Sa = S; Sa.hi = full; pg8::EpiY<false> E{HB, out, F.lds + STAGE_OFF};
          pg8::gemm_phase<pg8::EpiY<false>, pg8::StaticOrder, PG8_ALIGN, PG8_SP2>(F.lds + RING_OFF, g, Sa, E); }
        { pg8::TailHalfOrder T{S, full, (int)blockIdx.x}; pg8::EpiY<true> E{HB, out, F.lds + STAGE_OFF};
          pg8::gemm_phase<pg8::EpiY<true>, pg8::TailHalfOrder, PG8_ALIGN, PG8_SP2, true>(F.lds + RING_OFF, g, T, E); }
    }
#undef IN
#undef BOTH
}

extern "C" void kernel_launch(void* const* d_in, const int* in_sizes, int n_in, void* d_out, int out_size, void* d_ws, size_t ws_size, hipStream_t stream) {
    static int grid = 0;
    if (grid == 0) {
        if (n_in != 17 || in_sizes[0] != 65536 * 1024 || out_size != (int)pg8::O_END || ws_size < WS_END) { fprintf(stderr, "kernel_launch: shape mismatch: n_in %d, in0 %d, out %d, ws %zu (need >= %zu); nothing launched\n", n_in, n_in > 0 ? in_sizes[0] : -1, out_size, ws_size, (size_t)WS_END); grid = -1; return; }
        int dev = 0, cus = 0, per_cu = 0;
        if (hipGetDevice(&dev) != hipSuccess || hipDeviceGetAttribute(&cus, hipDeviceAttributeMultiprocessorCount, dev) != hipSuccess) { fprintf(stderr, "kernel_launch: hipGetDevice / hipDeviceGetAttribute failed; nothing launched\n"); grid = -1; return; }
        if (hipFuncSetAttribute((const void*)mk_fwd, hipFuncAttributeMaxDynamicSharedMemorySize, LDS_BYTES) != hipSuccess) { fprintf(stderr, "kernel_launch: hipFuncSetAttribute failed; nothing launched\n"); grid = -1; return; }
        if (hipOccupancyMaxActiveBlocksPerMultiprocessor(&per_cu, (const void*)mk_fwd, NWAVES * 64, LDS_BYTES) != hipSuccess || per_cu < 1)
            fprintf(stderr, "kernel_launch: note: the occupancy query reports %d workgroups per CU\n", per_cu);
        (void)hipGetLastError();
        grid = cus;
    }
    if (grid < 0) return;
    if (hipMemsetAsync((char*)d_ws + WS_CTL, 0, CTL_ZERO_BYTES, stream) != hipSuccess) { fprintf(stderr, "kernel_launch: hipMemsetAsync of the control words failed; nothing launched\n"); return; }
    Args a{};
    for (int i = 0; i < 17; ++i) a.in[i] = (const float*)d_in[i];
    a.out = (float*)d_out; a.ws = (unsigned char*)d_ws;
    static_assert(((N_LAUNCHES >= 1 && N_LAUNCHES <= 3) || N_LAUNCHES == PER_PHASE) && (CW_BAR + 3 * XCD_BAR_WORDS) * 4 <= (int)CTL_ZERO_BYTES, "-DMK_N_LAUNCHES must be 1, 2, 3 or 6");
    const int cuts3[4] = {0, N_LAUNCHES == 3 ? 1 : (N_LAUNCHES == 2 ? 4 : PER_PHASE), N_LAUNCHES == 3 ? 4 : PER_PHASE, PER_PHASE};
    for (int li = 0; li < N_LAUNCHES; ++li) {
        a.ph_lo = (N_LAUNCHES == PER_PHASE) ? li : cuts3[li]; a.ph_hi = (N_LAUNCHES == PER_PHASE) ? li + 1 : cuts3[li + 1]; a.li = li;
        hipLaunchKernelGGL(mk_fwd, dim3(grid), dim3(NWAVES * 64), LDS_BYTES, stream, a);
        const hipError_t le = hipPeekAtLastError();
        if (le != hipSuccess) { fprintf(stderr, "kernel_launch: launch %d failed: %s (grid %d x %d threads, %d B LDS)\n", li, hipGetErrorName(le), grid, NWAVES * 64, LDS_BYTES); break; }
    }
}
```

```cpp
#include <hip/hip_runtime.h>
#include <cstdio>
#include <cstdint>
namespace pg8 {
#define PG8_LAS __attribute__((address_space(3)))
typedef unsigned short bf16_t;
typedef short bf16x8 __attribute__((ext_vector_type(8)));
typedef float f32x4 __attribute__((ext_vector_type(4)));
typedef unsigned u32x4 __attribute__((ext_vector_type(4)));
constexpr int BM = 256, BK = 64, HALF = 128, HTB = HALF * BK * 2  , STAGE_BYTES = 8 * HTB, NXCD = 8, WGM = 8;

__host__ __device__ __forceinline__ int lds_byte(int r, int c) { const int st = (r >> 4) * 2 + (c >> 5), rr = r & 15, cc = c & 31, ob = rr * 64 + cc * 2; return st * 1024 + (ob ^ (((ob >> 9) & 1) << 5)); }
__host__ __device__ __forceinline__ int img_off(int r, int c) { return ((r >> 7) * HTB + lds_byte(r & 127, c)) >> 1; }
__host__ __device__ __forceinline__ void stage_rc(int b, int& R, int& C) { const int st = b / 1024, sb = b % 1024, swz = sb ^ (((sb >> 9) & 1) << 5); R = (st >> 1) * 16 + swz / 64; C = (st & 1) * 32 + (swz % 64) / 2; }
__host__ __device__ __forceinline__ int inv_perm32(int x) { return 16 * ((x >> 2) & 1) + 4 * (x >> 3) + (x & 3); }
__host__ __device__ __forceinline__ int perm32(int rho) { const int n = rho >> 4, i = rho & 15; return 8 * (i >> 2) + 4 * n + (i & 3); }

struct Unit { int pm, pn, hb, hm; };
struct Gemm { const bf16_t* A; const bf16_t* Bt; int M, N, K; };

struct StaticOrder {
    int nM, nN, nwg, G, c, lo, hi, rev, wgm;
    __host__ __device__ void init(int M, int N, int G_, int c_) { nM = M / BM; nN = N / BM; nwg = nM * nN; G = G_; c = c_; lo = 0; hi = nwg; rev = 0; wgm = WGM; }
    __host__ __device__ bool next(int i, Unit& u) const {
        const long L = (long)lo + (long)i * G + c; if (L >= hi) return false;
        int wgid = (int)L; { const int q = nwg / NXCD, r = nwg % NXCD, xcd = wgid % NXCD, off = wgid / NXCD; wgid = (xcd < r ? xcd * (q + 1) : r * (q + 1) + (xcd - r) * q) + off; }
        const int nig = wgm * nN, gid = wgid / nig, fm = gid * wgm, gsz = (nM - fm) < wgm ? (nM - fm) : wgm;
        u.pm = fm + ((wgid % nig) % gsz); u.pn = (wgid % nig) / gsz; u.hb = 0; u.hm = 0; if (rev) u.pm = nM - 1 - u.pm; return true;
    }
    __host__ __device__ void tile_of(int L, Unit& u) const { StaticOrder t = *this; t.lo = L; t.hi = L + 1; t.c = 0; (void)t.next(0, u); }
    __device__ __forceinline__ void a_ready(const Unit&) const {}
    __device__ __forceinline__ void done(const Unit&) const {}
};
struct BalancedFullOrder : StaticOrder {
    __host__ __device__ bool next(int i, Unit& u) const {
        if (G != 256 || nwg != 1320) return StaticOrder::next(i, u);
        int L; if (i < 4) L = i * G + c; else if (i == 4 && c < 208) L = 4 * G + c; else if (i == 5 && c < 88) L = 4 * G + 208 + c; else return false;
        StaticOrder t = *this; t.lo = L; t.hi = L + 1; t.c = 0; return t.StaticOrder::next(0, u);
    }
};
struct BalancedHalfOrder {
    int pn, hb, c, G, nM, busy;
    __host__ __device__ bool next(int i, Unit& u) const { int j;
        if (G != 256 || nM != 264) { if (c < busy) return false; j = (c - busy) + (G - busy) * i; if (j >= nM) return false; u.pm = j; u.pn = pn; u.hb = hb; u.hm = 0; return true; }
        if (c < 88) return false; if (c < 208) { if (i > 0) return false; j = c - 88; } else { if (i > 2) return false; j = 120 + 3 * (c - 208) + i; }
        u.pm = j; u.pn = pn; u.hb = hb; u.hm = 0; return true; }
    __device__ __forceinline__ void a_ready(const Unit&) const {}
    __device__ __forceinline__ void done(const Unit&) const {}
};
struct TailHalfOrder {
    StaticOrder S; int lo, c;
    __host__ __device__ bool next(int i, Unit& u) const { if (i > 0) return false; const int L = lo + (c >> 1); if (L >= S.nwg) return false; S.tile_of(L, u); u.hb = c & 1; return true; }
    __device__ __forceinline__ void a_ready(const Unit&) const {}
    __device__ __forceinline__ void done(const Unit&) const {}
};
struct TailQuarterOrder {
    StaticOrder S; int lo, c;
    __host__ __device__ bool next(int i, Unit& u) const { if (i > 0) return false; const int L = lo + (c >> 2); if (L >= S.nwg) return false; S.tile_of(L, u); u.hb = c & 1; u.hm = (c >> 1) & 1; return true; }
    __device__ __forceinline__ void a_ready(const Unit&) const {}
    __device__ __forceinline__ void done(const Unit&) const {}
};
typedef float f32x2 __attribute__((ext_vector_type(2))); typedef __bf16 bf16x2_t __attribute__((ext_vector_type(2)));
__device__ __forceinline__ unsigned cvt_pk_bf16(float lo, float hi) { f32x2 v = {lo, hi}; bf16x2_t b = __builtin_convertvector(v, bf16x2_t); return __builtin_bit_cast(unsigned, b); }
typedef unsigned u32x2 __attribute__((ext_vector_type(2)));
constexpr float LOG2E = 1.4426950408889634f;
constexpr float C2 = 0.125f * LOG2E;
constexpr float EPS = 1e-6f;
constexpr int HALF_COLS = 128;
constexpr int DM = 1024, ZP = 1408, FF = 2816;
constexpr int MP = 65536, MS = 2048, MT = MP + MS;
constexpr size_t O_POOL_P = 69206016, O_K_P = 69328896, O_V_P = 70115328, O_POOL_S = 70901760, O_K_S = 71024640, O_V_S = 71811072, O_END = 72597504;

__device__ __forceinline__ void acc_zero(f32x4 (&acc)[2][2][4][2]) {
#pragma unroll
    for (int a = 0; a < 2; ++a)
#pragma unroll
        for (int b = 0; b < 2; ++b)
#pragma unroll
            for (int m = 0; m < 4; ++m)
#pragma unroll
                for (int n = 0; n < 2; ++n) acc[a][b][m][n] = (f32x4){0.f, 0.f, 0.f, 0.f};
}
__device__ __forceinline__ float bf_lo(unsigned w) { return __uint_as_float(w << 16); }
__device__ __forceinline__ float bf_hi(unsigned w) { return __uint_as_float(w & 0xffff0000u); }
template <bool HN = false, bool HM = false, bool BLK = false>
__device__ __forceinline__ void acc_from_bf16(f32x4 (&acc)[2][2][4][2], const bf16_t* R, const Unit& u, int wr, int wc, int fr, int fq) {
    const int r0 = (HM ? u.hm * HALF : 0) + wr * 64 + fr, c0 = u.pn * BM + (HN ? u.hb * HALF_COLS : 0) + wc * 32 + 8 * fq;
    const bf16_t* rp = BLK ? R + (size_t)u.pm * (1024 / BK) * (BM * BK) : R + ((size_t)u.pm * BM + r0) * 1024 + c0;
#pragma unroll
    for (int ai = 0; ai < (HM ? 1 : 2); ++ai)
#pragma unroll
        for (int m = 0; m < 4; ++m)
#pragma unroll
            for (int bj = 0; bj < (HN ? 1 : 2); ++bj) { const int c = c0 + bj * HALF;
                const u32x4 w = BLK ? *(const u32x4*)(rp + (size_t)(c >> 6) * (BM * BK) + img_off(r0 + ai * HALF + m * 16, c & 63)) : *(const u32x4*)(rp + (size_t)(ai * HALF + m * 16) * 1024 + bj * HALF);
                acc[ai][bj][m][0] = (f32x4){bf_lo(w.x), bf_hi(w.x), bf_lo(w.y), bf_hi(w.y)}; acc[ai][bj][m][1] = (f32x4){bf_lo(w.z), bf_hi(w.z), bf_lo(w.w), bf_hi(w.w)}; }
}

struct EpiZ {
    static constexpr bool PERM = true, AFTER_DRAIN = false, INIT_LOADS = false; static constexpr int RELAX = 0, B_AUX = 0, A_BLK = 1;
    bf16_t* Z; const float* qn; const float* kn; float* out; const float* RX;
    struct Aux {};
    __device__ __forceinline__ void init(f32x4 (&acc)[2][2][4][2], const Unit&, int, int, int, int) const { acc_zero(acc); }
    __device__ __forceinline__ void aux_load(Aux&, const Unit&, int, int, int, int) const {}
    __device__ __forceinline__ void operator()(const f32x4 (&acc)[2][2][4][2], const Aux&, const Unit& u, int wr, int wc, int fr, int fq) const {
        const int zcol = u.pn * 256 + wc * 64;
        if (zcol >= ZP) return;
        const int kind = (zcol >= 256 && zcol < 1024) ? 1 : ((zcol >= 1024 && zcol < 1216) ? 2 : 0);
        f32x4 sc[2][2];
#pragma unroll
        for (int bj = 0; bj < 2; ++bj)
#pragma unroll
            for (int n = 0; n < 2; ++n) {
                if (kind == 1) sc[bj][n] = *(const f32x4*)(qn + 32 * bj + 8 * fq + 4 * n) * C2;
                else if (kind == 2) sc[bj][n] = *(const f32x4*)(kn + 32 * bj + 8 * fq + 4 * n);
                else sc[bj][n] = (f32x4){1.f, 1.f, 1.f, 1.f};
            }
        const bool samp = u.pm >= 256;
        const int cm = (!samp && (u.pm & 7) != 7) ? 0 : (zcol < 256 ? 1 : (zcol >= 1216 ? 3 : (zcol >= 1024 ? 2 : 0)));
        const int rowbase = u.pm * BM + wr * 64 + fr;
#pragma unroll
        for (int ai = 0; ai < 2; ++ai)
#pragma unroll
            for (int m = 0; m < 4; ++m) {
                const int row = rowbase + ai * HALF + m * 16;
                const float rx = RX[row];
                float rs = rx;
                if (kind) {
                    float ss = 0.f;
#pragma unroll
                    for (int bj = 0; bj < 2; ++bj)
#pragma unroll
                        for (int n = 0; n < 2; ++n) { const f32x4 x = acc[ai][bj][m][n]; ss += (x[0] * x[0] + x[1] * x[1]) + (x[2] * x[2] + x[3] * x[3]); }
                    ss += __shfl_xor(ss, 16); ss += __shfl_xor(ss, 32);
                    rs = rx / sqrtf(ss * (rx * rx) * (1.0f / 64.0f) + EPS);
                }
                f32x4 v[2][2];
#pragma unroll
                for (int bj = 0; bj < 2; ++bj)
#pragma unroll
                    for (int n = 0; n < 2; ++n) v[bj][n] = acc[ai][bj][m][n] * rs * sc[bj][n];
                bf16_t* zp = Z + ((size_t)(zcol >> 6) * MT + row) * 64 + 8 * fq;
#pragma unroll
                for (int bj = 0; bj < 2; ++bj) { u32x4 w; w.x = cvt_pk_bf16(v[bj][0][0], v[bj][0][1]); w.y = cvt_pk_bf16(v[bj][0][2], v[bj][0][3]); w.z = cvt_pk_bf16(v[bj][1][0], v[bj][1][1]); w.w = cvt_pk_bf16(v[bj][1][2], v[bj][1][3]);
                    *(u32x4*)(zp + 32 * bj) = w; }
                if (cm) {
                    int b, t, T; if (samp) { const int r2 = row - MP; b = r2 >> 6; t = r2 & 63; T = 64; } else { b = row >> 11; t = row & 2047; T = 2048; }
                    float* dst = nullptr;
                    if (cm == 1) { const int i = t - (T - 15); if (i >= 0) dst = out + (samp ? O_POOL_S : O_POOL_P) + ((size_t)(b * 15 + i) * 256 + zcol); }
                    else { const int i = samp ? 64 + t : t - (T - 128); if (i >= 0) dst = out + (cm == 2 ? (samp ? O_K_S : O_K_P) : (samp ? O_V_S : O_V_P)) + ((size_t)(b * 128 + i) * 192 + (zcol - (cm == 2 ? 1024 : 1216))); }
                    if (dst) {
#pragma unroll
                        for (int bj = 0; bj < 2; ++bj)
#pragma unroll
                            for (int n = 0; n < 2; ++n) *(f32x4*)(dst + 32 * bj + 8 * fq + 4 * n) = v[bj][n];
                    }
                }
            }
    }
};

struct EpiZv {
    static constexpr bool PERM = true, AFTER_DRAIN = false, INIT_LOADS = false; static constexpr int RELAX = 0, B_AUX = 0, A_BLK = 1;
    bf16_t* Z; float* out; const float* RX;
    struct Aux {};
    __device__ __forceinline__ void init(f32x4 (&acc)[2][2][4][2], const Unit&, int, int, int, int) const { acc_zero(acc); }
    __device__ __forceinline__ void aux_load(Aux&, const Unit&, int, int, int, int) const {}
    __device__ __forceinline__ void operator()(const f32x4 (&acc)[2][2][4][2], const Aux&, const Unit& u, int wr, int wc, int fr, int fq) const {
        const int zcol = 1280 + 32 * wc + 8 * fq;
        const bool samp = u.pm >= 256, cache = samp || (u.pm & 7) == 7;
        const int rowbase = u.pm * BM + wr * 64 + fr;
#pragma unroll
        for (int ai = 0; ai < 2; ++ai)
#pragma unroll
            for (int m = 0; m < 4; ++m) {
                const int row = rowbase + ai * HALF + m * 16;
                const float rx = RX[row];
                const f32x4 v0 = acc[ai][0][m][0] * rx, v1 = acc[ai][0][m][1] * rx;
                u32x4 w; w.x = cvt_pk_bf16(v0[0], v0[1]); w.y = cvt_pk_bf16(v0[2], v0[3]); w.z = cvt_pk_bf16(v1[0], v1[1]); w.w = cvt_pk_bf16(v1[2], v1[3]);
                *(u32x4*)(Z + ((size_t)(zcol >> 6) * MT + row) * 64 + (zcol & 63)) = w;
                if (cache) {
                    int b, i; if (samp) { const int r2 = row - MP; b = r2 >> 6; i = 64 + (r2 & 63); } else { b = row >> 11; i = (row & 2047) - 1920; }
                    if (i >= 0) { float* dst = out + (samp ? O_V_S : O_V_P) + ((size_t)(b * 128 + i) * 192 + (zcol - 1216)); *(f32x4*)dst = v0; *(f32x4*)(dst + 4) = v1; }
                }
            }
    }
};

template <bool HN = false, bool HM = false> struct EpiH {
    static constexpr bool PERM = true, AFTER_DRAIN = false, INIT_LOADS = true; static constexpr int RELAX = 0, B_AUX = 0, A_BLK = 1;
    const bf16_t* XB; bf16_t* HB; float* SS;
    struct Aux {};
    __device__ __forceinline__ void init(f32x4 (&acc)[2][2][4][2], const Unit& u, int wr, int wc, int fr, int fq) const { acc_from_bf16<HN, HM, true>(acc, XB, u, wr, wc, fr, fq); }
    __device__ __forceinline__ void aux_load(Aux&, const Unit&, int, int, int, int) const {}
    __device__ __forceinline__ void operator()(const f32x4 (&acc)[2][2][4][2], const Aux&, const Unit& u, int wr, int wc, int fr, int fq) const {
        const int col0 = u.pn * BM + (HN ? u.hb * HALF_COLS : 0) + wc * 32 + 8 * fq;
#pragma unroll
        for (int ai = 0; ai < (HM ? 1 : 2); ++ai) {
#pragma unroll
            for (int m = 0; m < 4; ++m) {
                const size_t grow = (size_t)u.pm * BM + (HM ? u.hm : ai) * HALF + wr * 64 + m * 16 + fr;
                float ss = 0.f;
#pragma unroll
                for (int bj = 0; bj < (HN ? 1 : 2); ++bj) { const f32x4 h0 = acc[ai][bj][m][0], h1 = acc[ai][bj][m][1];
                    ss += ((h0[0] * h0[0] + h0[1] * h0[1]) + (h0[2] * h0[2] + h0[3] * h0[3])) + ((h1[0] * h1[0] + h1[1] * h1[1]) + (h1[2] * h1[2] + h1[3] * h1[3]));
                    u32x4 w; w.x = cvt_pk_bf16(h0[0], h0[1]); w.y = cvt_pk_bf16(h0[2], h0[3]); w.z = cvt_pk_bf16(h1[0], h1[1]); w.w = cvt_pk_bf16(h1[2], h1[3]);
                    { const int c = col0 + bj * HALF; *(u32x4*)(HB + ((size_t)u.pm * (DM / BK) + (c >> 6)) * (BM * BK) + img_off((int)(grow & 255), c & 63)) = w; } }
                ss += __shfl_xor(ss, 16); ss += __shfl_xor(ss, 32);
                if (fq == 0) atomicAdd(SS + grow, ss);
            }
        }
    }
};

struct EpiAct {
    static constexpr bool PERM = true, AFTER_DRAIN = false, INIT_LOADS = false; static constexpr int RELAX = 0, B_AUX = 0, A_BLK = 1;
    const float* SS; bf16_t* ACT; PG8_LAS unsigned char* stage;
    struct Aux {};
    __device__ __forceinline__ void init(f32x4 (&acc)[2][2][4][2], const Unit&, int, int, int, int) const { acc_zero(acc); }
    __device__ __forceinline__ void aux_load(Aux&, const Unit& u, int wr, int wc, int fr, int fq) const {
        __builtin_amdgcn_global_load_lds((const unsigned*)(SS + (size_t)u.pm * BM + 4 * (fr + 16 * fq)), (PG8_LAS unsigned*)(stage + (wr * 4 + wc) * 1024), 16, 0, 0);
    }
    __device__ __forceinline__ void operator()(const f32x4 (&acc)[2][2][4][2], const Aux&, const Unit& u, int wr, int wc, int fr, int fq) const {
        const int col0 = u.pn * HALF + wc * 32 + 8 * fq;
        const PG8_LAS float* sl = (const PG8_LAS float*)(stage + (wr * 4 + wc) * 1024) + wr * 64 + fr;
#pragma unroll
        for (int ai = 0; ai < 2; ++ai)
#pragma unroll
            for (int m = 0; m < 4; ++m) {
                const size_t grow = (size_t)u.pm * BM + ai * HALF + wr * 64 + m * 16 + fr;
                const float r2 = __builtin_amdgcn_rcpf(sl[ai * HALF + m * 16] * (1.0f / DM) + EPS), rs = __builtin_amdgcn_sqrtf(r2), c1 = -LOG2E * rs;
                float o[8];
#pragma unroll
                for (int n = 0; n < 2; ++n)
#pragma unroll
                    for (int e = 0; e < 4; ++e) { const float g = acc[ai][0][m][n][e], uu = acc[ai][1][m][n][e];
                        o[4 * n + e] = (g * uu) * (r2 * __builtin_amdgcn_rcpf(1.0f + __builtin_amdgcn_exp2f(c1 * g))); }
                u32x4 w; w.x = cvt_pk_bf16(o[0], o[1]); w.y = cvt_pk_bf16(o[2], o[3]); w.z = cvt_pk_bf16(o[4], o[5]); w.w = cvt_pk_bf16(o[6], o[7]);
                *(u32x4*)(ACT + ((size_t)u.pm * (FF / BK) + (col0 >> 6)) * (BM * BK) + img_off((int)(grow & 255), col0 & 63)) = w;
            }
    }
};

template <bool HN = false, bool HM = false> struct EpiY {
    static constexpr bool PERM = true, AFTER_DRAIN = false, INIT_LOADS = true; static constexpr int RELAX = 0, B_AUX = 0, A_BLK = 1;
    const bf16_t* HB; float* Y; PG8_LAS unsigned char* stage;
    struct Aux {};
    __device__ __forceinline__ void init(f32x4 (&acc)[2][2][4][2], const Unit& u, int wr, int wc, int fr, int fq) const { acc_from_bf16<HN, HM, true>(acc, HB, u, wr, wc, fr, fq); }
    __device__ __forceinline__ void aux_load(Aux&, const Unit&, int, int, int, int) const {}
    __device__ __forceinline__ void operator()(const f32x4 (&acc)[2][2][4][2], const Aux&, const Unit& u, int wr, int wc, int fr, int fq) const {
        const int lane = fr + 16 * fq; PG8_LAS unsigned char* st = stage + (wr * 4 + wc) * 2048;
#pragma unroll
        for (int ai = 0; ai < (HM ? 1 : 2); ++ai) {
#pragma unroll
            for (int m = 0; m < 4; ++m) {
                float* tp = Y + ((size_t)u.pm * BM + (HM ? u.hm : ai) * HALF + wr * 64 + m * 16 + (lane >> 3)) * DM + u.pn * BM + (HN ? u.hb * HALF_COLS : 0) + wc * 32 + 4 * (lane & 7);
#pragma unroll
                for (int bj = 0; bj < (HN ? 1 : 2); ++bj) {
                    *(PG8_LAS f32x4*)(st + fr * 128 + (((2 * fq) ^ (fr & 7)) << 4)) = acc[ai][bj][m][0]; *(PG8_LAS f32x4*)(st + fr * 128 + (((2 * fq + 1) ^ (fr & 7)) << 4)) = acc[ai][bj][m][1];
                    asm volatile("s_waitcnt lgkmcnt(0)" ::: "memory");
#pragma unroll
                    for (int ps = 0; ps < 2; ++ps) { const int r = 8 * ps + (lane >> 3); const f32x4 v = *(const PG8_LAS f32x4*)(st + r * 128 + (((lane & 7) ^ (r & 7)) << 4)); *(f32x4*)(tp + (size_t)(8 * ps) * DM + bj * HALF) = v; }
                    asm volatile("s_waitcnt lgkmcnt(0)" ::: "memory");
                }
            }
        }
    }
};

template <class Epi, class Sched, bool ALIGN_EPI = false, bool SP2 = false, bool HALF_N = false>
__device__ __forceinline__ void gemm_phase(PG8_LAS unsigned char* lds, const Gemm g, const Sched& S, const Epi& E) {
    const int tid = threadIdx.x, wid = __builtin_amdgcn_readfirstlane(tid >> 6), lane = tid & 63, wr = wid >> 2, wc = wid & 3, fr = lane & 15, fq = lane >> 4;
    static_assert(SP2 || !HALF_N, "HALF_N needs the SP2 loop");
    const int K = g.K, nt = K / BK;
    unsigned voffA[2], voffB[2];
#pragma unroll
    for (int i = 0; i < 2; ++i) { int R, C; stage_rc(tid * 16 + i * 8192, R, C); const int Rb = Epi::PERM ? ((R & ~31) + perm32(R & 31)) : R;
        voffA[i] = Epi::A_BLK ? (unsigned)(tid * 16 + i * 8192) : (unsigned)(R * K + C) * 2u; voffB[i] = (unsigned)(tid * 16 + i * 8192); (void)Rb; }
    const size_t kstep = (size_t)(BK * 2);
    const size_t hstep = (size_t)HALF * K * 2;
    const size_t tstep = 2 * hstep;
    const size_t kstepA = Epi::A_BLK ? (size_t)BM * BK * 2 : kstep, hstepA = Epi::A_BLK ? (size_t)HALF * BK * 2 : hstep;
    const size_t kstepB = (size_t)BM * BK * 2, hstepB = (size_t)HALF * BK * 2;
    const unsigned ldsw = (unsigned)wid * 1024u;
    const int aoff = lds_byte(wr * 64 + fr, fq * 8), boff = lds_byte(wc * 32 + fr, fq * 8);
#define PG8_SA(b, h) (((b) * 2 + (h)) * HTB)
#define PG8_SB(b, h) ((4 + (b) * 2 + (h)) * HTB)
#define PG8_STAGE(bufoff, gbase, voff) do { _Pragma("unroll") for (int _i = 0; _i < 2; ++_i) \
        __builtin_amdgcn_global_load_lds((const unsigned*)((const char*)(gbase) + (voff)[_i]), (PG8_LAS unsigned*)(lds + (bufoff) + ldsw + _i * 8192), 16, 0, 0); } while (0)
#define PG8_STAGEB(bufoff, gbase) do { _Pragma("unroll") for (int _i = 0; _i < 2; ++_i) \
        __builtin_amdgcn_global_load_lds((const unsigned*)((const char*)(gbase) + voffB[_i]), (PG8_LAS unsigned*)(lds + (bufoff) + ldsw + _i * 8192), 16, 0, Epi::B_AUX); } while (0)
#define PG8_LDA(dst, b, h) do { _Pragma("unroll") for (int m = 0; m < 4; ++m) _Pragma("unroll") for (int k = 0; k < 2; ++k) dst[m][k] = *(const PG8_LAS bf16x8*)(lds + PG8_SA(b, h) + aoff + m * 2048 + k * 1024); } while (0)
#define PG8_LDB(dst, b, h) do { _Pragma("unroll") for (int n = 0; n < 2; ++n) _Pragma("unroll") for (int k = 0; k < 2; ++k) dst[n][k] = *(const PG8_LAS bf16x8*)(lds + PG8_SB(b, h) + boff + n * 2048 + k * 1024); } while (0)
#define PG8_MMA(ai, bj, At, Bt) do { __builtin_amdgcn_s_setprio(1); _Pragma("unroll") for (int m = 0; m < 4; ++m) _Pragma("unroll") for (int n = 0; n < 2; ++n) _Pragma("unroll") for (int k = 0; k < 2; ++k) \
        acc[ai][bj][m][n] = __builtin_amdgcn_mfma_f32_16x16x32_bf16(Bt[n][k], At[m][k], acc[ai][bj][m][n], 0, 0, 0); __builtin_amdgcn_s_setprio(0); } while (0)
#define PG8_WAIT_V(n) asm volatile("s_waitcnt vmcnt(" #n ")" ::: "memory")
#define PG8_WAIT_VK do { if constexpr (HALF_N) asm volatile("s_waitcnt vmcnt(6)" ::: "memory"); else asm volatile("s_waitcnt vmcnt(8)" ::: "memory"); } while (0)
#define PG8_STAGE_B1(bufoff, gbase) do { if constexpr (!HALF_N) PG8_STAGEB(bufoff, gbase); } while (0)
#define PG8_LDB1(dst, b) do { if constexpr (!HALF_N) PG8_LDB(dst, b, 1); } while (0)
#define PG8_MMA1(ai, At, Bt) do { if constexpr (!HALF_N) PG8_MMA(ai, 1, At, Bt); } while (0)
#define PG8_WAIT_V1 do { if (!HALF_N && Epi::RELAX == 9 && rl) asm volatile("s_waitcnt vmcnt(17)" ::: "memory"); else PG8_WAIT_VK; } while (0)
#define PG8_WAIT_L(n) asm volatile("s_waitcnt lgkmcnt(" #n ")" ::: "memory")
#define PG8_BAR __builtin_amdgcn_s_barrier()
#define PG8_SCHED __builtin_amdgcn_sched_barrier(0)
    Unit cur, nxt; int ui = 0;
    if (!S.next(0, cur)) return;
    f32x4 acc[2][2][4][2];
    typename Epi::Aux aux;
    E.init(acc, cur, wr, wc, fr, fq);
    bf16x8 At[4][2], B0[2][2], B1[2][2];
    const char* cA = (const char*)g.A + (size_t)cur.pm * tstep; const char* cB = (const char*)g.Bt + (size_t)cur.pn * tstep + (HALF_N ? (size_t)cur.hb * hstepB : (size_t)0);
    S.a_ready(cur);
    if constexpr (SP2) {
        PG8_STAGEB(PG8_SB(0, 0), cB); PG8_STAGE_B1(PG8_SB(0, 1), cB + hstepB); PG8_STAGE(PG8_SA(0, 0), cA, voffA); PG8_STAGE(PG8_SA(0, 1), cA + hstepA, voffA);
        if (wr == 1) PG8_BAR;
        PG8_WAIT_V(2); PG8_BAR;
        PG8_STAGEB(PG8_SB(1, 0), cB + kstepB); PG8_STAGE(PG8_SA(1, 0), cA + kstepA, voffA); PG8_STAGE_B1(PG8_SB(1, 1), cB + hstepB + kstepB);
        if constexpr (HALF_N) PG8_WAIT_V(4); else PG8_WAIT_V(6);
        PG8_BAR;
    } else {
        PG8_STAGEB(PG8_SB(0, 0), cB); PG8_STAGE(PG8_SA(0, 0), cA, voffA); PG8_STAGEB(PG8_SB(0, 1), cB + hstepB); PG8_STAGE(PG8_SA(0, 1), cA + hstepA, voffA);
        if (wr == 1) PG8_BAR;
        PG8_WAIT_V(4); PG8_BAR;
        PG8_STAGEB(PG8_SB(1, 0), cB + kstepB); PG8_STAGE(PG8_SA(1, 0), cA + kstepA, voffA); PG8_STAGEB(PG8_SB(1, 1), cB + hstepB + kstepB);
        PG8_WAIT_V(6); PG8_BAR;
    }
    for (;;) {
        if constexpr (Epi::INIT_LOADS) {
#pragma unroll
            for (int a = 0; a < 2; ++a)
#pragma unroll
                for (int b = 0; b < (HALF_N ? 1 : 2); ++b)
#pragma unroll
                    for (int m = 0; m < 4; ++m) asm volatile("" : "+v"(acc[a][b][m][0]), "+v"(acc[a][b][m][1]));
        }
        E.aux_load(aux, cur, wr, wc, fr, fq);
        const bool has_next = S.next(ui + 1, nxt);
        const char* nA = has_next ? (const char*)g.A + (size_t)nxt.pm * tstep : cA; const char* nB = has_next ? (const char*)g.Bt + (size_t)nxt.pn * tstep + (HALF_N ? (size_t)nxt.hb * hstepB : (size_t)0) : cB;
        for (int t = 0; t < nt; t += 2) {
            const bool last = (t == nt - 2);
            const char* a1 = cA + (size_t)(t + 1) * kstepA;
            const char* a2 = last ? nA : cA + (size_t)(t + 2) * kstepA; const char* b2 = last ? nB : cB + (size_t)(t + 2) * kstepB;
            const char* a3 = a2 + kstepA; const char* b3 = b2 + kstepB;
            if (last && has_next) S.a_ready(nxt);
            int rl = __builtin_amdgcn_readfirstlane((int)((t == 0) & (ui > 0))); asm volatile("" : "+s"(rl));
            if constexpr (SP2) {
            PG8_LDB(B0, 0, 0); PG8_LDB1(B1, 0); PG8_SCHED; PG8_LDA(At, 0, 0); PG8_STAGE(PG8_SA(1, 1), a1 + hstepA, voffA);
            PG8_WAIT_V1; PG8_WAIT_L(0); PG8_BAR; PG8_MMA(0, 0, At, B0); PG8_MMA1(0, At, B1); PG8_BAR; PG8_SCHED;
            PG8_LDA(At, 0, 1); PG8_STAGEB(PG8_SB(0, 0), b2); PG8_STAGE_B1(PG8_SB(0, 1), b2 + hstepB); PG8_STAGE(PG8_SA(0, 0), a2, voffA);
            PG8_WAIT_V1; PG8_WAIT_L(0); PG8_BAR; PG8_MMA(1, 0, At, B0); PG8_MMA1(1, At, B1); PG8_BAR; PG8_SCHED;
            PG8_LDB(B0, 1, 0); PG8_LDB1(B1, 1); PG8_SCHED; PG8_LDA(At, 1, 0); PG8_STAGE(PG8_SA(0, 1), a2 + hstepA, voffA);
            PG8_WAIT_VK; PG8_WAIT_L(0); PG8_BAR; PG8_MMA(0, 0, At, B0); PG8_MMA1(0, At, B1); PG8_BAR; PG8_SCHED;
            PG8_LDA(At, 1, 1); PG8_STAGEB(PG8_SB(1, 0), b3); PG8_STAGE_B1(PG8_SB(1, 1), b3 + hstepB); PG8_STAGE(PG8_SA(1, 0), a3, voffA);
            PG8_WAIT_VK; PG8_WAIT_L(0); PG8_BAR; PG8_MMA(1, 0, At, B0); PG8_MMA1(1, At, B1); PG8_BAR; PG8_SCHED;
            } else {
            PG8_LDB(B0, 0, 0); PG8_SCHED; PG8_LDA(At, 0, 0); PG8_STAGE(PG8_SA(1, 1), a1 + hstepA, voffA);
            PG8_WAIT_L(8); PG8_BAR; PG8_WAIT_L(0); PG8_MMA(0, 0, At, B0); PG8_BAR; PG8_SCHED;
            PG8_LDB(B1, 0, 1); PG8_STAGEB(PG8_SB(0, 0), b2);
            PG8_BAR; PG8_WAIT_L(0); PG8_MMA(0, 1, At, B1); PG8_BAR;
            PG8_LDA(At, 0, 1); PG8_STAGE(PG8_SA(0, 0), a2, voffA);
            PG8_BAR; PG8_WAIT_L(0); PG8_MMA(1, 0, At, B0); PG8_BAR; PG8_SCHED;
            PG8_STAGEB(PG8_SB(0, 1), b2 + hstepB);
            PG8_WAIT_V(6); PG8_BAR; PG8_MMA(1, 1, At, B1); PG8_BAR;
            PG8_LDB(B0, 1, 0); PG8_SCHED; PG8_LDA(At, 1, 0); PG8_STAGE(PG8_SA(0, 1), a2 + hstepA, voffA);
            PG8_WAIT_L(8); PG8_BAR; PG8_WAIT_L(0); PG8_MMA(0, 0, At, B0); PG8_BAR; PG8_SCHED;
            PG8_LDB(B1, 1, 1); PG8_STAGEB(PG8_SB(1, 0), b3);
            PG8_BAR; PG8_WAIT_L(0); PG8_MMA(0, 1, At, B1); PG8_BAR;
            PG8_LDA(At, 1, 1); PG8_STAGE(PG8_SA(1, 0), a3, voffA);
            PG8_BAR; PG8_WAIT_L(0); PG8_MMA(1, 0, At, B0); PG8_BAR; PG8_SCHED;
            PG8_STAGEB(PG8_SB(1, 1), b3 + hstepB);
            PG8_WAIT_V(6); PG8_BAR; PG8_MMA(1, 1, At, B1); PG8_BAR;
            }
        }
        if constexpr (ALIGN_EPI) { if (wr == 0) PG8_BAR; }
        if constexpr (!Epi::AFTER_DRAIN) { E(acc, aux, cur, wr, wc, fr, fq); S.done(cur); }
        if (!has_next) break;
        E.init(acc, nxt, wr, wc, fr, fq);
        cur = nxt; cA = nA; cB = nB; ++ui;
        if constexpr (ALIGN_EPI) { if (wr == 1) PG8_BAR; }
    }
    PG8_WAIT_V(0);
    if constexpr (!ALIGN_EPI) { if (wr == 0) PG8_BAR; }
    PG8_BAR;
    if constexpr (Epi::AFTER_DRAIN) { E.fused(acc, cur, wr, wc, fr, fq, lds, wid, lane); S.done(cur); }
}
template <class Epi, class Sched>
__device__ __forceinline__ void gemm_phase_q(PG8_LAS unsigned char* lds, const Gemm g, const Sched& S, const Epi& E) {
    const int tid = threadIdx.x, wid = __builtin_amdgcn_readfirstlane(tid >> 6), lane = tid & 63, wr = wid >> 2, wc = wid & 3, fr = lane & 15, fq = lane >> 4;
    const int K = g.K, nt = K / BK;
    unsigned voffA[2], voffB[2];
#pragma unroll
    for (int i = 0; i < 2; ++i) { int R, C; stage_rc(tid * 16 + i * 8192, R, C); const int Rb = Epi::PERM ? ((R & ~31) + perm32(R & 31)) : R;
        voffA[i] = (unsigned)(R * K + C) * 2u; voffB[i] = (unsigned)(Rb * K + C) * 2u; }
    const size_t kstep = (size_t)(BK * 2), hstep = (size_t)HALF * K * 2, tstep = 2 * hstep;
    const unsigned ldsw = (unsigned)wid * 1024u;
    const int aoff = lds_byte(wr * 64 + fr, fq * 8), boff = lds_byte(wc * 32 + fr, fq * 8);
    Unit cur;
    if (!S.next(0, cur)) return;
    f32x4 acc[2][2][4][2];
    typename Epi::Aux aux;
    E.init(acc, cur, wr, wc, fr, fq);
    bf16x8 At[4][2], B0[2][2];
    const char* cA = (const char*)g.A + (size_t)cur.pm * tstep + (size_t)cur.hm * hstep; const char* cB = (const char*)g.Bt + (size_t)cur.pn * tstep + (size_t)cur.hb * hstep;
    S.a_ready(cur);
    PG8_STAGEB(PG8_SB(0, 0), cB); PG8_STAGE(PG8_SA(0, 0), cA, voffA);
    PG8_STAGEB(PG8_SB(0, 1), cB + kstep); PG8_STAGE(PG8_SA(0, 1), cA + kstep, voffA);
    PG8_STAGEB(PG8_SB(1, 0), cB + 2 * kstep); PG8_STAGE(PG8_SA(1, 0), cA + 2 * kstep, voffA);
    if (wr == 1) PG8_BAR;
    PG8_WAIT_V(8); PG8_BAR;
    PG8_BAR;
    if constexpr (Epi::INIT_LOADS) {
#pragma unroll
        for (int m = 0; m < 4; ++m) asm volatile("" : "+v"(acc[0][0][m][0]), "+v"(acc[0][0][m][1]));
    }
    E.aux_load(aux, cur, wr, wc, fr, fq);
#define PG8_SPQ(s, kt) do { const int _k = (kt) < nt ? (kt) : (kt) - nt; \
        PG8_LDB(B0, (s) >> 1, (s) & 1); PG8_SCHED; PG8_LDA(At, (s) >> 1, (s) & 1); \
        PG8_STAGE(PG8_SB((((s) + 3) & 3) >> 1, ((s) + 3) & 1), cB + (size_t)_k * kstep, voffB); PG8_STAGE(PG8_SA((((s) + 3) & 3) >> 1, ((s) + 3) & 1), cA + (size_t)_k * kstep, voffA); \
        PG8_WAIT_V(8); PG8_WAIT_L(0); PG8_BAR; PG8_MMA(0, 0, At, B0); PG8_BAR; PG8_SCHED; } while (0)
    for (int t = 0; t < nt; t += 4) { PG8_SPQ(0, t + 3); PG8_SPQ(1, t + 4); PG8_SPQ(2, t + 5); PG8_SPQ(3, t + 6); }
#undef PG8_SPQ
    if (wr == 0) PG8_BAR;
    E(acc, aux, cur, wr, wc, fr, fq); S.done(cur);
    PG8_WAIT_V(0);
    PG8_BAR;
#undef PG8_SA
#undef PG8_SB
#undef PG8_STAGE
#undef PG8_STAGEB
#undef PG8_LDA
#undef PG8_LDB
#undef PG8_MMA
#undef PG8_WAIT_V
#undef PG8_WAIT_V1
#undef PG8_WAIT_VK
#undef PG8_STAGE_B1
#undef PG8_LDB1
#undef PG8_MMA1
#undef PG8_WAIT_L
#undef PG8_BAR
#undef PG8_SCHED
}
}
#ifndef PG8_SP2
#define PG8_SP2 true
#endif
#ifndef PG8_ALIGN
#define PG8_ALIGN true
#endif
namespace mixp {
using pg8::bf16_t; using pg8::bf16x8; using pg8::u32x4; using pg8::u32x2; using pg8::ZP; using pg8::MP; using pg8::MT; using pg8::LOG2E;
typedef float f32x16 __attribute__((ext_vector_type(16)));
typedef short v4i16_t __attribute__((ext_vector_type(4)));
#define MX_LAS __attribute__((address_space(3)))
typedef MX_LAS unsigned char* lptr;
constexpr int KR_OFF = 0, VR_OFF = 49152, OST_OFF = 98304;
constexpr int N_ATT_P = 32 * 3 * 32, N_ATT = N_ATT_P + 32 * 3, N_POOL_P = 32 * 32, N_UNITS = N_ATT + N_POOL_P + 32;
typedef float f32x2_t __attribute__((ext_vector_type(2))); typedef __bf16 bf16x2_t __attribute__((ext_vector_type(2)));
__device__ __forceinline__ unsigned pk_bf16(float lo, float hi) { f32x2_t v = {lo, hi}; bf16x2_t b = __builtin_convertvector(v, bf16x2_t); return __builtin_bit_cast(unsigned, b); }
__device__ __forceinline__ float bf_lo(unsigned w) { return __uint_as_float(w << 16); }
__device__ __forceinline__ float bf_hi(unsigned w) { return __uint_as_float(w & 0xffff0000u); }
__device__ __forceinline__ v4i16_t vtr(lptr p) { return __builtin_amdgcn_ds_read_tr16_b64_v4i16((MX_LAS v4i16_t*)p); }

struct AUnit { bool samp; int b, c, kvh, row0; };
__device__ __forceinline__ AUnit pool_decode(int j) { AUnit u; u.samp = j >= N_POOL_P; u.b = u.samp ? j - N_POOL_P : j >> 5; u.c = u.samp ? 0 : (j & 31); u.kvh = 0; u.row0 = u.samp ? MP + u.b * 64 : u.b * 2048 + 64 * u.c; return u; }
__device__ __forceinline__ void glds16(const void* gsrc, unsigned lds_dst) { unsigned keep;
    asm volatile("s_mov_b32 %0, m0\n\ts_mov_b32 m0, %2\n\ts_nop 0\n\tglobal_load_lds_dwordx4 %1, off\n\ts_mov_b32 m0, %0" : "=&s"(keep) : "v"(gsrc), "s"(lds_dst) : "memory"); }
#define MX_GLDS(src, dst) glds16((src), (unsigned)__builtin_amdgcn_readfirstlane((int)(unsigned)(uintptr_t)(dst)))

__device__ __forceinline__ void attn_issue_chunk(lptr ring, int slot, int j, const bf16_t* Z, const bf16_t* CK, const bf16_t* CV, const AUnit& u, int wid, int lane) {
    const int kkey = 8 * wid + (lane >> 3), kch = (lane & 7) ^ ((lane >> 3) & 7);
    const int vdh = wid >> 2, vkey = 16 * (wid & 3) + (lane >> 2), vch = 4 * vdh + (lane & 3);
    const bf16_t *ks, *vs;
    if (u.samp && j < 2) { const size_t o = (size_t)(u.b * 128 + 64 * j) * 192 + 64 * u.kvh; ks = CK + o + (size_t)kkey * 192 + 8 * kch; vs = CV + o + (size_t)vkey * 192 + 8 * vch; }
    else { const bool valid = u.samp || (u.c - 2 + j >= 0); const int rb = valid ? u.row0 - 128 + 64 * j : u.row0;
        ks = Z + ((size_t)(16 + u.kvh) * MT + rb + kkey) * 64 + 8 * kch; vs = Z + ((size_t)(19 + u.kvh) * MT + rb + vkey) * 64 + 8 * vch; }
    MX_GLDS(ks, ring + KR_OFF + slot * 8192 + wid * 1024);
    MX_GLDS(vs, ring + VR_OFF + slot * 8192 + wid * 1024);
}
__device__ __forceinline__ void attn_qload(bf16x8 (&q)[4], const bf16_t* Z, const AUnit& u, int wid, int lane) {
    const bf16_t* qp = Z + ((size_t)(4 + 4 * u.kvh + (wid >> 1)) * MT + u.row0 + 32 * (wid & 1) + (lane & 31)) * 64 + 8 * (lane >> 5);
#pragma unroll
    for (int ks = 0; ks < 4; ++ks) q[ks] = __builtin_nontemporal_load((const bf16x8*)(qp + 16 * ks));
}
__device__ __forceinline__ void attn_compute(lptr ring, int sl0, int sl1, int sl2, const bf16x8 (&qr)[4], bf16_t* MIX, float sink2, const AUnit& u, int wid, int lane) {
    const int slb[3] = {sl0 * 8192, sl1 * 8192, sl2 * 8192};
    const int r32 = lane & 31, hi = lane >> 5, g = wid >> 1, qh = wid & 1, hq = 4 * u.kvh + g;
    const float slope2 = __builtin_amdgcn_exp2f(-8.0f * (float)(hq + 1) * (1.0f / 12.0f)) * LOG2E;
    const float qb = (float)(32 * qh + r32 + 128 - 4 * hi);
    const float nsq = -slope2 * qb;
    f32x16 p[6];
#pragma unroll
    for (int kb = 0; kb < 6; ++kb) {
        const bool valid = u.samp || (u.c - 2 + (kb >> 1) >= 0);
#pragma unroll
        for (int r = 0; r < 16; ++r) { const float cst = (float)(32 * kb + (r & 3) + 8 * (r >> 2));
            const float bias = kb < 4 ? __builtin_fmaf(slope2, cst, nsq) : -slope2 * __builtin_fabsf(qb - cst);
            p[kb][r] = valid ? bias : -1e30f; }
#pragma unroll
        for (int ks = 0; ks < 4; ++ks) {
            const bf16x8 kf = *(const MX_LAS bf16x8*)(ring + KR_OFF + slb[kb >> 1] + (32 * (kb & 1) + r32) * 128 + (((2 * ks + hi) ^ (r32 & 7)) << 4));
            p[kb] = __builtin_amdgcn_mfma_f32_32x32x16_bf16(kf, qr[ks], p[kb], 0, 0, 0);
        }
    }
    float sum = 0.f;
#pragma unroll
    for (int kb = 0; kb < 6; ++kb)
#pragma unroll
        for (int r = 0; r < 16; ++r) { p[kb][r] = __builtin_amdgcn_exp2f(p[kb][r]); sum += p[kb][r]; }
    sum += __shfl_xor(sum, 32);
    sum += __builtin_amdgcn_exp2f(sink2);
    const float inv = 1.0f / sum;
    f32x16 o[2];
#pragma unroll
    for (int r = 0; r < 16; ++r) { o[0][r] = 0.f; o[1][r] = 0.f; }
    const lptr vb = ring + VR_OFF + ((lane >> 4) & 1) * 32 + (lane & 3) * 8 + (4 * hi + ((lane & 15) >> 2)) * 64;
#pragma unroll
    for (int kb = 0; kb < 6; ++kb)
#pragma unroll
        for (int s = 0; s < 2; ++s) {
            u32x4 pw;
            pw.x = pk_bf16(p[kb][8 * s + 0], p[kb][8 * s + 1]); pw.y = pk_bf16(p[kb][8 * s + 2], p[kb][8 * s + 3]);
            pw.z = pk_bf16(p[kb][8 * s + 4], p[kb][8 * s + 5]); pw.w = pk_bf16(p[kb][8 * s + 6], p[kb][8 * s + 7]);
            const bf16x8 pf = __builtin_bit_cast(bf16x8, pw);
#pragma unroll
            for (int db = 0; db < 2; ++db) {
                const v4i16_t lo = vtr(vb + slb[kb >> 1] + db * 4096 + (32 * (kb & 1) + 16 * s) * 64), hh = vtr(vb + slb[kb >> 1] + db * 4096 + (32 * (kb & 1) + 16 * s + 8) * 64);
                const bf16x8 vf = (bf16x8){lo[0], lo[1], lo[2], lo[3], hh[0], hh[1], hh[2], hh[3]};
                o[db] = __builtin_amdgcn_mfma_f32_32x32x16_bf16(vf, pf, o[db], 0, 0, 0);
            }
        }
    const lptr st = ring + OST_OFF + wid * 4096;
#pragma unroll
    for (int db = 0; db < 2; ++db)
#pragma unroll
        for (int rg = 0; rg < 4; ++rg) { u32x2 w; w.x = pk_bf16(o[db][4 * rg] * inv, o[db][4 * rg + 1] * inv); w.y = pk_bf16(o[db][4 * rg + 2] * inv, o[db][4 * rg + 3] * inv);
            *(MX_LAS u32x2*)(st + r32 * 128 + (((4 * db + rg) ^ (r32 & 7)) << 4) + 8 * hi) = w; }
    asm volatile("s_waitcnt lgkmcnt(0)" ::: "memory");
    bf16_t* op = MIX + ((size_t)(u.row0 >> 8) * 16 + 4 + hq) * (256 * 64);
#pragma unroll
    for (int i = 0; i < 4; ++i) { const int row = 8 * i + (lane >> 3); const u32x4 v = *(const MX_LAS u32x4*)(st + row * 128 + (((lane & 7) ^ (row & 7)) << 4)); *(u32x4*)(op + pg8::img_off((u.row0 & 255) + 32 * qh + row, 8 * (lane & 7))) = v; }
}

__device__ __forceinline__ void pool_issue(lptr buf, const bf16_t* Z, const bf16_t* CP, const bf16_t* ZERO, const AUnit& u, int wid, int lane) {
#pragma unroll
    for (int j = 0; j < 5; ++j) {
        const int p = wid + 8 * j, ri = 2 * p + (lane >> 5), rc = ri > 78 ? 78 : ri, ch = (lane & 31) ^ (ri & 15);
        const bf16_t* src = Z + ((size_t)(ch >> 3) * MT + (u.row0 + rc - 15)) * 64 + 8 * (ch & 7);
        if (ri < 15) { if (u.samp) src = CP + (size_t)(u.b * 15 + ri) * 256 + 8 * ch; else if (u.c == 0) src = ZERO + 8 * (lane & 31); }
        MX_GLDS(src, buf + p * 1024);
    }
}
__device__ __forceinline__ void pool_compute(lptr buf, const bf16x8 (&wf)[2][4], bf16_t* MIX, const AUnit& u, int wid, int lane) {
    const int r32 = lane & 31, hi = lane >> 5;
    const int g = wid >> 1, hh = wid & 1, W = 2 << g, t = 32 * hh + r32;
    const int pos = u.samp ? 4096 + t : 64 * u.c + t;
    const float icnt = 1.0f / (float)((pos + 1 < W) ? pos + 1 : W);
    bf16x8 df[4];
#pragma unroll
    for (int ks = 0; ks < 4; ++ks) {
        const int chunk = 8 * g + 2 * ks + hi;
        float a[8]; u32x4 cur = (u32x4){0u, 0u, 0u, 0u};
#pragma unroll
        for (int e = 0; e < 8; ++e) a[e] = 0.f;
        for (int i = 0; i < W; ++i) {
            const int ri = t + 15 - i;
            const u32x4 v = *(const MX_LAS u32x4*)(buf + ri * 512 + ((chunk ^ (ri & 15)) << 4));
            a[0] += bf_lo(v.x); a[1] += bf_hi(v.x); a[2] += bf_lo(v.y); a[3] += bf_hi(v.y); a[4] += bf_lo(v.z); a[5] += bf_hi(v.z); a[6] += bf_lo(v.w); a[7] += bf_hi(v.w);
            if (i == 0) cur = v;
        }
        u32x4 dw;
        dw.x = pk_bf16(a[0] * icnt - bf_lo(cur.x), a[1] * icnt - bf_hi(cur.x)); dw.y = pk_bf16(a[2] * icnt - bf_lo(cur.y), a[3] * icnt - bf_hi(cur.y));
        dw.z = pk_bf16(a[4] * icnt - bf_lo(cur.z), a[5] * icnt - bf_hi(cur.z)); dw.w = pk_bf16(a[6] * icnt - bf_lo(cur.w), a[7] * icnt - bf_hi(cur.w));
        df[ks] = __builtin_bit_cast(bf16x8, dw);
    }
    bf16_t* op = MIX + ((size_t)(u.row0 >> 8) * 16 + g) * (256 * 64);
#pragma unroll
    for (int eb = 0; eb < 2; ++eb) {
        f32x16 o;
#pragma unroll
        for (int r = 0; r < 16; ++r) o[r] = 0.f;
#pragma unroll
        for (int ks = 0; ks < 4; ++ks) o = __builtin_amdgcn_mfma_f32_32x32x16_bf16(wf[eb][ks], df[ks], o, 0, 0, 0);
#pragma unroll
        for (int rg = 0; rg < 4; ++rg) { u32x2 w; w.x = pk_bf16(o[4 * rg], o[4 * rg + 1]); w.y = pk_bf16(o[4 * rg + 2], o[4 * rg + 3]); *(u32x2*)(op + pg8::img_off((u.row0 & 255) + t, 32 * eb + 8 * rg + 4 * hi)) = w; }
    }
}

#define MX_SYNC() do { asm volatile("s_waitcnt vmcnt(0) lgkmcnt(0)" ::: "memory"); __builtin_amdgcn_s_barrier(); asm volatile("" ::: "memory"); } while (0)
__device__ __forceinline__ void mix_phase(lptr lds, const bf16_t* Z, const bf16_t* CK, const bf16_t* CV, const bf16_t* CP, const bf16_t* WPt, const bf16_t* ZERO, bf16_t* MIX, const float* sinks, int first, int stride) {
    const int tid = threadIdx.x, lane = tid & 63, wid = __builtin_amdgcn_readfirstlane(tid >> 6);
    constexpr int PBUF = 40960;
    constexpr int NRUN_P = 32 * 3 * 8, NRUN = NRUN_P + 32 * 3;
    int par = 0;
    if (first < NRUN) {
        const int g = wid >> 1;
        float sk0 = sinks[g] * LOG2E, sk1 = sinks[4 + g] * LOG2E, sk2 = sinks[8 + g] * LOG2E;
        asm volatile("" : "+v"(sk0), "+v"(sk1), "+v"(sk2));
        int run = first, st = 0, head = 0;
        auto unit_of = [](int run, int st) { AUnit u; u.samp = run >= NRUN_P; const int rr = u.samp ? run : NRUN_P - 1 - run;     const int a = u.samp ? run - NRUN_P : rr >> 3; u.b = a / 3; u.kvh = a % 3; u.c = u.samp ? 0 : 4 * (rr & 7) + st;
                                              u.row0 = u.samp ? MP + u.b * 64 : u.b * 2048 + 64 * u.c; return u; };
        bf16x8 qn[4];
        AUnit u = unit_of(run, 0);
        int s0 = 0, s1 = 1, s2 = 2; head = 3;
        attn_issue_chunk(lds, 0, 0, Z, CK, CV, u, wid, lane); attn_issue_chunk(lds, 1, 1, Z, CK, CV, u, wid, lane); attn_issue_chunk(lds, 2, 2, Z, CK, CV, u, wid, lane);
        attn_qload(qn, Z, u, wid, lane);
        for (;;) {
            MX_SYNC();
            bf16x8 qr[4];
#pragma unroll
            for (int ks = 0; ks < 4; ++ks) qr[ks] = qn[ks];
            asm volatile("" : "+v"(qr[0]), "+v"(qr[1]), "+v"(qr[2]), "+v"(qr[3]));
            int nrun = run, nst = st + 1; const int len = (run >= NRUN_P) ? 1 : 4;
            if (nst == len) { nrun = run + stride; nst = 0; }
            const bool more = nrun < NRUN;
            int n0 = s1, n1 = s2, n2 = head;
            AUnit un = u;
            if (more) {
                un = unit_of(nrun, nst);
                if (nst == 0) { n0 = head; n1 = head + 1 >= 6 ? head - 5 : head + 1; n2 = head + 2 >= 6 ? head - 4 : head + 2;
                    attn_issue_chunk(lds, n0, 0, Z, CK, CV, un, wid, lane); attn_issue_chunk(lds, n1, 1, Z, CK, CV, un, wid, lane); attn_issue_chunk(lds, n2, 2, Z, CK, CV, un, wid, lane);
                    head = head + 3 >= 6 ? head - 3 : head + 3; }
                else { attn_issue_chunk(lds, n2, 2, Z, CK, CV, un, wid, lane); head = head + 1 >= 6 ? 0 : head + 1; }
                attn_qload(qn, Z, un, wid, lane);
            }
            attn_compute(lds, s0, s1, s2, qr, MIX, u.kvh == 0 ? sk0 : (u.kvh == 1 ? sk1 : sk2), u, wid, lane);
            if (!more) break;
            run = nrun; st = nst; u = un; s0 = n0; s1 = n1; s2 = n2;
        }
    }
    MX_SYNC();
    int pj = first >= 96 ? first - 96 : first + stride - 96; par = 0;
    if (pj < N_POOL_P + 32) {
        bf16x8 wf[2][4];
#pragma unroll
        for (int eb = 0; eb < 2; ++eb)
#pragma unroll
            for (int ks = 0; ks < 4; ++ks) wf[eb][ks] = *(const bf16x8*)(WPt + (size_t)(((wid >> 1) * 64 + 32 * eb + (lane & 31)) * 64 + 16 * ks + 8 * (lane >> 5)));
        pool_issue(lds, Z, CP, ZERO, pool_decode(pj), wid, lane);
        for (; pj < N_POOL_P + 32; pj += stride, par ^= 1) {
            const AUnit u = pool_decode(pj);
            MX_SYNC();
            if (pj + stride < N_POOL_P + 32) pool_issue(lds + (par ^ 1) * PBUF, Z, CP, ZERO, pool_decode(pj + stride), wid, lane);
            pool_compute(lds + par * PBUF, wf, MIX, u, wid, lane);
        }
    }
    MX_SYNC();
}
#undef MX_SYNC
#undef MX_GLDS
#undef MX_LAS
}
constexpr int NWAVES = 8;
#ifndef MK_N_LAUNCHES
#define MK_N_LAUNCHES 1
#endif
constexpr int N_LAUNCHES = MK_N_LAUNCHES;
constexpr int PER_PHASE = 6;
#ifndef MK_P5_LAG
#define MK_P5_LAG 900
#endif
constexpr int P5_LAG = MK_P5_LAG;

constexpr size_t MiB = 1u << 20;
constexpr size_t WS_CTL = 0, CTL_ZERO_BYTES = 64 * 1024, WS_ZERO = 512 * 1024, WS_SS = 1 * MiB;
constexpr size_t WS_WIN = 2 * MiB, WS_WOUT = 5 * MiB, WS_WGU = 7 * MiB, WS_WD = 18 * MiB;
constexpr size_t WS_WP = 24 * MiB, WS_CK = 25 * MiB, WS_CV = 27 * MiB, WS_CP = 29 * MiB;
constexpr size_t WS_RX = 30 * MiB;
constexpr size_t WS_XB = 32 * MiB;
constexpr size_t WS_Z = 164 * MiB;
constexpr size_t WS_MIX = 346 * MiB;
constexpr size_t WS_ACT = 478 * MiB;
constexpr size_t WS_HB = 842 * MiB;
constexpr size_t WS_END = 974 * MiB;
static_assert(WS_SS + (size_t)67584 * 4 <= WS_WIN && WS_WD + (size_t)1024 * 2816 * 2 <= WS_WP && WS_XB + (size_t)67584 * 1024 * 2 <= WS_Z && WS_Z + (size_t)67584 * 1408 * 2 <= WS_MIX &&
              WS_MIX + (size_t)67584 * 1024 * 2 <= WS_ACT && WS_ACT + (size_t)67584 * 2816 * 2 <= WS_HB && WS_HB + (size_t)67584 * 1024 * 2 <= WS_END && WS_RX + (size_t)67584 * 4 <= WS_XB, "d_ws map");
constexpr int CW_TMO = 0, CW_CODE = 1;
constexpr int CW_BAR = 4096;
constexpr int RING_OFF = 0, RING_BYTES = 131072;
constexpr int LDSCTL_OFF = RING_BYTES, MISC_OFF = LDSCTL_OFF + 320;
constexpr int STAGE_OFF = LDSCTL_OFF + 1024;
constexpr int JUNK_OFF = STAGE_OFF + 16384;
constexpr int LDS_BYTES = STAGE_OFF + 16384;
static_assert(MISC_OFF + 128 <= LDS_BYTES, "LDS map");

#define GAS __attribute__((address_space(1)))
#define LAS __attribute__((address_space(3)))
typedef unsigned short bf16;
typedef unsigned v4u __attribute__((ext_vector_type(4)));
typedef float f32x4 __attribute__((ext_vector_type(4)));
typedef short bf16x8 __attribute__((ext_vector_type(8)));
typedef GAS unsigned gu32;
typedef GAS unsigned long long gu64;
#define RLX_AGENT __ATOMIC_RELAXED, __HIP_MEMORY_SCOPE_AGENT
#define LDS_WAIT() asm volatile("s_waitcnt lgkmcnt(0)" ::: "memory")
#define VM_WAIT() asm volatile("s_waitcnt vmcnt(0)" ::: "memory")
__device__ __forceinline__ unsigned long long rt() { return __builtin_amdgcn_s_memrealtime(); }
__device__ __forceinline__ unsigned f2bf(float f) { unsigned u = __builtin_bit_cast(unsigned, f); return (u + 0x7fffu + ((u >> 16) & 1u)) >> 16; }
__device__ __forceinline__ unsigned pk2(float lo, float hi) { return f2bf(lo) | (f2bf(hi) << 16); }

#define XB_TMO      128
#define XB_XCNT(j)  (256  + 64 * (j))
#define XB_XSUB(j)  (1280 + 64 * (j))
#define XB_XGEN(j)  (2304 + 64 * (j))
#define XB_TOP      3328
#define XB_TOPGEN   3392
#define XCD_BAR_WORDS 3456
#define XB_SPIN_CAP (1u << 18)

__device__ __forceinline__ unsigned xb_ld(unsigned* p)              { return __hip_atomic_load(p, __ATOMIC_RELAXED, __HIP_MEMORY_SCOPE_AGENT); }
__device__ __forceinline__ unsigned xb_add(unsigned* p, unsigned v) { return __hip_atomic_fetch_add(p, v, __ATOMIC_RELAXED, __HIP_MEMORY_SCOPE_AGENT); }
__device__ __forceinline__ unsigned xb_xcc_id() { return (unsigned)__builtin_amdgcn_s_getreg((3 << 11) | 20) & 0xFu; }
#define XB_SPIN(cond, bar) do { unsigned _sp = 0; while (cond) { __builtin_amdgcn_s_sleep(1); \
    if ((++_sp & 255u) == 0u) { if (xb_ld(&(bar)[XB_TMO])) break; if (_sp > XB_SPIN_CAP) { atomicAdd(&(bar)[XB_TMO], 1u); break; } } } } while (0)

struct XcdBarrier {
    unsigned* bar; unsigned x;
    volatile LAS unsigned* st;
};

__device__ __forceinline__ XcdBarrier xcd_barrier_post(unsigned* bar, volatile LAS unsigned* st) {
    XcdBarrier b; b.bar = bar; b.x = xb_xcc_id(); b.st = st;
    if (threadIdx.x == 0) (void)xb_add(&bar[XB_XCNT(b.x)], 1u);
    return b;
}
__device__ __forceinline__ void xcd_barrier_complete(unsigned* bar, unsigned x, unsigned& nloc, unsigned& nx) {
    const unsigned G = gridDim.x * gridDim.y * gridDim.z;
    unsigned sum, cnt, mine, sp = 0u;
    for (;;) {
        sum = 0u; cnt = 0u; mine = 0u;
#pragma unroll
        for (unsigned j = 0; j < 16; ++j) { const unsigned c = xb_ld(&bar[XB_XCNT(j)]); sum += c; cnt += (c > 0u) ? 1u : 0u; mine = (j == x) ? c : mine; }
        if (sum == G) break;
        __builtin_amdgcn_s_sleep(1);
        if ((++sp & 255u) == 0u) { if (xb_ld(&bar[XB_TMO])) break; if (sp > XB_SPIN_CAP) { atomicAdd(&bar[XB_TMO], 1u); break; } }
    }
    nloc = mine > 0u ? mine : 1u; nx = cnt > 0u ? cnt : 1u;
}

__device__ __forceinline__ void xcd_barrier(const XcdBarrier& b) {
    asm volatile("s_waitcnt vmcnt(0)" ::: "memory");
    __syncthreads();
    if (threadIdx.x == 0) {
        unsigned* bar = b.bar;
        __builtin_amdgcn_s_waitcnt(0);
        unsigned nloc = b.st[0], nx = b.st[1];
        if (nloc == 0u) { xcd_barrier_complete(bar, b.x, nloc, nx); b.st[0] = nloc; b.st[1] = nx; }
        const unsigned old = xb_add(&bar[XB_XSUB(b.x)], 1u);
        const unsigned gen = old / nloc;
        if (old + 1u == (gen + 1u) * nloc) {
            __builtin_amdgcn_fence(__ATOMIC_RELEASE, "agent");
            asm volatile("s_waitcnt vmcnt(0)" ::: "memory");
            const unsigned og = xb_add(&bar[XB_TOP], 1u);
            const unsigned tg = og / nx;
            if (og + 1u == (tg + 1u) * nx) xb_add(&bar[XB_TOPGEN], 1u);
            else XB_SPIN(xb_ld(&bar[XB_TOPGEN]) == tg, bar);
            __builtin_amdgcn_fence(__ATOMIC_ACQUIRE, "agent");
            xb_add(&bar[XB_XGEN(b.x)], 1u);
            asm volatile("s_waitcnt vmcnt(0)" ::: "memory");
        } else {
            XB_SPIN(xb_ld(&bar[XB_XGEN(b.x)]) == gen, bar);
            __builtin_amdgcn_fence(__ATOMIC_ACQUIRE, "agent");
            asm volatile("s_waitcnt vmcnt(0)" ::: "memory");
        }
    }
    __syncthreads();
}
struct Frame {
    LAS unsigned char* lds;
    volatile LAS unsigned* MISC;
    gu32* ctl;
    int tid, lane, wave;
    int vcu, G;
};

__device__ __forceinline__ float wave_sum(float v) {
#pragma unroll
    for (int o = 1; o < 64; o <<= 1) v += __shfl_xor(v, o);
    return v;
}
__device__ __forceinline__ void p0_transpose_item(const float* W, const float* gain, int K, int N, bf16* WT, int k0, int n0, int drow0, LAS float* scr, int lane) {
#pragma unroll 8
    for (int i = 0; i < 32; ++i) { const int kk = 2 * i + (lane >> 5); float w = __builtin_nontemporal_load(W + (size_t)(k0 + kk) * N + n0 + (lane & 31)); if (gain) w *= gain[k0 + kk]; scr[kk * 33 + (lane & 31)] = w; }
    LDS_WAIT(); asm volatile("" ::: "memory");
    const int c = lane & 7;
#pragma unroll
    for (int j = 0; j < 4; ++j) { const int n = (lane >> 3) + 8 * j; const LAS float* s = scr + (8 * c) * 33 + n;
        v4u o; o.x = pk2(s[0 * 33], s[1 * 33]); o.y = pk2(s[2 * 33], s[3 * 33]); o.z = pk2(s[4 * 33], s[5 * 33]); o.w = pk2(s[6 * 33], s[7 * 33]);
        const int row = drow0 + n, wr7 = row & 127, slot = (wr7 & ~31) + pg8::inv_perm32(wr7 & 31);
        *(GAS v4u*)((GAS char*)WT + ((size_t)((row >> 8) * (K >> 6) + (k0 >> 6)) * 2 + ((row >> 7) & 1)) * pg8::HTB + pg8::lds_byte(slot, 8 * c)) = o; }
    LDS_WAIT(); asm volatile("" ::: "memory");
}
__device__ __forceinline__ void x_rows2_to_bf16(const float* xa, const float* xb, bf16* oa, bf16* ob, float* ra, float* rb, int lane) {
    const GAS f32x4* pa = (const GAS f32x4*)xa + lane; const GAS f32x4* pb = (const GAS f32x4*)xb + lane;
    f32x4 va[4], vb[4]; float sa = 0.f, sb = 0.f;
#pragma unroll
    for (int j = 0; j < 4; ++j) { va[j] = __builtin_nontemporal_load(pa + 64 * j); vb[j] = __builtin_nontemporal_load(pb + 64 * j); }
#pragma unroll
    for (int j = 0; j < 4; ++j) { sa += (va[j].x * va[j].x + va[j].y * va[j].y) + (va[j].z * va[j].z + va[j].w * va[j].w); sb += (vb[j].x * vb[j].x + vb[j].y * vb[j].y) + (vb[j].z * vb[j].z + vb[j].w * vb[j].w); }
    GAS unsigned long long* qa = (GAS unsigned long long*)oa + lane; GAS unsigned long long* qb = (GAS unsigned long long*)ob + lane;
#pragma unroll
    for (int j = 0; j < 4; ++j) { qa[64 * j] = (unsigned long long)pk2(va[j].x, va[j].y) | ((unsigned long long)pk2(va[j].z, va[j].w) << 32);
                                  qb[64 * j] = (unsigned long long)pk2(vb[j].x, vb[j].y) | ((unsigned long long)pk2(vb[j].z, vb[j].w) << 32); }
    const float r1 = 1.f / sqrtf(wave_sum(sa) * (1.f / 1024.f) + 1e-6f), r2 = 1.f / sqrtf(wave_sum(sb) * (1.f / 1024.f) + 1e-6f);
    if (lane == 0) { *ra = r1; *rb = r2; }
}
struct P0Args { const float *xp, *xs, *cpool, *ck, *cv, *norm_mix, *w_in, *w_pool, *pool_scale, *w_out, *norm_ffn, *w_gate, *w_up, *w_down; float* out;
                bf16 *Win_t, *Wout_t, *Wgu_t, *Wd_t, *WPt, *CK, *CV, *CP, *XB; float* RX; float* SS; float* ZERO; };
__device__ __forceinline__ void p0_prologue(Frame& F, const P0Args& A) {
    LAS float* scr = (LAS float*)(F.lds + RING_OFF + F.wave * 16384);
    const int gw = F.vcu * NWAVES + F.wave, NGW = F.G * NWAVES;
    constexpr int I_IN = 16 * 44, I_OUT = 16 * 32, I_G = 16 * 88, I_D = 44 * 32, NITEMS = I_IN + I_OUT + 2 * I_G + I_D;
    for (int it = gw; it < NITEMS; it += NGW) {
        int r = it;
        if (r < I_IN) { const int kb = r / 44, nb = r % 44, n0 = 32 * nb, lc = n0 & 255, dd = lc & 63;
            p0_transpose_item(A.w_in, A.norm_mix, 1024, 1408, A.Win_t, 64 * kb, n0, n0 >= 1280 ? n0 : (n0 & ~255) + 128 * (dd >> 5) + 32 * (lc >> 6), scr, F.lane); continue; } r -= I_IN;
        if (r < I_OUT) { const int kb = r / 32, nb = r % 32; p0_transpose_item(A.w_out, nullptr, 1024, 1024, A.Wout_t, 64 * kb, 32 * nb, 32 * nb, scr, F.lane); continue; } r -= I_OUT;
        if (r < I_G) { const int kb = r / 88, nb = r % 88, n0 = 32 * nb;
            p0_transpose_item(A.w_gate, A.norm_ffn, 1024, 2816, A.Wgu_t, 64 * kb, n0, 256 * (n0 >> 7) + (n0 & 127), scr, F.lane); continue; } r -= I_G;
        if (r < I_G) { const int kb = r / 88, nb = r % 88, n0 = 32 * nb;
            p0_transpose_item(A.w_up, A.norm_ffn, 1024, 2816, A.Wgu_t, 64 * kb, n0, 256 * (n0 >> 7) + 128 + (n0 & 127), scr, F.lane); continue; } r -= I_G;
        { const int kb = r / 32, nb = r % 32; p0_transpose_item(A.w_down, nullptr, 2816, 1024, A.Wd_t, 64 * kb, 32 * nb, 32 * nb, scr, F.lane); }
    }
    __syncthreads();
    {
        constexpr int RS = 2112, NG = pg8::MT / 16;
        LAS unsigned char* stg = F.lds + RING_OFF;
        f32x4 va[4], vb[4];
        int grp = F.vcu;
        auto issue = [&](int g) { const int r = 16 * g + 2 * F.wave; const float* xa = r < pg8::MP ? A.xp + (size_t)r * 1024 : A.xs + (size_t)(r - pg8::MP) * 1024;
            const GAS f32x4* pa = (const GAS f32x4*)xa + F.lane;
#pragma unroll
            for (int j = 0; j < 4; ++j) { va[j] = __builtin_nontemporal_load(pa + 64 * j); vb[j] = __builtin_nontemporal_load(pa + 256 + 64 * j); } };
        if (grp < NG) issue(grp);
        for (; grp < NG; grp += F.G) {
            const int r = 16 * grp + 2 * F.wave;
            float sa = 0.f, sb = 0.f;
#pragma unroll
            for (int j = 0; j < 4; ++j) { sa += (va[j].x * va[j].x + va[j].y * va[j].y) + (va[j].z * va[j].z + va[j].w * va[j].w); sb += (vb[j].x * vb[j].x + vb[j].y * vb[j].y) + (vb[j].z * vb[j].z + vb[j].w * vb[j].w); }
            LAS unsigned long long* la = (LAS unsigned long long*)(stg + (2 * F.wave) * RS) + F.lane; LAS unsigned long long* lb = (LAS unsigned long long*)(stg + (2 * F.wave + 1) * RS) + F.lane;
#pragma unroll
            for (int j = 0; j < 4; ++j) { la[64 * j] = (unsigned long long)pk2(va[j].x, va[j].y) | ((unsigned long long)pk2(va[j].z, va[j].w) << 32);
                                          lb[64 * j] = (unsigned long long)pk2(vb[j].x, vb[j].y) | ((unsigned long long)pk2(vb[j].z, vb[j].w) << 32); }
            if (grp + F.G < NG) issue(grp + F.G);
            const float r1 = 1.f / sqrtf(wave_sum(sa) * (1.f / 1024.f) + 1e-6f), r2 = 1.f / sqrtf(wave_sum(sb) * (1.f / 1024.f) + 1e-6f);
            if (F.lane == 0) { A.RX[r] = r1; A.RX[r + 1] = r2; }
            __syncthreads();
            GAS unsigned char* blk = (GAS unsigned char*)A.XB + ((size_t)(grp >> 4) * 16 * 2 + ((grp >> 3) & 1)) * pg8::HTB + (size_t)(grp & 7) * 2048;
            const int pb = F.lane * 16, ob = pb ^ (((pb >> 9) & 1) << 5), rr = ob >> 6, cc = (ob & 63) >> 1;
#pragma unroll
            for (int q = 0; q < 4; ++q) { const int st = F.wave + 8 * q, kt = st >> 1, ch = st & 1;
                const v4u val = *(const LAS v4u*)(stg + rr * RS + (kt * 64 + ch * 32 + cc) * 2);
                *(GAS v4u*)(blk + (size_t)kt * (2 * pg8::HTB) + ch * 1024 + pb) = val; }
            __syncthreads();
        }
    }
    const int gt = gw * 64 + F.lane, NGT = NGW * 64;
    for (int i = gt; i < 4 * 64 * 64; i += NGT) { const int g = i >> 12, e = (i >> 6) & 63, c = i & 63;
        A.WPt[i] = (bf16)f2bf(A.w_pool[(g * 64 + c) * 64 + e] * A.pool_scale[64 * g + e]); }
    for (int i = gt; i < 32 * 128 * 192 / 4; i += NGT) {
        const f32x4 k4 = ((const GAS f32x4*)A.ck)[i], v4 = ((const GAS f32x4*)A.cv)[i];
        ((GAS unsigned long long*)A.CK)[i] = (unsigned long long)pk2(k4.x, k4.y) | ((unsigned long long)pk2(k4.z, k4.w) << 32);
        ((GAS unsigned long long*)A.CV)[i] = (unsigned long long)pk2(v4.x, v4.y) | ((unsigned long long)pk2(v4.z, v4.w) << 32);
        const int b = i / (128 * 48), rr = (i / 48) & 127, q = i % 48;
        if (rr >= 64) { const size_t o = ((size_t)(b * 128 + rr - 64) * 192) / 4 + q; ((GAS f32x4*)(A.out + pg8::O_K_S))[o] = k4; ((GAS f32x4*)(A.out + pg8::O_V_S))[o] = v4; }
    }
    for (int i = gt; i < 67584 / 4; i += NGT) ((GAS f32x4*)A.SS)[i] = (f32x4){0.f, 0.f, 0.f, 0.f};
    if (gt < 64) ((GAS f32x4*)A.ZERO)[gt] = (f32x4){0.f, 0.f, 0.f, 0.f};
    for (int i = gt; i < 32 * 15 * 256 / 4; i += NGT) { const f32x4 p4 = ((const GAS f32x4*)A.cpool)[i]; ((GAS unsigned long long*)A.CP)[i] = (unsigned long long)pk2(p4.x, p4.y) | ((unsigned long long)pk2(p4.z, p4.w) << 32); }
}

struct Args { const float* in[17]; float* out; unsigned char* ws; int ph_lo, ph_hi, li, pad; };
__global__ void __launch_bounds__(NWAVES * 64, 2) mk_fwd(Args args) {
    extern __shared__ __attribute__((aligned(16))) unsigned char lds[];
    Frame F;
    F.lds = (LAS unsigned char*)lds;
    F.MISC = (volatile LAS unsigned*)(F.lds + MISC_OFF);
    F.tid = threadIdx.x; F.lane = F.tid & 63; F.wave = __builtin_amdgcn_readfirstlane(F.tid >> 6);
    F.G = gridDim.x; { const int bx = blockIdx.x; F.vcu = (F.G % 8 == 0) ? (bx % 8) * (F.G / 8) + bx / 8 : bx; }
#define GRID_BAR(seam) do { if (N_LAUNCHES == PER_PHASE) { if (F.tid == 0) __hip_atomic_store(F.ctl + CW_TMO, 0xBADBA0u | (unsigned)(seam), RLX_AGENT); } \
    else { xcd_barrier(bar); } } while (0)
    unsigned char* ws = args.ws;
    F.ctl = (gu32*)(ws + WS_CTL);
    float* const out = args.out;
    bf16* const Win_t = (bf16*)(ws + WS_WIN); bf16* const Wout_t = (bf16*)(ws + WS_WOUT); bf16* const Wgu_t = (bf16*)(ws + WS_WGU); bf16* const Wd_t = (bf16*)(ws + WS_WD);
    bf16* const WPt = (bf16*)(ws + WS_WP); bf16* const CKb = (bf16*)(ws + WS_CK); bf16* const CVb = (bf16*)(ws + WS_CV); bf16* const CPb = (bf16*)(ws + WS_CP);
    bf16* const XB = (bf16*)(ws + WS_XB); bf16* const HB = (bf16*)(ws + WS_HB); bf16* const Z = (bf16*)(ws + WS_Z); bf16* const MIX = (bf16*)(ws + WS_MIX); bf16* const ACT = (bf16*)(ws + WS_ACT);
    float* const SS = (float*)(ws + WS_SS); float* const RX = (float*)(ws + WS_RX);
    for (int u = F.tid; u < (LDS_BYTES - LDSCTL_OFF) / 4; u += NWAVES * 64) ((LAS unsigned*)(F.lds + LDSCTL_OFF))[u] = 0u;
    __syncthreads();
    const int bli = (N_LAUNCHES == PER_PHASE) ? 0 : args.li;
    XcdBarrier bar; bar.bar = (unsigned*)(F.ctl + CW_BAR) + bli * XCD_BAR_WORDS; bar.x = 0; bar.st = nullptr;
    if (N_LAUNCHES != PER_PHASE)
        bar = xcd_barrier_post((unsigned*)(F.ctl + CW_BAR) + bli * XCD_BAR_WORDS, F.MISC + 8);

    const int lo = args.ph_lo, hi = args.ph_hi;
#define IN(k) (lo <= (k) && (k) < hi)
#define BOTH(k) (IN(k) && IN((k) + 1))

    if (IN(0)) {
        P0Args A{args.in[0], args.in[1], args.in[2], args.in[3], args.in[4], args.in[5], args.in[6], args.in[7], args.in[8], args.in[12], args.in[13], args.in[14], args.in[15], args.in[16], out,
                 Win_t, Wout_t, Wgu_t, Wd_t, WPt, CKb, CVb, CPb, XB, RX, SS, (float*)(ws + WS_ZERO)};
        p0_prologue(F, A);
        if (BOTH(0)) GRID_BAR(0);
    }
    if (IN(1)) {
        pg8::Gemm g{XB, Win_t, pg8::MT, 1536, 1024};
        pg8::StaticOrder S; S.init(pg8::MT, 1280, F.G, (int)blockIdx.x);
        { pg8::BalancedFullOrder Sb; Sb.init(pg8::MT, 1280, F.G, (int)blockIdx.x); pg8::EpiZ E{Z, args.in[9], args.in[10], out, RX};
          pg8::gemm_phase<pg8::EpiZ, pg8::BalancedFullOrder, PG8_ALIGN, PG8_SP2>(F.lds + RING_OFF, g, Sb, E); }
        { pg8::BalancedHalfOrder T{5, 0, (int)blockIdx.x, F.G, S.nM, S.nwg % F.G}; pg8::EpiZv E{Z, out, RX};
          pg8::gemm_phase<pg8::EpiZv, pg8::BalancedHalfOrder, PG8_ALIGN, PG8_SP2, true>(F.lds + RING_OFF, g, T, E); }
        if (BOTH(1)) GRID_BAR(1);
    }
    if (IN(2)) {
        mixp::mix_phase(F.lds + RING_OFF, Z, CKb, CVb, CPb, WPt, (const bf16*)(ws + WS_ZERO), MIX, args.in[11], (int)blockIdx.x, F.G);
        if (BOTH(2)) GRID_BAR(2);
    }
    if (IN(3)) {
        pg8::Gemm g{MIX, Wout_t, pg8::MT, 1024, 1024}; pg8::StaticOrder S; S.init(pg8::MT, 1024, F.G, (int)blockIdx.x);
        const int full = (S.nwg / F.G) * F.G;
        { pg8::StaticOrder Sa = S; Sa.hi = full; pg8::EpiH<false> E{XB, HB, SS};
          pg8::gemm_phase<pg8::EpiH<false>, pg8::StaticOrder, PG8_ALIGN, PG8_SP2>(F.lds + RING_OFF, g, Sa, E); }
        { pg8::TailHalfOrder T{S, full, (int)blockIdx.x}; pg8::EpiH<true> E{XB, HB, SS};
          pg8::gemm_phase<pg8::EpiH<true>, pg8::TailHalfOrder, PG8_ALIGN, PG8_SP2, true>(F.lds + RING_OFF, g, T, E); }
        if (BOTH(3)) GRID_BAR(3);
    }
    if (IN(4)) {
        pg8::Gemm g{HB, Wgu_t, pg8::MT, 5632, 1024}; pg8::StaticOrder S; S.init(pg8::MT, 5632, F.G, (int)blockIdx.x);
        S.rev = 1;
        pg8::EpiAct E{SS, ACT, F.lds + STAGE_OFF};
        pg8::gemm_phase<pg8::EpiAct, pg8::StaticOrder, PG8_ALIGN, PG8_SP2>(F.lds + RING_OFF, g, S, E);
        if (BOTH(4)) GRID_BAR(4);
    }
    if (IN(5)) {
        pg8::Gemm g{ACT, Wd_t, pg8::MT, 1024, 2816}; pg8::StaticOrder S; S.init(pg8::MT, 1024, F.G, (int)blockIdx.x);
        const int full = (S.nwg / F.G) * F.G;
        { pg8::StaticOrder Sa = S; Sa.hi = full; pg8::EpiY<false> E{HB, out, F.lds + STAGE_OFF};
          pg8::gemm_phase<pg8::EpiY<false>, pg8::StaticOrder, PG8_ALIGN, PG8_SP2>(F.lds + RING_OFF, g, Sa, E); }
        { pg8::TailHalfOrder T{S, full, (int)blockIdx.x}; pg8::EpiY<true> E{HB, out, F.lds + STAGE_OFF};
          pg8::gemm_phase<pg8::EpiY<true>, pg8::TailHalfOrder, PG8_ALIGN, PG8_SP2, true>(F.lds + RING_OFF, g, T, E); }
    }
#undef IN
#undef BOTH
}

extern "C" void kernel_launch(void* const* d_in, const int* in_sizes, int n_in, void* d_out, int out_size, void* d_ws, size_t ws_size, hipStream_t stream) {
    static int grid = 0;
    if (grid == 0) {
        if (n_in != 17 || in_sizes[0] != 65536 * 1024 || out_size != (int)pg8::O_END || ws_size < WS_END) { fprintf(stderr, "kernel_launch: shape mismatch: n_in %d, in0 %d, out %d, ws %zu (need >= %zu); nothing launched\n", n_in, n_in > 0 ? in_sizes[0] : -1, out_size, ws_size, (size_t)WS_END); grid = -1; return; }
        int dev = 0, cus = 0, per_cu = 0;
        if (hipGetDevice(&dev) != hipSuccess || hipDeviceGetAttribute(&cus, hipDeviceAttributeMultiprocessorCount, dev) != hipSuccess) { fprintf(stderr, "kernel_launch: hipGetDevice / hipDeviceGetAttribute failed; nothing launched\n"); grid = -1; return; }
        if (hipFuncSetAttribute((const void*)mk_fwd, hipFuncAttributeMaxDynamicSharedMemorySize, LDS_BYTES) != hipSuccess) { fprintf(stderr, "kernel_launch: hipFuncSetAttribute failed; nothing launched\n"); grid = -1; return; }
        if (hipOccupancyMaxActiveBlocksPerMultiprocessor(&per_cu, (const void*)mk_fwd, NWAVES * 64, LDS_BYTES) != hipSuccess || per_cu < 1)
            fprintf(stderr, "kernel_launch: note: the occupancy query reports %d workgroups per CU\n", per_cu);
        (void)hipGetLastError();
        grid = cus;
    }
    if (grid < 0) return;
    if (hipMemsetAsync((char*)d_ws + WS_CTL, 0, CTL_ZERO_BYTES, stream) != hipSuccess) { fprintf(stderr, "kernel_launch: hipMemsetAsync of the control words failed; nothing launched\n"); return; }
    Args a{};
    for (int i = 0; i < 17; ++i) a.in[i] = (const float*)d_in[i];
    a.out = (float*)d_out; a.ws = (unsigned char*)d_ws;
    static_assert(((N_LAUNCHES >= 1 && N_LAUNCHES <= 3) || N_LAUNCHES == PER_PHASE) && (CW_BAR + 3 * XCD_BAR_WORDS) * 4 <= (int)CTL_ZERO_BYTES, "-DMK_N_LAUNCHES must be 1, 2, 3 or 6");
    const int cuts3[4] = {0, N_LAUNCHES == 3 ? 1 : (N_LAUNCHES == 2 ? 4 : PER_PHASE), N_LAUNCHES == 3 ? 4 : PER_PHASE, PER_PHASE};
    for (int li = 0; li < N_LAUNCHES; ++li) {
        a.ph_lo = (N_LAUNCHES == PER_PHASE) ? li : cuts3[li]; a.ph_hi = (N_LAUNCHES == PER_PHASE) ? li + 1 : cuts3[li + 1]; a.li = li;
        hipLaunchKernelGGL(mk_fwd, dim3(grid), dim3(NWAVES * 64), LDS_BYTES, stream, a);
        const hipError_t le = hipPeekAtLastError();
        if (le != hipSuccess) { fprintf(stderr, "kernel_launch: launch %d failed: %s (grid %d x %d threads, %d B LDS)\n", li, hipGetErrorName(le), grid, NWAVES * 64, LDS_BYTES); break; }
    }
}
```

```cpp
#include <hip/hip_runtime.h>
#include <cstdio>
#include <cstdint>
namespace pg8 {
#define PG8_LAS __attribute__((address_space(3)))
typedef unsigned short bf16_t;
typedef short bf16x8 __attribute__((ext_vector_type(8)));
typedef float f32x4 __attribute__((ext_vector_type(4)));
typedef unsigned u32x4 __attribute__((ext_vector_type(4)));
constexpr int BM = 256, BK = 64, HALF = 128, HTB = HALF * BK * 2  , STAGE_BYTES = 8 * HTB, NXCD = 8, WGM = 8;

__host__ __device__ __forceinline__ int lds_byte(int r, int c) { const int st = (r >> 4) * 2 + (c >> 5), rr = r & 15, cc = c & 31, ob = rr * 64 + cc * 2; return st * 1024 + (ob ^ (((ob >> 9) & 1) << 5)); }
__host__ __device__ __forceinline__ int img_off(int r, int c) { return ((r >> 7) * HTB + lds_byte(r & 127, c)) >> 1; }
__host__ __device__ __forceinline__ void stage_rc(int b, int& R, int& C) { const int st = b / 1024, sb = b % 1024, swz = sb ^ (((sb >> 9) & 1) << 5); R = (st >> 1) * 16 + swz / 64; C = (st & 1) * 32 + (swz % 64) / 2; }
__host__ __device__ __forceinline__ int inv_perm32(int x) { return 16 * ((x >> 2) & 1) + 4 * (x >> 3) + (x & 3); }
__host__ __device__ __forceinline__ int perm32(int rho) { const int n = rho >> 4, i = rho & 15; return 8 * (i >> 2) + 4 * n + (i & 3); }

struct Unit { int pm, pn, hb, hm; };
struct Gemm { const bf16_t* A; const bf16_t* Bt; int M, N, K; };

struct StaticOrder {
    int nM, nN, nwg, G, c, lo, hi, rev, wgm;
    __host__ __device__ void init(int M, int N, int G_, int c_) { nM = M / BM; nN = N / BM; nwg = nM * nN; G = G_; c = c_; lo = 0; hi = nwg; rev = 0; wgm = WGM; }
    __host__ __device__ bool next(int i, Unit& u) const {
        const long L = (long)lo + (long)i * G + c; if (L >= hi) return false;
        int wgid = (int)L; { const int q = nwg / NXCD, r = nwg % NXCD, xcd = wgid % NXCD, off = wgid / NXCD; wgid = (xcd < r ? xcd * (q + 1) : r * (q + 1) + (xcd - r) * q) + off; }
        const int nig = wgm * nN, gid = wgid / nig, fm = gid * wgm, gsz = (nM - fm) < wgm ? (nM - fm) : wgm;
        u.pm = fm + ((wgid % nig) % gsz); u.pn = (wgid % nig) / gsz; u.hb = 0; u.hm = 0; if (rev) u.pm = nM - 1 - u.pm; return true;
    }
    __host__ __device__ void tile_of(int L, Unit& u) const { StaticOrder t = *this; t.lo = L; t.hi = L + 1; t.c = 0; (void)t.next(0, u); }
    __device__ __forceinline__ void a_ready(const Unit&) const {}
    __device__ __forceinline__ void done(const Unit&) const {}
};
struct BalancedFullOrder : StaticOrder {
    __host__ __device__ bool next(int i, Unit& u) const {
        if (G != 256 || nwg != 1320) return StaticOrder::next(i, u);
        int L; if (i < 4) L = i * G + c; else if (i == 4 && c < 208) L = 4 * G + c; else if (i == 5 && c < 88) L = 4 * G + 208 + c; else return false;
        StaticOrder t = *this; t.lo = L; t.hi = L + 1; t.c = 0; return t.StaticOrder::next(0, u);
    }
};
struct BalancedHalfOrder {
    int pn, hb, c, G, nM, busy;
    __host__ __device__ bool next(int i, Unit& u) const { int j;
        if (G != 256 || nM != 264) { if (c < busy) return false; j = (c - busy) + (G - busy) * i; if (j >= nM) return false; u.pm = j; u.pn = pn; u.hb = hb; u.hm = 0; return true; }
        if (c < 88) return false; if (c < 208) { if (i > 0) return false; j = c - 88; } else { if (i > 2) return false; j = 120 + 3 * (c - 208) + i; }
        u.pm = j; u.pn = pn; u.hb = hb; u.hm = 0; return true; }
    __device__ __forceinline__ void a_ready(const Unit&) const {}
    __device__ __forceinline__ void done(const Unit&) const {}
};
struct TailHalfOrder {
    StaticOrder S; int lo, c;
    __host__ __device__ bool next(int i, Unit& u) const { if (i > 0) return false; const int L = lo + (c >> 1); if (L >= S.nwg) return false; S.tile_of(L, u); u.hb = c & 1; return true; }
    __device__ __forceinline__ void a_ready(const Unit&) const {}
    __device__ __forceinline__ void done(const Unit&) const {}
};
struct TailQuarterOrder {
    StaticOrder S; int lo, c;
    __host__ __device__ bool next(int i, Unit& u) const { if (i > 0) return false; const int L = lo + (c >> 2); if (L >= S.nwg) return false; S.tile_of(L, u); u.hb = c & 1; u.hm = (c >> 1) & 1; return true; }
    __device__ __forceinline__ void a_ready(const Unit&) const {}
    __device__ __forceinline__ void done(const Unit&) const {}
};
typedef float f32x2 __attribute__((ext_vector_type(2))); typedef __bf16 bf16x2_t __attribute__((ext_vector_type(2)));
__device__ __forceinline__ unsigned cvt_pk_bf16(float lo, float hi) { f32x2 v = {lo, hi}; bf16x2_t b = __builtin_convertvector(v, bf16x2_t); return __builtin_bit_cast(unsigned, b); }
typedef unsigned u32x2 __attribute__((ext_vector_type(2)));
constexpr float LOG2E = 1.4426950408889634f;
constexpr float C2 = 0.125f * LOG2E;
constexpr float EPS = 1e-6f;
constexpr int HALF_COLS = 128;
constexpr int DM = 1024, ZP = 1408, FF = 2816;
constexpr int MP = 65536, MS = 2048, MT = MP + MS;
constexpr size_t O_POOL_P = 69206016, O_K_P = 69328896, O_V_P = 70115328, O_POOL_S = 70901760, O_K_S = 71024640, O_V_S = 71811072, O_END = 72597504;

__host__ __device__ __forceinline__ size_t zsub_off(int row, int c) { return ((size_t)(row >> 4) * 2 + (c >> 5)) * 512 + (row & 15) * 32 + (c & 31); }
__device__ __forceinline__ void acc_zero(f32x4 (&acc)[2][2][4][2]) {
#pragma unroll
    for (int a = 0; a < 2; ++a)
#pragma unroll
        for (int b = 0; b < 2; ++b)
#pragma unroll
            for (int m = 0; m < 4; ++m)
#pragma unroll
                for (int n = 0; n < 2; ++n) acc[a][b][m][n] = (f32x4){0.f, 0.f, 0.f, 0.f};
}
__device__ __forceinline__ float bf_lo(unsigned w) { return __uint_as_float(w << 16); }
__device__ __forceinline__ float bf_hi(unsigned w) { return __uint_as_float(w & 0xffff0000u); }
template <bool HN = false, bool HM = false, bool BLK = false>
__device__ __forceinline__ void acc_from_bf16(f32x4 (&acc)[2][2][4][2], const bf16_t* R, const Unit& u, int wr, int wc, int fr, int fq) {
    const int r0 = (HM ? u.hm * HALF : 0) + wr * 64 + fr, c0 = u.pn * BM + (HN ? u.hb * HALF_COLS : 0) + wc * 32 + 8 * fq;
    const bf16_t* rp = BLK ? R + (size_t)u.pm * (1024 / BK) * (BM * BK) : R + ((size_t)u.pm * BM + r0) * 1024 + c0;
#pragma unroll
    for (int ai = 0; ai < (HM ? 1 : 2); ++ai)
#pragma unroll
        for (int m = 0; m < 4; ++m)
#pragma unroll
            for (int bj = 0; bj < (HN ? 1 : 2); ++bj) { const int c = c0 + bj * HALF;
                const u32x4 w = BLK ? *(const u32x4*)(rp + (size_t)(c >> 6) * (BM * BK) + img_off(r0 + ai * HALF + m * 16, c & 63)) : *(const u32x4*)(rp + (size_t)(ai * HALF + m * 16) * 1024 + bj * HALF);
                acc[ai][bj][m][0] = (f32x4){bf_lo(w.x), bf_hi(w.x), bf_lo(w.y), bf_hi(w.y)}; acc[ai][bj][m][1] = (f32x4){bf_lo(w.z), bf_hi(w.z), bf_lo(w.w), bf_hi(w.w)}; }
}

struct EpiZ {
    static constexpr bool PERM = true, AFTER_DRAIN = false, INIT_LOADS = false; static constexpr int RELAX = 0, B_AUX = 0, A_BLK = 1;
    bf16_t* Z; const float* qn; const float* kn; float* out; const float* RX;
    struct Aux {};
    __device__ __forceinline__ void init(f32x4 (&acc)[2][2][4][2], const Unit&, int, int, int, int) const { acc_zero(acc); }
    __device__ __forceinline__ void aux_load(Aux&, const Unit&, int, int, int, int) const {}
    __device__ __forceinline__ void operator()(const f32x4 (&acc)[2][2][4][2], const Aux&, const Unit& u, int wr, int wc, int fr, int fq) const {
        const int zcol = u.pn * 256 + wc * 64;
        if (zcol >= ZP) return;
        const int kind = (zcol >= 256 && zcol < 1024) ? 1 : ((zcol >= 1024 && zcol < 1216) ? 2 : 0);
        f32x4 sc[2][2];
#pragma unroll
        for (int bj = 0; bj < 2; ++bj)
#pragma unroll
            for (int n = 0; n < 2; ++n) {
                if (kind == 1) sc[bj][n] = *(const f32x4*)(qn + 32 * bj + 8 * fq + 4 * n) * C2;
                else if (kind == 2) sc[bj][n] = *(const f32x4*)(kn + 32 * bj + 8 * fq + 4 * n);
                else sc[bj][n] = (f32x4){1.f, 1.f, 1.f, 1.f};
            }
        const bool samp = u.pm >= 256;
        const int cm = (!samp && (u.pm & 7) != 7) ? 0 : (zcol < 256 ? 1 : (zcol >= 1216 ? 3 : (zcol >= 1024 ? 2 : 0)));
        const int rowbase = u.pm * BM + wr * 64 + fr;
#pragma unroll
        for (int ai = 0; ai < 2; ++ai)
#pragma unroll
            for (int m = 0; m < 4; ++m) {
                const int row = rowbase + ai * HALF + m * 16;
                const float rx = RX[row];
                float rs = rx;
                if (kind) {
                    float ss = 0.f;
#pragma unroll
                    for (int bj = 0; bj < 2; ++bj)
#pragma unroll
                        for (int n = 0; n < 2; ++n) { const f32x4 x = acc[ai][bj][m][n]; ss += (x[0] * x[0] + x[1] * x[1]) + (x[2] * x[2] + x[3] * x[3]); }
                    ss += __shfl_xor(ss, 16); ss += __shfl_xor(ss, 32);
                    rs = rx / sqrtf(ss * (rx * rx) * (1.0f / 64.0f) + EPS);
                }
                f32x4 v[2][2];
#pragma unroll
                for (int bj = 0; bj < 2; ++bj)
#pragma unroll
                    for (int n = 0; n < 2; ++n) v[bj][n] = acc[ai][bj][m][n] * rs * sc[bj][n];
                bf16_t* zp = Z + (size_t)(zcol >> 6) * MT * 64 + zsub_off(row, 8 * fq);
#pragma unroll
                for (int bj = 0; bj < 2; ++bj) { u32x4 w; w.x = cvt_pk_bf16(v[bj][0][0], v[bj][0][1]); w.y = cvt_pk_bf16(v[bj][0][2], v[bj][0][3]); w.z = cvt_pk_bf16(v[bj][1][0], v[bj][1][1]); w.w = cvt_pk_bf16(v[bj][1][2], v[bj][1][3]);
                    *(u32x4*)(zp + 512 * bj) = w; }
                if (cm) {
                    int b, t, T; if (samp) { const int r2 = row - MP; b = r2 >> 6; t = r2 & 63; T = 64; } else { b = row >> 11; t = row & 2047; T = 2048; }
                    float* dst = nullptr;
                    if (cm == 1) { const int i = t - (T - 15); if (i >= 0) dst = out + (samp ? O_POOL_S : O_POOL_P) + ((size_t)(b * 15 + i) * 256 + zcol); }
                    else { const int i = samp ? 64 + t : t - (T - 128); if (i >= 0) dst = out + (cm == 2 ? (samp ? O_K_S : O_K_P) : (samp ? O_V_S : O_V_P)) + ((size_t)(b * 128 + i) * 192 + (zcol - (cm == 2 ? 1024 : 1216))); }
                    if (dst) {
#pragma unroll
                        for (int bj = 0; bj < 2; ++bj)
#pragma unroll
                            for (int n = 0; n < 2; ++n) *(f32x4*)(dst + 32 * bj + 8 * fq + 4 * n) = v[bj][n];
                    }
                }
            }
    }
};

struct EpiZv {
    static constexpr bool PERM = true, AFTER_DRAIN = false, INIT_LOADS = false; static constexpr int RELAX = 0, B_AUX = 0, A_BLK = 1;
    bf16_t* Z; float* out; const float* RX;
    struct Aux {};
    __device__ __forceinline__ void init(f32x4 (&acc)[2][2][4][2], const Unit&, int, int, int, int) const { acc_zero(acc); }
    __device__ __forceinline__ void aux_load(Aux&, const Unit&, int, int, int, int) const {}
    __device__ __forceinline__ void operator()(const f32x4 (&acc)[2][2][4][2], const Aux&, const Unit& u, int wr, int wc, int fr, int fq) const {
        const int zcol = 1280 + 32 * wc + 8 * fq;
        const bool samp = u.pm >= 256, cache = samp || (u.pm & 7) == 7;
        const int rowbase = u.pm * BM + wr * 64 + fr;
#pragma unroll
        for (int ai = 0; ai < 2; ++ai)
#pragma unroll
            for (int m = 0; m < 4; ++m) {
                const int row = rowbase + ai * HALF + m * 16;
                const float rx = RX[row];
                const f32x4 v0 = acc[ai][0][m][0] * rx, v1 = acc[ai][0][m][1] * rx;
                u32x4 w; w.x = cvt_pk_bf16(v0[0], v0[1]); w.y = cvt_pk_bf16(v0[2], v0[3]); w.z = cvt_pk_bf16(v1[0], v1[1]); w.w = cvt_pk_bf16(v1[2], v1[3]);
                *(u32x4*)(Z + (size_t)(zcol >> 6) * MT * 64 + zsub_off(row, zcol & 63)) = w;
                if (cache) {
                    int b, i; if (samp) { const int r2 = row - MP; b = r2 >> 6; i = 64 + (r2 & 63); } else { b = row >> 11; i = (row & 2047) - 1920; }
                    if (i >= 0) { float* dst = out + (samp ? O_V_S : O_V_P) + ((size_t)(b * 128 + i) * 192 + (zcol - 1216)); *(f32x4*)dst = v0; *(f32x4*)(dst + 4) = v1; }
                }
            }
    }
};

template <bool HN = false, bool HM = false> struct EpiH {
    static constexpr bool PERM = true, AFTER_DRAIN = false, INIT_LOADS = true; static constexpr int RELAX = 0, B_AUX = 0, A_BLK = 1;
    const bf16_t* XB; bf16_t* HB; float* SS;
    struct Aux {};
    __device__ __forceinline__ void init(f32x4 (&acc)[2][2][4][2], const Unit& u, int wr, int wc, int fr, int fq) const { acc_from_bf16<HN, HM, true>(acc, XB, u, wr, wc, fr, fq); }
    __device__ __forceinline__ void aux_load(Aux&, const Unit&, int, int, int, int) const {}
    __device__ __forceinline__ void operator()(const f32x4 (&acc)[2][2][4][2], const Aux&, const Unit& u, int wr, int wc, int fr, int fq) const {
        const int col0 = u.pn * BM + (HN ? u.hb * HALF_COLS : 0) + wc * 32 + 8 * fq;
#pragma unroll
        for (int ai = 0; ai < (HM ? 1 : 2); ++ai) {
#pragma unroll
            for (int m = 0; m < 4; ++m) {
                const size_t grow = (size_t)u.pm * BM + (HM ? u.hm : ai) * HALF + wr * 64 + m * 16 + fr;
                float ss = 0.f;
#pragma unroll
                for (int bj = 0; bj < (HN ? 1 : 2); ++bj) { const f32x4 h0 = acc[ai][bj][m][0], h1 = acc[ai][bj][m][1];
                    ss += ((h0[0] * h0[0] + h0[1] * h0[1]) + (h0[2] * h0[2] + h0[3] * h0[3])) + ((h1[0] * h1[0] + h1[1] * h1[1]) + (h1[2] * h1[2] + h1[3] * h1[3]));
                    u32x4 w; w.x = cvt_pk_bf16(h0[0], h0[1]); w.y = cvt_pk_bf16(h0[2], h0[3]); w.z = cvt_pk_bf16(h1[0], h1[1]); w.w = cvt_pk_bf16(h1[2], h1[3]);
                    { const int c = col0 + bj * HALF; *(u32x4*)(HB + ((size_t)u.pm * (DM / BK) + (c >> 6)) * (BM * BK) + img_off((int)(grow & 255), c & 63)) = w; } }
                ss += __shfl_xor(ss, 16); ss += __shfl_xor(ss, 32);
                if (fq == 0) atomicAdd(SS + grow, ss);
            }
        }
    }
};

struct EpiAct {
    static constexpr bool PERM = true, AFTER_DRAIN = false, INIT_LOADS = false; static constexpr int RELAX = 0, B_AUX = 0, A_BLK = 1;
    const float* SS; bf16_t* ACT; PG8_LAS unsigned char* stage;
    struct Aux {};
    __device__ __forceinline__ void init(f32x4 (&acc)[2][2][4][2], const Unit&, int, int, int, int) const { acc_zero(acc); }
    __device__ __forceinline__ void aux_load(Aux&, const Unit& u, int wr, int wc, int fr, int fq) const {
        __builtin_amdgcn_global_load_lds((const unsigned*)(SS + (size_t)u.pm * BM + 4 * (fr + 16 * fq)), (PG8_LAS unsigned*)(stage + (wr * 4 + wc) * 1024), 16, 0, 0);
    }
    __device__ __forceinline__ void operator()(const f32x4 (&acc)[2][2][4][2], const Aux&, const Unit& u, int wr, int wc, int fr, int fq) const {
        const int col0 = u.pn * HALF + wc * 32 + 8 * fq;
        const PG8_LAS float* sl = (const PG8_LAS float*)(stage + (wr * 4 + wc) * 1024) + wr * 64 + fr;
#pragma unroll
        for (int ai = 0; ai < 2; ++ai)
#pragma unroll
            for (int m = 0; m < 4; ++m) {
                const size_t grow = (size_t)u.pm * BM + ai * HALF + wr * 64 + m * 16 + fr;
                const float r2 = __builtin_amdgcn_rcpf(sl[ai * HALF + m * 16] * (1.0f / DM) + EPS), rs = __builtin_amdgcn_sqrtf(r2), c1 = -LOG2E * rs;
                float o[8];
#pragma unroll
                for (int n = 0; n < 2; ++n)
#pragma unroll
                    for (int e = 0; e < 4; ++e) { const float g = acc[ai][0][m][n][e], uu = acc[ai][1][m][n][e];
                        o[4 * n + e] = (g * uu) * (r2 * __builtin_amdgcn_rcpf(1.0f + __builtin_amdgcn_exp2f(c1 * g))); }
                u32x4 w; w.x = cvt_pk_bf16(o[0], o[1]); w.y = cvt_pk_bf16(o[2], o[3]); w.z = cvt_pk_bf16(o[4], o[5]); w.w = cvt_pk_bf16(o[6], o[7]);
                *(u32x4*)(ACT + ((size_t)u.pm * (FF / BK) + (col0 >> 6)) * (BM * BK) + img_off((int)(grow & 255), col0 & 63)) = w;
            }
    }
};

template <bool HN = false, bool HM = false> struct EpiY {
    static constexpr bool PERM = true, AFTER_DRAIN = false, INIT_LOADS = true; static constexpr int RELAX = 0, B_AUX = 0, A_BLK = 1;
    const bf16_t* HB; float* Y; PG8_LAS unsigned char* stage;
    struct Aux {};
    __device__ __forceinline__ void init(f32x4 (&acc)[2][2][4][2], const Unit& u, int wr, int wc, int fr, int fq) const { acc_from_bf16<HN, HM, true>(acc, HB, u, wr, wc, fr, fq); }
    __device__ __forceinline__ void aux_load(Aux&, const Unit&, int, int, int, int) const {}
    __device__ __forceinline__ void operator()(const f32x4 (&acc)[2][2][4][2], const Aux&, const Unit& u, int wr, int wc, int fr, int fq) const {
        const int lane = fr + 16 * fq; PG8_LAS unsigned char* st = stage + (wr * 4 + wc) * 2048;
#pragma unroll
        for (int ai = 0; ai < (HM ? 1 : 2); ++ai) {
#pragma unroll
            for (int m = 0; m < 4; ++m) {
                float* tp = Y + ((size_t)u.pm * BM + (HM ? u.hm : ai) * HALF + wr * 64 + m * 16 + (lane >> 3)) * DM + u.pn * BM + (HN ? u.hb * HALF_COLS : 0) + wc * 32 + 4 * (lane & 7);
#pragma unroll
                for (int bj = 0; bj < (HN ? 1 : 2); ++bj) {
                    *(PG8_LAS f32x4*)(st + fr * 128 + (((2 * fq) ^ (fr & 7)) << 4)) = acc[ai][bj][m][0]; *(PG8_LAS f32x4*)(st + fr * 128 + (((2 * fq + 1) ^ (fr & 7)) << 4)) = acc[ai][bj][m][1];
                    asm volatile("s_waitcnt lgkmcnt(0)" ::: "memory");
#pragma unroll
                    for (int ps = 0; ps < 2; ++ps) { const int r = 8 * ps + (lane >> 3); const f32x4 v = *(const PG8_LAS f32x4*)(st + r * 128 + (((lane & 7) ^ (r & 7)) << 4)); *(f32x4*)(tp + (size_t)(8 * ps) * DM + bj * HALF) = v; }
                    asm volatile("s_waitcnt lgkmcnt(0)" ::: "memory");
                }
            }
        }
    }
};

template <class Epi, class Sched, bool ALIGN_EPI = false, bool SP2 = false, bool HALF_N = false>
__device__ __forceinline__ void gemm_phase(PG8_LAS unsigned char* lds, const Gemm g, const Sched& S, const Epi& E) {
    const int tid = threadIdx.x, wid = __builtin_amdgcn_readfirstlane(tid >> 6), lane = tid & 63, wr = wid >> 2, wc = wid & 3, fr = lane & 15, fq = lane >> 4;
    static_assert(SP2 || !HALF_N, "HALF_N needs the SP2 loop");
    const int K = g.K, nt = K / BK;
    unsigned voffA[2], voffB[2];
#pragma unroll
    for (int i = 0; i < 2; ++i) { int R, C; stage_rc(tid * 16 + i * 8192, R, C); const int Rb = Epi::PERM ? ((R & ~31) + perm32(R & 31)) : R;
        voffA[i] = Epi::A_BLK ? (unsigned)(tid * 16 + i * 8192) : (unsigned)(R * K + C) * 2u; voffB[i] = (unsigned)(tid * 16 + i * 8192); (void)Rb; }
    const size_t kstep = (size_t)(BK * 2);
    const size_t hstep = (size_t)HALF * K * 2;
    const size_t tstep = 2 * hstep;
    const size_t kstepA = Epi::A_BLK ? (size_t)BM * BK * 2 : kstep, hstepA = Epi::A_BLK ? (size_t)HALF * BK * 2 : hstep;
    const size_t kstepB = (size_t)BM * BK * 2, hstepB = (size_t)HALF * BK * 2;
    const unsigned ldsw = (unsigned)wid * 1024u;
    const int aoff = lds_byte(wr * 64 + fr, fq * 8), boff = lds_byte(wc * 32 + fr, fq * 8);
#define PG8_SA(b, h) (((b) * 2 + (h)) * HTB)
#define PG8_SB(b, h) ((4 + (b) * 2 + (h)) * HTB)
#define PG8_STAGE(bufoff, gbase, voff) do { _Pragma("unroll") for (int _i = 0; _i < 2; ++_i) \
        __builtin_amdgcn_global_load_lds((const unsigned*)((const char*)(gbase) + (voff)[_i]), (PG8_LAS unsigned*)(lds + (bufoff) + ldsw + _i * 8192), 16, 0, 0); } while (0)
#define PG8_STAGEB(bufoff, gbase) do { _Pragma("unroll") for (int _i = 0; _i < 2; ++_i) \
        __builtin_amdgcn_global_load_lds((const unsigned*)((const char*)(gbase) + voffB[_i]), (PG8_LAS unsigned*)(lds + (bufoff) + ldsw + _i * 8192), 16, 0, Epi::B_AUX); } while (0)
#define PG8_LDA(dst, b, h) do { _Pragma("unroll") for (int m = 0; m < 4; ++m) _Pragma("unroll") for (int k = 0; k < 2; ++k) dst[m][k] = *(const PG8_LAS bf16x8*)(lds + PG8_SA(b, h) + aoff + m * 2048 + k * 1024); } while (0)
#define PG8_LDB(dst, b, h) do { _Pragma("unroll") for (int n = 0; n < 2; ++n) _Pragma("unroll") for (int k = 0; k < 2; ++k) dst[n][k] = *(const PG8_LAS bf16x8*)(lds + PG8_SB(b, h) + boff + n * 2048 + k * 1024); } while (0)
#define PG8_MMA(ai, bj, At, Bt) do { __builtin_amdgcn_s_setprio(1); _Pragma("unroll") for (int m = 0; m < 4; ++m) _Pragma("unroll") for (int n = 0; n < 2; ++n) _Pragma("unroll") for (int k = 0; k < 2; ++k) \
        acc[ai][bj][m][n] = __builtin_amdgcn_mfma_f32_16x16x32_bf16(Bt[n][k], At[m][k], acc[ai][bj][m][n], 0, 0, 0); __builtin_amdgcn_s_setprio(0); } while (0)
#define PG8_WAIT_V(n) asm volatile("s_waitcnt vmcnt(" #n ")" ::: "memory")
#define PG8_WAIT_VK do { if constexpr (HALF_N) asm volatile("s_waitcnt vmcnt(6)" ::: "memory"); else asm volatile("s_waitcnt vmcnt(8)" ::: "memory"); } while (0)
#define PG8_STAGE_B1(bufoff, gbase) do { if constexpr (!HALF_N) PG8_STAGEB(bufoff, gbase); } while (0)
#define PG8_LDB1(dst, b) do { if constexpr (!HALF_N) PG8_LDB(dst, b, 1); } while (0)
#define PG8_MMA1(ai, At, Bt) do { if constexpr (!HALF_N) PG8_MMA(ai, 1, At, Bt); } while (0)
#define PG8_WAIT_V1 do { if (!HALF_N && Epi::RELAX == 9 && rl) asm volatile("s_waitcnt vmcnt(17)" ::: "memory"); else PG8_WAIT_VK; } while (0)
#define PG8_WAIT_L(n) asm volatile("s_waitcnt lgkmcnt(" #n ")" ::: "memory")
#define PG8_BAR __builtin_amdgcn_s_barrier()
#define PG8_SCHED __builtin_amdgcn_sched_barrier(0)
    Unit cur, nxt; int ui = 0;
    if (!S.next(0, cur)) return;
    f32x4 acc[2][2][4][2];
    typename Epi::Aux aux;
    E.init(acc, cur, wr, wc, fr, fq);
    bf16x8 At[4][2], B0[2][2], B1[2][2];
    const char* cA = (const char*)g.A + (size_t)cur.pm * tstep; const char* cB = (const char*)g.Bt + (size_t)cur.pn * tstep + (HALF_N ? (size_t)cur.hb * hstepB : (size_t)0);
    S.a_ready(cur);
    if constexpr (SP2) {
        PG8_STAGEB(PG8_SB(0, 0), cB); PG8_STAGE_B1(PG8_SB(0, 1), cB + hstepB); PG8_STAGE(PG8_SA(0, 0), cA, voffA); PG8_STAGE(PG8_SA(0, 1), cA + hstepA, voffA);
        if (wr == 1) PG8_BAR;
        PG8_WAIT_V(2); PG8_BAR;
        PG8_STAGEB(PG8_SB(1, 0), cB + kstepB); PG8_STAGE(PG8_SA(1, 0), cA + kstepA, voffA); PG8_STAGE_B1(PG8_SB(1, 1), cB + hstepB + kstepB);
        if constexpr (HALF_N) PG8_WAIT_V(4); else PG8_WAIT_V(6);
        PG8_BAR;
    } else {
        PG8_STAGEB(PG8_SB(0, 0), cB); PG8_STAGE(PG8_SA(0, 0), cA, voffA); PG8_STAGEB(PG8_SB(0, 1), cB + hstepB); PG8_STAGE(PG8_SA(0, 1), cA + hstepA, voffA);
        if (wr == 1) PG8_BAR;
        PG8_WAIT_V(4); PG8_BAR;
        PG8_STAGEB(PG8_SB(1, 0), cB + kstepB); PG8_STAGE(PG8_SA(1, 0), cA + kstepA, voffA); PG8_STAGEB(PG8_SB(1, 1), cB + hstepB + kstepB);
        PG8_WAIT_V(6); PG8_BAR;
    }
    for (;;) {
        if constexpr (Epi::INIT_LOADS) {
#pragma unroll
            for (int a = 0; a < 2; ++a)
#pragma unroll
                for (int b = 0; b < (HALF_N ? 1 : 2); ++b)
#pragma unroll
                    for (int m = 0; m < 4; ++m) asm volatile("" : "+v"(acc[a][b][m][0]), "+v"(acc[a][b][m][1]));
        }
        E.aux_load(aux, cur, wr, wc, fr, fq);
        const bool has_next = S.next(ui + 1, nxt);
        const char* nA = has_next ? (const char*)g.A + (size_t)nxt.pm * tstep : cA; const char* nB = has_next ? (const char*)g.Bt + (size_t)nxt.pn * tstep + (HALF_N ? (size_t)nxt.hb * hstepB : (size_t)0) : cB;
        for (int t = 0; t < nt; t += 2) {
            const bool last = (t == nt - 2);
            const char* a1 = cA + (size_t)(t + 1) * kstepA;
            const char* a2 = last ? nA : cA + (size_t)(t + 2) * kstepA; const char* b2 = last ? nB : cB + (size_t)(t + 2) * kstepB;
            const char* a3 = a2 + kstepA; const char* b3 = b2 + kstepB;
            if (last && has_next) S.a_ready(nxt);
            int rl = __builtin_amdgcn_readfirstlane((int)((t == 0) & (ui > 0))); asm volatile("" : "+s"(rl));
            if constexpr (SP2) {
            PG8_LDB(B0, 0, 0); PG8_LDB1(B1, 0); PG8_SCHED; PG8_LDA(At, 0, 0); PG8_STAGE(PG8_SA(1, 1), a1 + hstepA, voffA);
            PG8_WAIT_V1; PG8_WAIT_L(0); PG8_BAR; PG8_MMA(0, 0, At, B0); PG8_MMA1(0, At, B1); PG8_BAR; PG8_SCHED;
            PG8_LDA(At, 0, 1); PG8_STAGEB(PG8_SB(0, 0), b2); PG8_STAGE_B1(PG8_SB(0, 1), b2 + hstepB); PG8_STAGE(PG8_SA(0, 0), a2, voffA);
            PG8_WAIT_V1; PG8_WAIT_L(0); PG8_BAR; PG8_MMA(1, 0, At, B0); PG8_MMA1(1, At, B1); PG8_BAR; PG8_SCHED;
            PG8_LDB(B0, 1, 0); PG8_LDB1(B1, 1); PG8_SCHED; PG8_LDA(At, 1, 0); PG8_STAGE(PG8_SA(0, 1), a2 + hstepA, voffA);
            PG8_WAIT_VK; PG8_WAIT_L(0); PG8_BAR; PG8_MMA(0, 0, At, B0); PG8_MMA1(0, At, B1); PG8_BAR; PG8_SCHED;
            PG8_LDA(At, 1, 1); PG8_STAGEB(PG8_SB(1, 0), b3); PG8_STAGE_B1(PG8_SB(1, 1), b3 + hstepB); PG8_STAGE(PG8_SA(1, 0), a3, voffA);
            PG8_WAIT_VK; PG8_WAIT_L(0); PG8_BAR; PG8_MMA(1, 0, At, B0); PG8_MMA1(1, At, B1); PG8_BAR; PG8_SCHED;
            } else {
            PG8_LDB(B0, 0, 0); PG8_SCHED; PG8_LDA(At, 0, 0); PG8_STAGE(PG8_SA(1, 1), a1 + hstepA, voffA);
            PG8_WAIT_L(8); PG8_BAR; PG8_WAIT_L(0); PG8_MMA(0, 0, At, B0); PG8_BAR; PG8_SCHED;
            PG8_LDB(B1, 0, 1); PG8_STAGEB(PG8_SB(0, 0), b2);
            PG8_BAR; PG8_WAIT_L(0); PG8_MMA(0, 1, At, B1); PG8_BAR;
            PG8_LDA(At, 0, 1); PG8_STAGE(PG8_SA(0, 0), a2, voffA);
            PG8_BAR; PG8_WAIT_L(0); PG8_MMA(1, 0, At, B0); PG8_BAR; PG8_SCHED;
            PG8_STAGEB(PG8_SB(0, 1), b2 + hstepB);
            PG8_WAIT_V(6); PG8_BAR; PG8_MMA(1, 1, At, B1); PG8_BAR;
            PG8_LDB(B0, 1, 0); PG8_SCHED; PG8_LDA(At, 1, 0); PG8_STAGE(PG8_SA(0, 1), a2 + hstepA, voffA);
            PG8_WAIT_L(8); PG8_BAR; PG8_WAIT_L(0); PG8_MMA(0, 0, At, B0); PG8_BAR; PG8_SCHED;
            PG8_LDB(B1, 1, 1); PG8_STAGEB(PG8_SB(1, 0), b3);
            PG8_BAR; PG8_WAIT_L(0); PG8_MMA(0, 1, At, B1); PG8_BAR;
            PG8_LDA(At, 1, 1); PG8_STAGE(PG8_SA(1, 0), a3, voffA);
            PG8_BAR; PG8_WAIT_L(0); PG8_MMA(1, 0, At, B0); PG8_BAR; PG8_SCHED;
            PG8_STAGEB(PG8_SB(1, 1), b3 + hstepB);
            PG8_WAIT_V(6); PG8_BAR; PG8_MMA(1, 1, At, B1); PG8_BAR;
            }
        }
        if constexpr (ALIGN_EPI) { if (wr == 0) PG8_BAR; }
        if constexpr (!Epi::AFTER_DRAIN) { E(acc, aux, cur, wr, wc, fr, fq); S.done(cur); }
        if (!has_next) break;
        E.init(acc, nxt, wr, wc, fr, fq);
        cur = nxt; cA = nA; cB = nB; ++ui;
        if constexpr (ALIGN_EPI) { if (wr == 1) PG8_BAR; }
    }
    PG8_WAIT_V(0);
    if constexpr (!ALIGN_EPI) { if (wr == 0) PG8_BAR; }
    PG8_BAR;
    if constexpr (Epi::AFTER_DRAIN) { E.fused(acc, cur, wr, wc, fr, fq, lds, wid, lane); S.done(cur); }
}
template <class Epi, class Sched>
__device__ __forceinline__ void gemm_phase_q(PG8_LAS unsigned char* lds, const Gemm g, const Sched& S, const Epi& E) {
    const int tid = threadIdx.x, wid = __builtin_amdgcn_readfirstlane(tid >> 6), lane = tid & 63, wr = wid >> 2, wc = wid & 3, fr = lane & 15, fq = lane >> 4;
    const int K = g.K, nt = K / BK;
    unsigned voffA[2], voffB[2];
#pragma unroll
    for (int i = 0; i < 2; ++i) { int R, C; stage_rc(tid * 16 + i * 8192, R, C); const int Rb = Epi::PERM ? ((R & ~31) + perm32(R & 31)) : R;
        voffA[i] = (unsigned)(R * K + C) * 2u; voffB[i] = (unsigned)(Rb * K + C) * 2u; }
    const size_t kstep = (size_t)(BK * 2), hstep = (size_t)HALF * K * 2, tstep = 2 * hstep;
    const unsigned ldsw = (unsigned)wid * 1024u;
    const int aoff = lds_byte(wr * 64 + fr, fq * 8), boff = lds_byte(wc * 32 + fr, fq * 8);
    Unit cur;
    if (!S.next(0, cur)) return;
    f32x4 acc[2][2][4][2];
    typename Epi::Aux aux;
    E.init(acc, cur, wr, wc, fr, fq);
    bf16x8 At[4][2], B0[2][2];
    const char* cA = (const char*)g.A + (size_t)cur.pm * tstep + (size_t)cur.hm * hstep; const char* cB = (const char*)g.Bt + (size_t)cur.pn * tstep + (size_t)cur.hb * hstep;
    S.a_ready(cur);
    PG8_STAGEB(PG8_SB(0, 0), cB); PG8_STAGE(PG8_SA(0, 0), cA, voffA);
    PG8_STAGEB(PG8_SB(0, 1), cB + kstep); PG8_STAGE(PG8_SA(0, 1), cA + kstep, voffA);
    PG8_STAGEB(PG8_SB(1, 0), cB + 2 * kstep); PG8_STAGE(PG8_SA(1, 0), cA + 2 * kstep, voffA);
    if (wr == 1) PG8_BAR;
    PG8_WAIT_V(8); PG8_BAR;
    PG8_BAR;
    if constexpr (Epi::INIT_LOADS) {
#pragma unroll
        for (int m = 0; m < 4; ++m) asm volatile("" : "+v"(acc[0][0][m][0]), "+v"(acc[0][0][m][1]));
    }
    E.aux_load(aux, cur, wr, wc, fr, fq);
#define PG8_SPQ(s, kt) do { const int _k = (kt) < nt ? (kt) : (kt) - nt; \
        PG8_LDB(B0, (s) >> 1, (s) & 1); PG8_SCHED; PG8_LDA(At, (s) >> 1, (s) & 1); \
        PG8_STAGE(PG8_SB((((s) + 3) & 3) >> 1, ((s) + 3) & 1), cB + (size_t)_k * kstep, voffB); PG8_STAGE(PG8_SA((((s) + 3) & 3) >> 1, ((s) + 3) & 1), cA + (size_t)_k * kstep, voffA); \
        PG8_WAIT_V(8); PG8_WAIT_L(0); PG8_BAR; PG8_MMA(0, 0, At, B0); PG8_BAR; PG8_SCHED; } while (0)
    for (int t = 0; t < nt; t += 4) { PG8_SPQ(0, t + 3); PG8_SPQ(1, t + 4); PG8_SPQ(2, t + 5); PG8_SPQ(3, t + 6); }
#undef PG8_SPQ
    if (wr == 0) PG8_BAR;
    E(acc, aux, cur, wr, wc, fr, fq); S.done(cur);
    PG8_WAIT_V(0);
    PG8_BAR;
#undef PG8_SA
#undef PG8_SB
#undef PG8_STAGE
#undef PG8_STAGEB
#undef PG8_LDA
#undef PG8_LDB
#undef PG8_MMA
#undef PG8_WAIT_V
#undef PG8_WAIT_V1
#undef PG8_WAIT_VK
#undef PG8_STAGE_B1
#undef PG8_LDB1
#undef PG8_MMA1
#undef PG8_WAIT_L
#undef PG8_BAR
#undef PG8_SCHED
}
}
#ifndef PG8_SP2
#define PG8_SP2 true
#endif
#ifndef PG8_ALIGN
#define PG8_ALIGN true
#endif
namespace mixp {
using pg8::bf16_t; using pg8::bf16x8; using pg8::u32x4; using pg8::u32x2; using pg8::ZP; using pg8::MP; using pg8::MT; using pg8::LOG2E;
typedef float f32x16 __attribute__((ext_vector_type(16)));
typedef short v4i16_t __attribute__((ext_vector_type(4)));
#define MX_LAS __attribute__((address_space(3)))
typedef MX_LAS unsigned char* lptr;
constexpr int KR_OFF = 0, VR_OFF = 49152, OST_OFF = 98304;
constexpr int N_ATT_P = 32 * 3 * 32, N_ATT = N_ATT_P + 32 * 3, N_POOL_P = 32 * 32, N_UNITS = N_ATT + N_POOL_P + 32;
typedef float f32x2_t __attribute__((ext_vector_type(2))); typedef __bf16 bf16x2_t __attribute__((ext_vector_type(2)));
__device__ __forceinline__ unsigned pk_bf16(float lo, float hi) { f32x2_t v = {lo, hi}; bf16x2_t b = __builtin_convertvector(v, bf16x2_t); return __builtin_bit_cast(unsigned, b); }
__device__ __forceinline__ float bf_lo(unsigned w) { return __uint_as_float(w << 16); }
__device__ __forceinline__ float bf_hi(unsigned w) { return __uint_as_float(w & 0xffff0000u); }
__device__ __forceinline__ v4i16_t vtr(lptr p) { return __builtin_amdgcn_ds_read_tr16_b64_v4i16((MX_LAS v4i16_t*)p); }

struct AUnit { bool samp; int b, c, kvh, row0; };
__device__ __forceinline__ AUnit pool_decode(int j) { AUnit u; u.samp = j >= N_POOL_P; u.b = u.samp ? j - N_POOL_P : j >> 5; u.c = u.samp ? 0 : (j & 31); u.kvh = 0; u.row0 = u.samp ? MP + u.b * 64 : u.b * 2048 + 64 * u.c; return u; }
__device__ __forceinline__ void glds16(const void* gsrc, unsigned lds_dst) { unsigned keep;
    asm volatile("s_mov_b32 %0, m0\n\ts_mov_b32 m0, %2\n\ts_nop 0\n\tglobal_load_lds_dwordx4 %1, off\n\ts_mov_b32 m0, %0" : "=&s"(keep) : "v"(gsrc), "s"(lds_dst) : "memory"); }
#define MX_GLDS(src, dst) glds16((src), (unsigned)__builtin_amdgcn_readfirstlane((int)(unsigned)(uintptr_t)(dst)))

__device__ __forceinline__ void attn_issue_chunk(lptr ring, int slot, int j, const bf16_t* Z, const bf16_t* CK, const bf16_t* CV, const AUnit& u, int wid, int lane) {
    const int kkey = 8 * wid + (lane >> 3), kch = (lane & 7) ^ ((lane >> 3) & 7);
    const int vdh = wid >> 2, vkey = 16 * (wid & 3) + (lane >> 2), vch = 4 * vdh + (lane & 3);
    const bf16_t *ks, *vs;
    if (u.samp && j < 2) { const size_t o = (size_t)(u.b * 128 + 64 * j) * 192 + 64 * u.kvh; ks = CK + o + (size_t)kkey * 192 + 8 * kch; vs = CV + o + (size_t)vkey * 192 + 8 * vch; }
    else { const bool valid = u.samp || (u.c - 2 + j >= 0); const int rb = valid ? u.row0 - 128 + 64 * j : u.row0;
        ks = Z + (size_t)(16 + u.kvh) * MT * 64 + pg8::zsub_off(rb + kkey, 8 * kch); vs = Z + (size_t)(19 + u.kvh) * MT * 64 + pg8::zsub_off(rb + vkey, 8 * vch); }
    MX_GLDS(ks, ring + KR_OFF + slot * 8192 + wid * 1024);
    MX_GLDS(vs, ring + VR_OFF + slot * 8192 + wid * 1024);
}
__device__ __forceinline__ void attn_qload(bf16x8 (&q)[4], const bf16_t* Z, const AUnit& u, int wid, int lane) {
    const bf16_t* qp = Z + (size_t)(4 + 4 * u.kvh + (wid >> 1)) * MT * 64 + pg8::zsub_off(u.row0 + 32 * (wid & 1) + (lane & 31), 8 * (lane >> 5));
#pragma unroll
    for (int ks = 0; ks < 4; ++ks) q[ks] = __builtin_nontemporal_load((const bf16x8*)(qp + 512 * (ks >> 1) + 16 * (ks & 1)));
}
__device__ __forceinline__ void attn_compute(lptr ring, int sl0, int sl1, int sl2, const bf16x8 (&qr)[4], bf16_t* MIX, float sink2, const AUnit& u, int wid, int lane) {
    const int slb[3] = {sl0 * 8192, sl1 * 8192, sl2 * 8192};
    const int r32 = lane & 31, hi = lane >> 5, g = wid >> 1, qh = wid & 1, hq = 4 * u.kvh + g;
    const float slope2 = __builtin_amdgcn_exp2f(-8.0f * (float)(hq + 1) * (1.0f / 12.0f)) * LOG2E;
    const float qb = (float)(32 * qh + r32 + 128 - 4 * hi);
    const float nsq = -slope2 * qb;
    f32x16 p[6];
#pragma unroll
    for (int kb = 0; kb < 6; ++kb) {
        const bool valid = u.samp || (u.c - 2 + (kb >> 1) >= 0);
#pragma unroll
        for (int r = 0; r < 16; ++r) { const float cst = (float)(32 * kb + (r & 3) + 8 * (r >> 2));
            const float bias = kb < 4 ? __builtin_fmaf(slope2, cst, nsq) : -slope2 * __builtin_fabsf(qb - cst);
            p[kb][r] = valid ? bias : -1e30f; }
#pragma unroll
        for (int ks = 0; ks < 4; ++ks) {
            const bf16x8 kf = *(const MX_LAS bf16x8*)(ring + KR_OFF + slb[kb >> 1] + (32 * (kb & 1) + r32) * 128 + (((2 * ks + hi) ^ (r32 & 7)) << 4));
            p[kb] = __builtin_amdgcn_mfma_f32_32x32x16_bf16(kf, qr[ks], p[kb], 0, 0, 0);
        }
    }
    float sum = 0.f;
#pragma unroll
    for (int kb = 0; kb < 6; ++kb)
#pragma unroll
        for (int r = 0; r < 16; ++r) { p[kb][r] = __builtin_amdgcn_exp2f(p[kb][r]); sum += p[kb][r]; }
    sum += __shfl_xor(sum, 32);
    sum += __builtin_amdgcn_exp2f(sink2);
    const float inv = 1.0f / sum;
    f32x16 o[2];
#pragma unroll
    for (int r = 0; r < 16; ++r) { o[0][r] = 0.f; o[1][r] = 0.f; }
    const lptr vb = ring + VR_OFF + ((lane >> 4) & 1) * 32 + (lane & 3) * 8 + (4 * hi + ((lane & 15) >> 2)) * 64;
#pragma unroll
    for (int kb = 0; kb < 6; ++kb)
#pragma unroll
        for (int s = 0; s < 2; ++s) {
            u32x4 pw;
            pw.x = pk_bf16(p[kb][8 * s + 0], p[kb][8 * s + 1]); pw.y = pk_bf16(p[kb][8 * s + 2], p[kb][8 * s + 3]);
            pw.z = pk_bf16(p[kb][8 * s + 4], p[kb][8 * s + 5]); pw.w = pk_bf16(p[kb][8 * s + 6], p[kb][8 * s + 7]);
            const bf16x8 pf = __builtin_bit_cast(bf16x8, pw);
#pragma unroll
            for (int db = 0; db < 2; ++db) {
                const v4i16_t lo = vtr(vb + slb[kb >> 1] + db * 4096 + (32 * (kb & 1) + 16 * s) * 64), hh = vtr(vb + slb[kb >> 1] + db * 4096 + (32 * (kb & 1) + 16 * s + 8) * 64);
                const bf16x8 vf = (bf16x8){lo[0], lo[1], lo[2], lo[3], hh[0], hh[1], hh[2], hh[3]};
                o[db] = __builtin_amdgcn_mfma_f32_32x32x16_bf16(vf, pf, o[db], 0, 0, 0);
            }
        }
    const lptr st = ring + OST_OFF + wid * 4096;
#pragma unroll
    for (int db = 0; db < 2; ++db)
#pragma unroll
        for (int rg = 0; rg < 4; ++rg) { u32x2 w; w.x = pk_bf16(o[db][4 * rg] * inv, o[db][4 * rg + 1] * inv); w.y = pk_bf16(o[db][4 * rg + 2] * inv, o[db][4 * rg + 3] * inv);
            *(MX_LAS u32x2*)(st + r32 * 128 + (((4 * db + rg) ^ (r32 & 7)) << 4) + 8 * hi) = w; }
    asm volatile("s_waitcnt lgkmcnt(0)" ::: "memory");
    bf16_t* op = MIX + ((size_t)(u.row0 >> 8) * 16 + 4 + hq) * (256 * 64);
#pragma unroll
    for (int i = 0; i < 4; ++i) { const int row = 8 * i + (lane >> 3); const u32x4 v = *(const MX_LAS u32x4*)(st + row * 128 + (((lane & 7) ^ (row & 7)) << 4)); *(u32x4*)(op + pg8::img_off((u.row0 & 255) + 32 * qh + row, 8 * (lane & 7))) = v; }
}

__device__ __forceinline__ void pool_issue(lptr buf, const bf16_t* Z, const bf16_t* CP, const bf16_t* ZERO, const AUnit& u, int wid, int lane) {
#pragma unroll
    for (int j = 0; j < 5; ++j) {
        const int p = wid + 8 * j, ri = 2 * p + (lane >> 5), rc = ri > 78 ? 78 : ri, ch = (lane & 31) ^ (ri & 15);
        const bf16_t* src = Z + (size_t)(ch >> 3) * MT * 64 + pg8::zsub_off(u.row0 + rc - 15, 8 * (ch & 7));
        if (ri < 15) { if (u.samp) src = CP + (size_t)(u.b * 15 + ri) * 256 + 8 * ch; else if (u.c == 0) src = ZERO + 8 * (lane & 31); }
        MX_GLDS(src, buf + p * 1024);
    }
}
__device__ __forceinline__ void pool_compute(lptr buf, const bf16x8 (&wf)[2][4], bf16_t* MIX, const AUnit& u, int wid, int lane) {
    const int r32 = lane & 31, hi = lane >> 5;
    const int g = wid >> 1, hh = wid & 1, W = 2 << g, t = 32 * hh + r32;
    const int pos = u.samp ? 4096 + t : 64 * u.c + t;
    const float icnt = 1.0f / (float)((pos + 1 < W) ? pos + 1 : W);
    bf16x8 df[4];
#pragma unroll
    for (int ks = 0; ks < 4; ++ks) {
        const int chunk = 8 * g + 2 * ks + hi;
        float a[8]; u32x4 cur = (u32x4){0u, 0u, 0u, 0u};
#pragma unroll
        for (int e = 0; e < 8; ++e) a[e] = 0.f;
        for (int i = 0; i < W; ++i) {
            const int ri = t + 15 - i;
            const u32x4 v = *(const MX_LAS u32x4*)(buf + ri * 512 + ((chunk ^ (ri & 15)) << 4));
            a[0] += bf_lo(v.x); a[1] += bf_hi(v.x); a[2] += bf_lo(v.y); a[3] += bf_hi(v.y); a[4] += bf_lo(v.z); a[5] += bf_hi(v.z); a[6] += bf_lo(v.w); a[7] += bf_hi(v.w);
            if (i == 0) cur = v;
        }
        u32x4 dw;
        dw.x = pk_bf16(a[0] * icnt - bf_lo(cur.x), a[1] * icnt - bf_hi(cur.x)); dw.y = pk_bf16(a[2] * icnt - bf_lo(cur.y), a[3] * icnt - bf_hi(cur.y));
        dw.z = pk_bf16(a[4] * icnt - bf_lo(cur.z), a[5] * icnt - bf_hi(cur.z)); dw.w = pk_bf16(a[6] * icnt - bf_lo(cur.w), a[7] * icnt - bf_hi(cur.w));
        df[ks] = __builtin_bit_cast(bf16x8, dw);
    }
    bf16_t* op = MIX + ((size_t)(u.row0 >> 8) * 16 + g) * (256 * 64);
#pragma unroll
    for (int eb = 0; eb < 2; ++eb) {
        f32x16 o;
#pragma unroll
        for (int r = 0; r < 16; ++r) o[r] = 0.f;
#pragma unroll
        for (int ks = 0; ks < 4; ++ks) o = __builtin_amdgcn_mfma_f32_32x32x16_bf16(wf[eb][ks], df[ks], o, 0, 0, 0);
#pragma unroll
        for (int rg = 0; rg < 4; ++rg) { u32x2 w; w.x = pk_bf16(o[4 * rg], o[4 * rg + 1]); w.y = pk_bf16(o[4 * rg + 2], o[4 * rg + 3]); *(u32x2*)(op + pg8::img_off((u.row0 & 255) + t, 32 * eb + 8 * rg + 4 * hi)) = w; }
    }
}

#define MX_SYNC() do { asm volatile("s_waitcnt vmcnt(0) lgkmcnt(0)" ::: "memory"); __builtin_amdgcn_s_barrier(); asm volatile("" ::: "memory"); } while (0)
__device__ __forceinline__ void mix_phase(lptr lds, const bf16_t* Z, const bf16_t* CK, const bf16_t* CV, const bf16_t* CP, const bf16_t* WPt, const bf16_t* ZERO, bf16_t* MIX, const float* sinks, int first, int stride) {
    const int tid = threadIdx.x, lane = tid & 63, wid = __builtin_amdgcn_readfirstlane(tid >> 6);
    constexpr int PBUF = 40960;
    constexpr int NRUN_P = 32 * 3 * 8, NRUN = NRUN_P + 32 * 3;
    int par = 0;
    if (first < NRUN) {
        const int g = wid >> 1;
        float sk0 = sinks[g] * LOG2E, sk1 = sinks[4 + g] * LOG2E, sk2 = sinks[8 + g] * LOG2E;
        asm volatile("" : "+v"(sk0), "+v"(sk1), "+v"(sk2));
        int run = first, st = 0, head = 0;
        auto unit_of = [](int run, int st) { AUnit u; u.samp = run >= NRUN_P; const int rr = u.samp ? run : NRUN_P - 1 - run;     const int a = u.samp ? run - NRUN_P : rr >> 3; u.b = a / 3; u.kvh = a % 3; u.c = u.samp ? 0 : 4 * (rr & 7) + st;
                                              u.row0 = u.samp ? MP + u.b * 64 : u.b * 2048 + 64 * u.c; return u; };
        bf16x8 qn[4];
        AUnit u = unit_of(run, 0);
        int s0 = 0, s1 = 1, s2 = 2; head = 3;
        attn_issue_chunk(lds, 0, 0, Z, CK, CV, u, wid, lane); attn_issue_chunk(lds, 1, 1, Z, CK, CV, u, wid, lane); attn_issue_chunk(lds, 2, 2, Z, CK, CV, u, wid, lane);
        attn_qload(qn, Z, u, wid, lane);
        for (;;) {
            MX_SYNC();
            bf16x8 qr[4];
#pragma unroll
            for (int ks = 0; ks < 4; ++ks) qr[ks] = qn[ks];
            asm volatile("" : "+v"(qr[0]), "+v"(qr[1]), "+v"(qr[2]), "+v"(qr[3]));
            int nrun = run, nst = st + 1; const int len = (run >= NRUN_P) ? 1 : 4;
            if (nst == len) { nrun = run + stride; nst = 0; }
            const bool more = nrun < NRUN;
            int n0 = s1, n1 = s2, n2 = head;
            AUnit un = u;
            if (more) {
                un = unit_of(nrun, nst);
                if (nst == 0) { n0 = head; n1 = head + 1 >= 6 ? head - 5 : head + 1; n2 = head + 2 >= 6 ? head - 4 : head + 2;
                    attn_issue_chunk(lds, n0, 0, Z, CK, CV, un, wid, lane); attn_issue_chunk(lds, n1, 1, Z, CK, CV, un, wid, lane); attn_issue_chunk(lds, n2, 2, Z, CK, CV, un, wid, lane);
                    head = head + 3 >= 6 ? head - 3 : head + 3; }
                else { attn_issue_chunk(lds, n2, 2, Z, CK, CV, un, wid, lane); head = head + 1 >= 6 ? 0 : head + 1; }
                attn_qload(qn, Z, un, wid, lane);
            }
            attn_compute(lds, s0, s1, s2, qr, MIX, u.kvh == 0 ? sk0 : (u.kvh == 1 ? sk1 : sk2), u, wid, lane);
            if (!more) break;
            run = nrun; st = nst; u = un; s0 = n0; s1 = n1; s2 = n2;
        }
    }
    MX_SYNC();
    int pj = first >= 96 ? first - 96 : first + stride - 96; par = 0;
    if (pj < N_POOL_P + 32) {
        bf16x8 wf[2][4];
#pragma unroll
        for (int eb = 0; eb < 2; ++eb)
#pragma unroll
            for (int ks = 0; ks < 4; ++ks) wf[eb][ks] = *(const bf16x8*)(WPt + (size_t)(((wid >> 1) * 64 + 32 * eb + (lane & 31)) * 64 + 16 * ks + 8 * (lane >> 5)));
        pool_issue(lds, Z, CP, ZERO, pool_decode(pj), wid, lane);
        for (; pj < N_POOL_P + 32; pj += stride, par ^= 1) {
            const AUnit u = pool_decode(pj);
            MX_SYNC();
            if (pj + stride < N_POOL_P + 32) pool_issue(lds + (par ^ 1) * PBUF, Z, CP, ZERO, pool_decode(pj + stride), wid, lane);
            pool_compute(lds + par * PBUF, wf, MIX, u, wid, lane);
        }
    }
    MX_SYNC();
}
#undef MX_SYNC
#undef MX_GLDS
#undef MX_LAS
}
constexpr int NWAVES = 8;
#ifndef MK_N_LAUNCHES
#define MK_N_LAUNCHES 1
#endif
constexpr int N_LAUNCHES = MK_N_LAUNCHES;
constexpr int PER_PHASE = 6;
#ifndef MK_P5_LAG
#define MK_P5_LAG 900
#endif
constexpr int P5_LAG = MK_P5_LAG;

constexpr size_t MiB = 1u << 20;
constexpr size_t WS_CTL = 0, CTL_ZERO_BYTES = 64 * 1024, WS_ZERO = 512 * 1024, WS_SS = 1 * MiB;
constexpr size_t WS_WIN = 2 * MiB, WS_WOUT = 5 * MiB, WS_WGU = 7 * MiB, WS_WD = 18 * MiB;
constexpr size_t WS_WP = 24 * MiB, WS_CK = 25 * MiB, WS_CV = 27 * MiB, WS_CP = 29 * MiB;
constexpr size_t WS_RX = 30 * MiB;
constexpr size_t WS_XB = 32 * MiB;
constexpr size_t WS_Z = 164 * MiB;
constexpr size_t WS_MIX = 346 * MiB;
constexpr size_t WS_ACT = 478 * MiB;
constexpr size_t WS_HB = 842 * MiB;
constexpr size_t WS_END = 974 * MiB;
static_assert(WS_SS + (size_t)67584 * 4 <= WS_WIN && WS_WD + (size_t)1024 * 2816 * 2 <= WS_WP && WS_XB + (size_t)67584 * 1024 * 2 <= WS_Z && WS_Z + (size_t)67584 * 1408 * 2 <= WS_MIX &&
              WS_MIX + (size_t)67584 * 1024 * 2 <= WS_ACT && WS_ACT + (size_t)67584 * 2816 * 2 <= WS_HB && WS_HB + (size_t)67584 * 1024 * 2 <= WS_END && WS_RX + (size_t)67584 * 4 <= WS_XB, "d_ws map");
constexpr int CW_TMO = 0, CW_CODE = 1;
constexpr int CW_BAR = 4096;
constexpr int RING_OFF = 0, RING_BYTES = 131072;
constexpr int LDSCTL_OFF = RING_BYTES, MISC_OFF = LDSCTL_OFF + 320;
constexpr int STAGE_OFF = LDSCTL_OFF + 1024;
constexpr int JUNK_OFF = STAGE_OFF + 16384;
constexpr int LDS_BYTES = STAGE_OFF + 16384;
static_assert(MISC_OFF + 128 <= LDS_BYTES, "LDS map");

#define GAS __attribute__((address_space(1)))
#define LAS __attribute__((address_space(3)))
typedef unsigned short bf16;
typedef unsigned v4u __attribute__((ext_vector_type(4)));
typedef float f32x4 __attribute__((ext_vector_type(4)));
typedef short bf16x8 __attribute__((ext_vector_type(8)));
typedef GAS unsigned gu32;
typedef GAS unsigned long long gu64;
#define RLX_AGENT __ATOMIC_RELAXED, __HIP_MEMORY_SCOPE_AGENT
#define LDS_WAIT() asm volatile("s_waitcnt lgkmcnt(0)" ::: "memory")
#define VM_WAIT() asm volatile("s_waitcnt vmcnt(0)" ::: "memory")
__device__ __forceinline__ unsigned long long rt() { return __builtin_amdgcn_s_memrealtime(); }
__device__ __forceinline__ unsigned f2bf(float f) { unsigned u = __builtin_bit_cast(unsigned, f); return (u + 0x7fffu + ((u >> 16) & 1u)) >> 16; }
__device__ __forceinline__ unsigned pk2(float lo, float hi) { return f2bf(lo) | (f2bf(hi) << 16); }

#define XB_TMO      128
#define XB_XCNT(j)  (256  + 64 * (j))
#define XB_XSUB(j)  (1280 + 64 * (j))
#define XB_XGEN(j)  (2304 + 64 * (j))
#define XB_TOP      3328
#define XB_TOPGEN   3392
#define XCD_BAR_WORDS 3456
#define XB_SPIN_CAP (1u << 18)

__device__ __forceinline__ unsigned xb_ld(unsigned* p)              { return __hip_atomic_load(p, __ATOMIC_RELAXED, __HIP_MEMORY_SCOPE_AGENT); }
__device__ __forceinline__ unsigned xb_add(unsigned* p, unsigned v) { return __hip_atomic_fetch_add(p, v, __ATOMIC_RELAXED, __HIP_MEMORY_SCOPE_AGENT); }
__device__ __forceinline__ unsigned xb_xcc_id() { return (unsigned)__builtin_amdgcn_s_getreg((3 << 11) | 20) & 0xFu; }
#define XB_SPIN(cond, bar) do { unsigned _sp = 0; while (cond) { __builtin_amdgcn_s_sleep(1); \
    if ((++_sp & 255u) == 0u) { if (xb_ld(&(bar)[XB_TMO])) break; if (_sp > XB_SPIN_CAP) { atomicAdd(&(bar)[XB_TMO], 1u); break; } } } } while (0)

struct XcdBarrier {
    unsigned* bar; unsigned x;
    volatile LAS unsigned* st;
};

__device__ __forceinline__ XcdBarrier xcd_barrier_post(unsigned* bar, volatile LAS unsigned* st) {
    XcdBarrier b; b.bar = bar; b.x = xb_xcc_id(); b.st = st;
    if (threadIdx.x == 0) (void)xb_add(&bar[XB_XCNT(b.x)], 1u);
    return b;
}
__device__ __forceinline__ void xcd_barrier_complete(unsigned* bar, unsigned x, unsigned& nloc, unsigned& nx) {
    const unsigned G = gridDim.x * gridDim.y * gridDim.z;
    unsigned sum, cnt, mine, sp = 0u;
    for (;;) {
        sum = 0u; cnt = 0u; mine = 0u;
#pragma unroll
        for (unsigned j = 0; j < 16; ++j) { const unsigned c = xb_ld(&bar[XB_XCNT(j)]); sum += c; cnt += (c > 0u) ? 1u : 0u; mine = (j == x) ? c : mine; }
        if (sum == G) break;
        __builtin_amdgcn_s_sleep(1);
        if ((++sp & 255u) == 0u) { if (xb_ld(&bar[XB_TMO])) break; if (sp > XB_SPIN_CAP) { atomicAdd(&bar[XB_TMO], 1u); break; } }
    }
    nloc = mine > 0u ? mine : 1u; nx = cnt > 0u ? cnt : 1u;
}

__device__ __forceinline__ void xcd_barrier(const XcdBarrier& b) {
    asm volatile("s_waitcnt vmcnt(0)" ::: "memory");
    __syncthreads();
    if (threadIdx.x == 0) {
        unsigned* bar = b.bar;
        __builtin_amdgcn_s_waitcnt(0);
        unsigned nloc = b.st[0], nx = b.st[1];
        if (nloc == 0u) { xcd_barrier_complete(bar, b.x, nloc, nx); b.st[0] = nloc; b.st[1] = nx; }
        const unsigned old = xb_add(&bar[XB_XSUB(b.x)], 1u);
        const unsigned gen = old / nloc;
        if (old + 1u == (gen + 1u) * nloc) {
            __builtin_amdgcn_fence(__ATOMIC_RELEASE, "agent");
            asm volatile("s_waitcnt vmcnt(0)" ::: "memory");
            const unsigned og = xb_add(&bar[XB_TOP], 1u);
            const unsigned tg = og / nx;
            if (og + 1u == (tg + 1u) * nx) xb_add(&bar[XB_TOPGEN], 1u);
            else XB_SPIN(xb_ld(&bar[XB_TOPGEN]) == tg, bar);
            __builtin_amdgcn_fence(__ATOMIC_ACQUIRE, "agent");
            xb_add(&bar[XB_XGEN(b.x)], 1u);
            asm volatile("s_waitcnt vmcnt(0)" ::: "memory");
        } else {
            XB_SPIN(xb_ld(&bar[XB_XGEN(b.x)]) == gen, bar);
            __builtin_amdgcn_fence(__ATOMIC_ACQUIRE, "agent");
            asm volatile("s_waitcnt vmcnt(0)" ::: "memory");
        }
    }
    __syncthreads();
}
struct Frame {
    LAS unsigned char* lds;
    volatile LAS unsigned* MISC;
    gu32* ctl;
    int tid, lane, wave;
    int vcu, G;
};

__device__ __forceinline__ float wave_sum(float v) {
#pragma unroll
    for (int o = 1; o < 64; o <<= 1) v += __shfl_xor(v, o);
    return v;
}
__device__ __forceinline__ void p0_transpose_item(const float* W, const float* gain, int K, int N, bf16* WT, int k0, int n0, int drow0, LAS float* scr, int lane) {
#pragma unroll 8
    for (int i = 0; i < 32; ++i) { const int kk = 2 * i + (lane >> 5); float w = __builtin_nontemporal_load(W + (size_t)(k0 + kk) * N + n0 + (lane & 31)); if (gain) w *= gain[k0 + kk]; scr[kk * 33 + (lane & 31)] = w; }
    LDS_WAIT(); asm volatile("" ::: "memory");
    const int c = lane & 7;
#pragma unroll
    for (int j = 0; j < 4; ++j) { const int n = (lane >> 3) + 8 * j; const LAS float* s = scr + (8 * c) * 33 + n;
        v4u o; o.x = pk2(s[0 * 33], s[1 * 33]); o.y = pk2(s[2 * 33], s[3 * 33]); o.z = pk2(s[4 * 33], s[5 * 33]); o.w = pk2(s[6 * 33], s[7 * 33]);
        const int row = drow0 + n, wr7 = row & 127, slot = (wr7 & ~31) + pg8::inv_perm32(wr7 & 31);
        *(GAS v4u*)((GAS char*)WT + ((size_t)((row >> 8) * (K >> 6) + (k0 >> 6)) * 2 + ((row >> 7) & 1)) * pg8::HTB + pg8::lds_byte(slot, 8 * c)) = o; }
    LDS_WAIT(); asm volatile("" ::: "memory");
}
__device__ __forceinline__ void x_rows2_to_bf16(const float* xa, const float* xb, bf16* oa, bf16* ob, float* ra, float* rb, int lane) {
    const GAS f32x4* pa = (const GAS f32x4*)xa + lane; const GAS f32x4* pb = (const GAS f32x4*)xb + lane;
    f32x4 va[4], vb[4]; float sa = 0.f, sb = 0.f;
#pragma unroll
    for (int j = 0; j < 4; ++j) { va[j] = __builtin_nontemporal_load(pa + 64 * j); vb[j] = __builtin_nontemporal_load(pb + 64 * j); }
#pragma unroll
    for (int j = 0; j < 4; ++j) { sa += (va[j].x * va[j].x + va[j].y * va[j].y) + (va[j].z * va[j].z + va[j].w * va[j].w); sb += (vb[j].x * vb[j].x + vb[j].y * vb[j].y) + (vb[j].z * vb[j].z + vb[j].w * vb[j].w); }
    GAS unsigned long long* qa = (GAS unsigned long long*)oa + lane; GAS unsigned long long* qb = (GAS unsigned long long*)ob + lane;
#pragma unroll
    for (int j = 0; j < 4; ++j) { qa[64 * j] = (unsigned long long)pk2(va[j].x, va[j].y) | ((unsigned long long)pk2(va[j].z, va[j].w) << 32);
                                  qb[64 * j] = (unsigned long long)pk2(vb[j].x, vb[j].y) | ((unsigned long long)pk2(vb[j].z, vb[j].w) << 32); }
    const float r1 = 1.f / sqrtf(wave_sum(sa) * (1.f / 1024.f) + 1e-6f), r2 = 1.f / sqrtf(wave_sum(sb) * (1.f / 1024.f) + 1e-6f);
    if (lane == 0) { *ra = r1; *rb = r2; }
}
struct P0Args { const float *xp, *xs, *cpool, *ck, *cv, *norm_mix, *w_in, *w_pool, *pool_scale, *w_out, *norm_ffn, *w_gate, *w_up, *w_down; float* out;
                bf16 *Win_t, *Wout_t, *Wgu_t, *Wd_t, *WPt, *CK, *CV, *CP, *XB; float* RX; float* SS; float* ZERO; };
__device__ __forceinline__ void p0_prologue(Frame& F, const P0Args& A) {
    LAS float* scr = (LAS float*)(F.lds + RING_OFF + F.wave * 16384);
    const int gw = F.vcu * NWAVES + F.wave, NGW = F.G * NWAVES;
    constexpr int I_IN = 16 * 44, I_OUT = 16 * 32, I_G = 16 * 88, I_D = 44 * 32, NITEMS = I_IN + I_OUT + 2 * I_G + I_D;
    for (int it = gw; it < NITEMS; it += NGW) {
        int r = it;
        if (r < I_IN) { const int kb = r / 44, nb = r % 44, n0 = 32 * nb, lc = n0 & 255, dd = lc & 63;
            p0_transpose_item(A.w_in, A.norm_mix, 1024, 1408, A.Win_t, 64 * kb, n0, n0 >= 1280 ? n0 : (n0 & ~255) + 128 * (dd >> 5) + 32 * (lc >> 6), scr, F.lane); continue; } r -= I_IN;
        if (r < I_OUT) { const int kb = r / 32, nb = r % 32; p0_transpose_item(A.w_out, nullptr, 1024, 1024, A.Wout_t, 64 * kb, 32 * nb, 32 * nb, scr, F.lane); continue; } r -= I_OUT;
        if (r < I_G) { const int kb = r / 88, nb = r % 88, n0 = 32 * nb;
            p0_transpose_item(A.w_gate, A.norm_ffn, 1024, 2816, A.Wgu_t, 64 * kb, n0, 256 * (n0 >> 7) + (n0 & 127), scr, F.lane); continue; } r -= I_G;
        if (r < I_G) { const int kb = r / 88, nb = r % 88, n0 = 32 * nb;
            p0_transpose_item(A.w_up, A.norm_ffn, 1024, 2816, A.Wgu_t, 64 * kb, n0, 256 * (n0 >> 7) + 128 + (n0 & 127), scr, F.lane); continue; } r -= I_G;
        { const int kb = r / 32, nb = r % 32; p0_transpose_item(A.w_down, nullptr, 2816, 1024, A.Wd_t, 64 * kb, 32 * nb, 32 * nb, scr, F.lane); }
    }
    __syncthreads();
    {
        constexpr int RS = 2112, NG = pg8::MT / 16;
        LAS unsigned char* stg = F.lds + RING_OFF;
        f32x4 va[4], vb[4];
        int grp = F.vcu;
        auto issue = [&](int g) { const int r = 16 * g + 2 * F.wave; const float* xa = r < pg8::MP ? A.xp + (size_t)r * 1024 : A.xs + (size_t)(r - pg8::MP) * 1024;
            const GAS f32x4* pa = (const GAS f32x4*)xa + F.lane;
#pragma unroll
            for (int j = 0; j < 4; ++j) { va[j] = __builtin_nontemporal_load(pa + 64 * j); vb[j] = __builtin_nontemporal_load(pa + 256 + 64 * j); } };
        if (grp < NG) issue(grp);
        for (; grp < NG; grp += F.G) {
            const int r = 16 * grp + 2 * F.wave;
            float sa = 0.f, sb = 0.f;
#pragma unroll
            for (int j = 0; j < 4; ++j) { sa += (va[j].x * va[j].x + va[j].y * va[j].y) + (va[j].z * va[j].z + va[j].w * va[j].w); sb += (vb[j].x * vb[j].x + vb[j].y * vb[j].y) + (vb[j].z * vb[j].z + vb[j].w * vb[j].w); }
            LAS unsigned long long* la = (LAS unsigned long long*)(stg + (2 * F.wave) * RS) + F.lane; LAS unsigned long long* lb = (LAS unsigned long long*)(stg + (2 * F.wave + 1) * RS) + F.lane;
#pragma unroll
            for (int j = 0; j < 4; ++j) { la[64 * j] = (unsigned long long)pk2(va[j].x, va[j].y) | ((unsigned long long)pk2(va[j].z, va[j].w) << 32);
                                          lb[64 * j] = (unsigned long long)pk2(vb[j].x, vb[j].y) | ((unsigned long long)pk2(vb[j].z, vb[j].w) << 32); }
            if (grp + F.G < NG) issue(grp + F.G);
            const float r1 = 1.f / sqrtf(wave_sum(sa) * (1.f / 1024.f) + 1e-6f), r2 = 1.f / sqrtf(wave_sum(sb) * (1.f / 1024.f) + 1e-6f);
            if (F.lane == 0) { A.RX[r] = r1; A.RX[r + 1] = r2; }
            __syncthreads();
            GAS unsigned char* blk = (GAS unsigned char*)A.XB + ((size_t)(grp >> 4) * 16 * 2 + ((grp >> 3) & 1)) * pg8::HTB + (size_t)(grp & 7) * 2048;
            const int pb = F.lane * 16, ob = pb ^ (((pb >> 9) & 1) << 5), rr = ob >> 6, cc = (ob & 63) >> 1;
#pragma unroll
            for (int q = 0; q < 4; ++q) { const int st = F.wave + 8 * q, kt = st >> 1, ch = st & 1;
                const v4u val = *(const LAS v4u*)(stg + rr * RS + (kt * 64 + ch * 32 + cc) * 2);
                *(GAS v4u*)(blk + (size_t)kt * (2 * pg8::HTB) + ch * 1024 + pb) = val; }
            __syncthreads();
        }
    }
    const int gt = gw * 64 + F.lane, NGT = NGW * 64;
    for (int i = gt; i < 4 * 64 * 64; i += NGT) { const int g = i >> 12, e = (i >> 6) & 63, c = i & 63;
        A.WPt[i] = (bf16)f2bf(A.w_pool[(g * 64 + c) * 64 + e] * A.pool_scale[64 * g + e]); }
    for (int i = gt; i < 32 * 128 * 192 / 4; i += NGT) {
        const f32x4 k4 = ((const GAS f32x4*)A.ck)[i], v4 = ((const GAS f32x4*)A.cv)[i];
        ((GAS unsigned long long*)A.CK)[i] = (unsigned long long)pk2(k4.x, k4.y) | ((unsigned long long)pk2(k4.z, k4.w) << 32);
        ((GAS unsigned long long*)A.CV)[i] = (unsigned long long)pk2(v4.x, v4.y) | ((unsigned long long)pk2(v4.z, v4.w) << 32);
        const int b = i / (128 * 48), rr = (i / 48) & 127, q = i % 48;
        if (rr >= 64) { const size_t o = ((size_t)(b * 128 + rr - 64) * 192) / 4 + q; ((GAS f32x4*)(A.out + pg8::O_K_S))[o] = k4; ((GAS f32x4*)(A.out + pg8::O_V_S))[o] = v4; }
    }
    for (int i = gt; i < 67584 / 4; i += NGT) ((GAS f32x4*)A.SS)[i] = (f32x4){0.f, 0.f, 0.f, 0.f};
    if (gt < 64) ((GAS f32x4*)A.ZERO)[gt] = (f32x4){0.f, 0.f, 0.f, 0.f};
    for (int i = gt; i < 32 * 15 * 256 / 4; i += NGT) { const f32x4 p4 = ((const GAS f32x4*)A.cpool)[i]; ((GAS unsigned long long*)A.CP)[i] = (unsigned long long)pk2(p4.x, p4.y) | ((unsigned long long)pk2(p4.z, p4.w) << 32); }
}

struct Args { const float* in[17]; float* out; unsigned char* ws; int ph_lo, ph_hi, li, pad; };
__global__ void __launch_bounds__(NWAVES * 64, 2) mk_fwd(Args args) {
    extern __shared__ __attribute__((aligned(16))) unsigned char lds[];
    Frame F;
    F.lds = (LAS unsigned char*)lds;
    F.MISC = (volatile LAS unsigned*)(F.lds + MISC_OFF);
    F.tid = threadIdx.x; F.lane = F.tid & 63; F.wave = __builtin_amdgcn_readfirstlane(F.tid >> 6);
    F.G = gridDim.x; { const int bx = blockIdx.x; F.vcu = (F.G % 8 == 0) ? (bx % 8) * (F.G / 8) + bx / 8 : bx; }
#define GRID_BAR(seam) do { if (N_LAUNCHES == PER_PHASE) { if (F.tid == 0) __hip_atomic_store(F.ctl + CW_TMO, 0xBADBA0u | (unsigned)(seam), RLX_AGENT); } \
    else { xcd_barrier(bar); } } while (0)
    unsigned char* ws = args.ws;
    F.ctl = (gu32*)(ws + WS_CTL);
    float* const out = args.out;
    bf16* const Win_t = (bf16*)(ws + WS_WIN); bf16* const Wout_t = (bf16*)(ws + WS_WOUT); bf16* const Wgu_t = (bf16*)(ws + WS_WGU); bf16* const Wd_t = (bf16*)(ws + WS_WD);
    bf16* const WPt = (bf16*)(ws + WS_WP); bf16* const CKb = (bf16*)(ws + WS_CK); bf16* const CVb = (bf16*)(ws + WS_CV); bf16* const CPb = (bf16*)(ws + WS_CP);
    bf16* const XB = (bf16*)(ws + WS_XB); bf16* const HB = (bf16*)(ws + WS_HB); bf16* const Z = (bf16*)(ws + WS_Z); bf16* const MIX = (bf16*)(ws + WS_MIX); bf16* const ACT = (bf16*)(ws + WS_ACT);
    float* const SS = (float*)(ws + WS_SS); float* const RX = (float*)(ws + WS_RX);
    for (int u = F.tid; u < (LDS_BYTES - LDSCTL_OFF) / 4; u += NWAVES * 64) ((LAS unsigned*)(F.lds + LDSCTL_OFF))[u] = 0u;
    __syncthreads();
    const int bli = (N_LAUNCHES == PER_PHASE) ? 0 : args.li;
    XcdBarrier bar; bar.bar = (unsigned*)(F.ctl + CW_BAR) + bli * XCD_BAR_WORDS; bar.x = 0; bar.st = nullptr;
    if (N_LAUNCHES != PER_PHASE)
        bar = xcd_barrier_post((unsigned*)(F.ctl + CW_BAR) + bli * XCD_BAR_WORDS, F.MISC + 8);

    const int lo = args.ph_lo, hi = args.ph_hi;
#define IN(k) (lo <= (k) && (k) < hi)
#define BOTH(k) (IN(k) && IN((k) + 1))

    if (IN(0)) {
        P0Args A{args.in[0], args.in[1], args.in[2], args.in[3], args.in[4], args.in[5], args.in[6], args.in[7], args.in[8], args.in[12], args.in[13], args.in[14], args.in[15], args.in[16], out,
                 Win_t, Wout_t, Wgu_t, Wd_t, WPt, CKb, CVb, CPb, XB, RX, SS, (float*)(ws + WS_ZERO)};
        p0_prologue(F, A);
        if (BOTH(0)) GRID_BAR(0);
    }
    if (IN(1)) {
        pg8::Gemm g{XB, Win_t, pg8::MT, 1536, 1024};
        pg8::StaticOrder S; S.init(pg8::MT, 1280, F.G, (int)blockIdx.x);
        { pg8::BalancedFullOrder Sb; Sb.init(pg8::MT, 1280, F.G, (int)blockIdx.x); pg8::EpiZ E{Z, args.in[9], args.in[10], out, RX};
          pg8::gemm_phase<pg8::EpiZ, pg8::BalancedFullOrder, PG8_ALIGN, PG8_SP2>(F.lds + RING_OFF, g, Sb, E); }
        { pg8::BalancedHalfOrder T{5, 0, (int)blockIdx.x, F.G, S.nM, S.nwg % F.G}; pg8::EpiZv E{Z, out, RX};
          pg8::gemm_phase<pg8::EpiZv, pg8::BalancedHalfOrder, PG8_ALIGN, PG8_SP2, true>(F.lds + RING_OFF, g, T, E); }
        if (BOTH(1)) GRID_BAR(1);
    }
    if (IN(2)) {
        mixp::mix_phase(F.lds + RING_OFF, Z, CKb, CVb, CPb, WPt, (const bf16*)(ws + WS_ZERO), MIX, args.in[11], (int)blockIdx.x, F.G);
        if (BOTH(2)) GRID_BAR(2);
    }
    if (IN(3)) {
        pg8::Gemm g{MIX, Wout_t, pg8::MT, 1024, 1024}; pg8::StaticOrder S; S.init(pg8::MT, 1024, F.G, (int)blockIdx.x);
        const int full = (S.nwg / F.G) * F.G;
        { pg8::StaticOrder Sa = S; Sa.hi = full; pg8::EpiH<false> E{XB, HB, SS};
          pg8::gemm_phase<pg8::EpiH<false>, pg8::StaticOrder, PG8_ALIGN, PG8_SP2>(F.lds + RING_OFF, g, Sa, E); }
        { pg8::TailHalfOrder T{S, full, (int)blockIdx.x}; pg8::EpiH<true> E{XB, HB, SS};
          pg8::gemm_phase<pg8::EpiH<true>, pg8::TailHalfOrder, PG8_ALIGN, PG8_SP2, true>(F.lds + RING_OFF, g, T, E); }
        if (BOTH(3)) GRID_BAR(3);
    }
    if (IN(4)) {
        pg8::Gemm g{HB, Wgu_t, pg8::MT, 5632, 1024}; pg8::StaticOrder S; S.init(pg8::MT, 5632, F.G, (int)blockIdx.x);
        S.rev = 1;
        pg8::EpiAct E{SS, ACT, F.lds + STAGE_OFF};
        pg8::gemm_phase<pg8::EpiAct, pg8::StaticOrder, PG8_ALIGN, PG8_SP2>(F.lds + RING_OFF, g, S, E);
        if (BOTH(4)) GRID_BAR(4);
    }
    if (IN(5)) {
        pg8::Gemm g{ACT, Wd_t, pg8::MT, 1024, 2816}; pg8::StaticOrder S; S.init(pg8::MT, 1024, F.G, (int)blockIdx.x);
        const int full = (S.nwg / F.G) * F.G;
        { pg8::StaticOrder Sa = S; Sa.hi = full; pg8::EpiY<false> E{HB, out, F.lds + STAGE_OFF};
          pg8::gemm_phase<pg8::EpiY<false>, pg8::StaticOrder, PG8_ALIGN, PG8_SP2>(F.lds + RING_OFF, g, Sa, E); }
        { pg8::TailHalfOrder T{S, full, (int)blockIdx.x}; pg8::EpiY<true> E{HB, out, F.lds + STAGE_OFF};
          pg8::gemm_phase<pg8::EpiY<true>, pg8::TailHalfOrder, PG8_ALIGN, PG8_SP2, true>(F.lds + RING_OFF, g, T, E); }
    }
#undef IN
#undef BOTH
}

extern "C" void kernel_launch(void* const* d_in, const int* in_sizes, int n_in, void* d_out, int out_size, void* d_ws, size_t ws_size, hipStream_t stream) {
    static int grid = 0;
    if (grid == 0) {
        if (n_in != 17 || in_sizes[0] != 65536 * 1024 || out_size != (int)pg8::O_END || ws_size < WS_END) { fprintf(stderr, "kernel_launch: shape mismatch: n_in %d, in0 %d, out %d, ws %zu (need >= %zu); nothing launched\n", n_in, n_in > 0 ? in_sizes[0] : -1, out_size, ws_size, (size_t)WS_END); grid = -1; return; }
        int dev = 0, cus = 0, per_cu = 0;
        if (hipGetDevice(&dev) != hipSuccess || hipDeviceGetAttribute(&cus, hipDeviceAttributeMultiprocessorCount, dev) != hipSuccess) { fprintf(stderr, "kernel_launch: hipGetDevice / hipDeviceGetAttribute failed; nothing launched\n"); grid = -1; return; }
        if (hipFuncSetAttribute((const void*)mk_fwd, hipFuncAttributeMaxDynamicSharedMemorySize, LDS_BYTES) != hipSuccess) { fprintf(stderr, "kernel_launch: hipFuncSetAttribute failed; nothing launched\n"); grid = -1; return; }
        if (hipOccupancyMaxActiveBlocksPerMultiprocessor(&per_cu, (const void*)mk_fwd, NWAVES * 64, LDS_BYTES) != hipSuccess || per_cu < 1)
            fprintf(stderr, "kernel_launch: note: the occupancy query reports %d workgroups per CU\n", per_cu);
        (void)hipGetLastError();
        grid = cus;
    }
    if (grid < 0) return;
    if (hipMemsetAsync((char*)d_ws + WS_CTL, 0, CTL_ZERO_BYTES, stream) != hipSuccess) { fprintf(stderr, "kernel_launch: hipMemsetAsync of the control words failed; nothing launched\n"); return; }
    Args a{};
    for (int i = 0; i < 17; ++i) a.in[i] = (const float*)d_in[i];
    a.out = (float*)d_out; a.ws = (unsigned char*)d_ws;
    static_assert(((N_LAUNCHES >= 1 && N_LAUNCHES <= 3) || N_LAUNCHES == PER_PHASE) && (CW_BAR + 3 * XCD_BAR_WORDS) * 4 <= (int)CTL_ZERO_BYTES, "-DMK_N_LAUNCHES must be 1, 2, 3 or 6");
    const int cuts3[4] = {0, N_LAUNCHES == 3 ? 1 : (N_LAUNCHES == 2 ? 4 : PER_PHASE), N_LAUNCHES == 3 ? 4 : PER_PHASE, PER_PHASE};
    for (int li = 0; li < N_LAUNCHES; ++li) {
        a.ph_lo = (N_LAUNCHES == PER_PHASE) ? li : cuts3[li]; a.ph_hi = (N_LAUNCHES == PER_PHASE) ? li + 1 : cuts3[li + 1]; a.li = li;
        hipLaunchKernelGGL(mk_fwd, dim3(grid), dim3(NWAVES * 64), LDS_BYTES, stream, a);
        const hipError_t le = hipPeekAtLastError();
        if (le != hipSuccess) { fprintf(stderr, "kernel_launch: launch %d failed: %s (grid %d x %d threads, %d B LDS)\n", li, hipGetErrorName(le), grid, NWAVES * 64, LDS_BYTES); break; }
    }
}
```

```cpp
#include <hip/hip_runtime.h>
#include <cstdio>
#include <cstdint>
namespace pg8 {
#define PG8_LAS __attribute__((address_space(3)))
typedef unsigned short bf16_t;
typedef short bf16x8 __attribute__((ext_vector_type(8)));
typedef float f32x4 __attribute__((ext_vector_type(4)));
typedef unsigned u32x4 __attribute__((ext_vector_type(4)));
constexpr int BM = 256, BK = 64, HALF = 128, HTB = HALF * BK * 2  , STAGE_BYTES = 8 * HTB, NXCD = 8, WGM = 8;

__host__ __device__ __forceinline__ int lds_byte(int r, int c) { const int st = (r >> 4) * 2 + (c >> 5), rr = r & 15, cc = c & 31, ob = rr * 64 + cc * 2; return st * 1024 + (ob ^ (((ob >> 9) & 1) << 5)); }
__host__ __device__ __forceinline__ int img_off(int r, int c) { return ((r >> 7) * HTB + lds_byte(r & 127, c)) >> 1; }
__host__ __device__ __forceinline__ void stage_rc(int b, int& R, int& C) { const int st = b / 1024, sb = b % 1024, swz = sb ^ (((sb >> 9) & 1) << 5); R = (st >> 1) * 16 + swz / 64; C = (st & 1) * 32 + (swz % 64) / 2; }
__host__ __device__ __forceinline__ int inv_perm32(int x) { return 16 * ((x >> 2) & 1) + 4 * (x >> 3) + (x & 3); }
__host__ __device__ __forceinline__ int perm32(int rho) { const int n = rho >> 4, i = rho & 15; return 8 * (i >> 2) + 4 * n + (i & 3); }

struct Unit { int pm, pn, hb, hm; };
struct Gemm { const bf16_t* A; const bf16_t* Bt; int M, N, K; };

struct StaticOrder {
    int nM, nN, nwg, G, c, lo, hi, rev, wgm;
    __host__ __device__ void init(int M, int N, int G_, int c_) { nM = M / BM; nN = N / BM; nwg = nM * nN; G = G_; c = c_; lo = 0; hi = nwg; rev = 0; wgm = WGM; }
    __host__ __device__ bool next(int i, Unit& u) const {
        const long L = (long)lo + (long)i * G + c; if (L >= hi) return false;
        int wgid = (int)L; { const int q = nwg / NXCD, r = nwg % NXCD, xcd = wgid % NXCD, off = wgid / NXCD; wgid = (xcd < r ? xcd * (q + 1) : r * (q + 1) + (xcd - r) * q) + off; }
        const int nig = wgm * nN, gid = wgid / nig, fm = gid * wgm, gsz = (nM - fm) < wgm ? (nM - fm) : wgm;
        u.pm = fm + ((wgid % nig) % gsz); u.pn = (wgid % nig) / gsz; u.hb = 0; u.hm = 0; if (rev) u.pm = nM - 1 - u.pm; return true;
    }
    __host__ __device__ void tile_of(int L, Unit& u) const { StaticOrder t = *this; t.lo = L; t.hi = L + 1; t.c = 0; (void)t.next(0, u); }
    __device__ __forceinline__ void a_ready(const Unit&) const {}
    __device__ __forceinline__ void done(const Unit&) const {}
};
struct BalancedFullOrder : StaticOrder {
    __host__ __device__ bool next(int i, Unit& u) const {
        if (G != 256 || nwg != 1320) return StaticOrder::next(i, u);
        int L; if (i < 4) L = i * G + c; else if (i == 4 && c < 208) L = 4 * G + c; else if (i == 5 && c < 88) L = 4 * G + 208 + c; else return false;
        StaticOrder t = *this; t.lo = L; t.hi = L + 1; t.c = 0; return t.StaticOrder::next(0, u);
    }
};
struct BalancedHalfOrder {
    int pn, hb, c, G, nM, busy;
    __host__ __device__ bool next(int i, Unit& u) const { int j;
        if (G != 256 || nM != 264) { if (c < busy) return false; j = (c - busy) + (G - busy) * i; if (j >= nM) return false; u.pm = j; u.pn = pn; u.hb = hb; u.hm = 0; return true; }
        if (c < 88) return false; if (c < 208) { if (i > 0) return false; j = c - 88; } else { if (i > 2) return false; j = 120 + 3 * (c - 208) + i; }
        u.pm = j; u.pn = pn; u.hb = hb; u.hm = 0; return true; }
    __device__ __forceinline__ void a_ready(const Unit&) const {}
    __device__ __forceinline__ void done(const Unit&) const {}
};
struct TailHalfOrder {
    StaticOrder S; int lo, c;
    __host__ __device__ bool next(int i, Unit& u) const { if (i > 0) return false; const int L = lo + (c >> 1); if (L >= S.nwg) return false; S.tile_of(L, u); u.hb = c & 1; return true; }
    __device__ __forceinline__ void a_ready(const Unit&) const {}
    __device__ __forceinline__ void done(const Unit&) const {}
};
struct TailQuarterOrder {
    StaticOrder S; int lo, c;
    __host__ __device__ bool next(int i, Unit& u) const { if (i > 0) return false; const int L = lo + (c >> 2); if (L >= S.nwg) return false; S.tile_of(L, u); u.hb = c & 1; u.hm = (c >> 1) & 1; return true; }
    __device__ __forceinline__ void a_ready(const Unit&) const {}
    __device__ __forceinline__ void done(const Unit&) const {}
};
typedef float f32x2 __attribute__((ext_vector_type(2))); typedef __bf16 bf16x2_t __attribute__((ext_vector_type(2)));
__device__ __forceinline__ unsigned cvt_pk_bf16(float lo, float hi) { f32x2 v = {lo, hi}; bf16x2_t b = __builtin_convertvector(v, bf16x2_t); return __builtin_bit_cast(unsigned, b); }
typedef unsigned u32x2 __attribute__((ext_vector_type(2)));
constexpr float LOG2E = 1.4426950408889634f;
constexpr float C2 = 0.125f * LOG2E;
constexpr float EPS = 1e-6f;
constexpr int HALF_COLS = 128;
constexpr int DM = 1024, ZP = 1408, FF = 2816;
constexpr int MP = 65536, MS = 2048, MT = MP + MS;
constexpr size_t O_POOL_P = 69206016, O_K_P = 69328896, O_V_P = 70115328, O_POOL_S = 70901760, O_K_S = 71024640, O_V_S = 71811072, O_END = 72597504;

__host__ __device__ __forceinline__ size_t zsub_off(int row, int c) { return ((size_t)(row >> 4) * 2 + (c >> 5)) * 512 + (row & 15) * 32 + (c & 31); }
__device__ __forceinline__ void acc_zero(f32x4 (&acc)[2][2][4][2]) {
#pragma unroll
    for (int a = 0; a < 2; ++a)
#pragma unroll
        for (int b = 0; b < 2; ++b)
#pragma unroll
            for (int m = 0; m < 4; ++m)
#pragma unroll
                for (int n = 0; n < 2; ++n) acc[a][b][m][n] = (f32x4){0.f, 0.f, 0.f, 0.f};
}
__device__ __forceinline__ float bf_lo(unsigned w) { return __uint_as_float(w << 16); }
__device__ __forceinline__ float bf_hi(unsigned w) { return __uint_as_float(w & 0xffff0000u); }
template <bool HN = false, bool HM = false, bool BLK = false>
__device__ __forceinline__ void acc_from_bf16(f32x4 (&acc)[2][2][4][2], const bf16_t* R, const Unit& u, int wr, int wc, int fr, int fq) {
    const int r0 = (HM ? u.hm * HALF : 0) + wr * 64 + fr, c0 = u.pn * BM + (HN ? u.hb * HALF_COLS : 0) + wc * 32 + 8 * fq;
    const bf16_t* rp = BLK ? R + (size_t)u.pm * (1024 / BK) * (BM * BK) : R + ((size_t)u.pm * BM + r0) * 1024 + c0;
#pragma unroll
    for (int ai = 0; ai < (HM ? 1 : 2); ++ai)
#pragma unroll
        for (int m = 0; m < 4; ++m)
#pragma unroll
            for (int bj = 0; bj < (HN ? 1 : 2); ++bj) { const int c = c0 + bj * HALF;
                const u32x4 w = BLK ? *(const u32x4*)(rp + (size_t)(c >> 6) * (BM * BK) + img_off(r0 + ai * HALF + m * 16, c & 63)) : *(const u32x4*)(rp + (size_t)(ai * HALF + m * 16) * 1024 + bj * HALF);
                acc[ai][bj][m][0] = (f32x4){bf_lo(w.x), bf_hi(w.x), bf_lo(w.y), bf_hi(w.y)}; acc[ai][bj][m][1] = (f32x4){bf_lo(w.z), bf_hi(w.z), bf_lo(w.w), bf_hi(w.w)}; }
}

struct EpiZ {
    static constexpr bool PERM = true, AFTER_DRAIN = false, INIT_LOADS = false; static constexpr int RELAX = 0, B_AUX = 0, A_BLK = 1;
    bf16_t* Z; const float* qn; const float* kn; float* out; const float* RX;
    struct Aux {};
    __device__ __forceinline__ void init(f32x4 (&acc)[2][2][4][2], const Unit&, int, int, int, int) const { acc_zero(acc); }
    __device__ __forceinline__ void aux_load(Aux&, const Unit&, int, int, int, int) const {}
    __device__ __forceinline__ void operator()(const f32x4 (&acc)[2][2][4][2], const Aux&, const Unit& u, int wr, int wc, int fr, int fq) const {
        const int zcol = u.pn * 256 + wc * 64;
        if (zcol >= ZP) return;
        const int kind = (zcol >= 256 && zcol < 1024) ? 1 : ((zcol >= 1024 && zcol < 1216) ? 2 : 0);
        f32x4 sc[2][2];
#pragma unroll
        for (int bj = 0; bj < 2; ++bj)
#pragma unroll
            for (int n = 0; n < 2; ++n) {
                if (kind == 1) sc[bj][n] = *(const f32x4*)(qn + 32 * bj + 8 * fq + 4 * n) * C2;
                else if (kind == 2) sc[bj][n] = *(const f32x4*)(kn + 32 * bj + 8 * fq + 4 * n);
                else sc[bj][n] = (f32x4){1.f, 1.f, 1.f, 1.f};
            }
        const bool samp = u.pm >= 256;
        const int cm = (!samp && (u.pm & 7) != 7) ? 0 : (zcol < 256 ? 1 : (zcol >= 1216 ? 3 : (zcol >= 1024 ? 2 : 0)));
        const int rowbase = u.pm * BM + wr * 64 + fr;
#pragma unroll
        for (int ai = 0; ai < 2; ++ai)
#pragma unroll
            for (int m = 0; m < 4; ++m) {
                const int row = rowbase + ai * HALF + m * 16;
                const float rx = RX[row];
                float rs = rx;
                if (kind) {
                    float ss = 0.f;
#pragma unroll
                    for (int bj = 0; bj < 2; ++bj)
#pragma unroll
                        for (int n = 0; n < 2; ++n) { const f32x4 x = acc[ai][bj][m][n]; ss += (x[0] * x[0] + x[1] * x[1]) + (x[2] * x[2] + x[3] * x[3]); }
                    ss += __shfl_xor(ss, 16); ss += __shfl_xor(ss, 32);
                    rs = rx / sqrtf(ss * (rx * rx) * (1.0f / 64.0f) + EPS);
                }
                f32x4 v[2][2];
#pragma unroll
                for (int bj = 0; bj < 2; ++bj)
#pragma unroll
                    for (int n = 0; n < 2; ++n) v[bj][n] = acc[ai][bj][m][n] * rs * sc[bj][n];
                bf16_t* zp = Z + (size_t)(zcol >> 6) * MT * 64 + zsub_off(row, 8 * fq);
#pragma unroll
                for (int bj = 0; bj < 2; ++bj) { u32x4 w; w.x = cvt_pk_bf16(v[bj][0][0], v[bj][0][1]); w.y = cvt_pk_bf16(v[bj][0][2], v[bj][0][3]); w.z = cvt_pk_bf16(v[bj][1][0], v[bj][1][1]); w.w = cvt_pk_bf16(v[bj][1][2], v[bj][1][3]);
                    *(u32x4*)(zp + 512 * bj) = w; }
                if (cm) {
                    int b, t, T; if (samp) { const int r2 = row - MP; b = r2 >> 6; t = r2 & 63; T = 64; } else { b = row >> 11; t = row & 2047; T = 2048; }
                    float* dst = nullptr;
                    if (cm == 1) { const int i = t - (T - 15); if (i >= 0) dst = out + (samp ? O_POOL_S : O_POOL_P) + ((size_t)(b * 15 + i) * 256 + zcol); }
                    else { const int i = samp ? 64 + t : t - (T - 128); if (i >= 0) dst = out + (cm == 2 ? (samp ? O_K_S : O_K_P) : (samp ? O_V_S : O_V_P)) + ((size_t)(b * 128 + i) * 192 + (zcol - (cm == 2 ? 1024 : 1216))); }
                    if (dst) {
#pragma unroll
                        for (int bj = 0; bj < 2; ++bj)
#pragma unroll
                            for (int n = 0; n < 2; ++n) *(f32x4*)(dst + 32 * bj + 8 * fq + 4 * n) = v[bj][n];
                    }
                }
            }
    }
};

struct EpiZv {
    static constexpr bool PERM = true, AFTER_DRAIN = false, INIT_LOADS = false; static constexpr int RELAX = 0, B_AUX = 0, A_BLK = 1;
    bf16_t* Z; float* out; const float* RX;
    struct Aux {};
    __device__ __forceinline__ void init(f32x4 (&acc)[2][2][4][2], const Unit&, int, int, int, int) const { acc_zero(acc); }
    __device__ __forceinline__ void aux_load(Aux&, const Unit&, int, int, int, int) const {}
    __device__ __forceinline__ void operator()(const f32x4 (&acc)[2][2][4][2], const Aux&, const Unit& u, int wr, int wc, int fr, int fq) const {
        const int zcol = 1280 + 32 * wc + 8 * fq;
        const bool samp = u.pm >= 256, cache = samp || (u.pm & 7) == 7;
        const int rowbase = u.pm * BM + wr * 64 + fr;
#pragma unroll
        for (int ai = 0; ai < 2; ++ai)
#pragma unroll
            for (int m = 0; m < 4; ++m) {
                const int row = rowbase + ai * HALF + m * 16;
                const float rx = RX[row];
                const f32x4 v0 = acc[ai][0][m][0] * rx, v1 = acc[ai][0][m][1] * rx;
                u32x4 w; w.x = cvt_pk_bf16(v0[0], v0[1]); w.y = cvt_pk_bf16(v0[2], v0[3]); w.z = cvt_pk_bf16(v1[0], v1[1]); w.w = cvt_pk_bf16(v1[2], v1[3]);
                *(u32x4*)(Z + (size_t)(zcol >> 6) * MT * 64 + zsub_off(row, zcol & 63)) = w;
                if (cache) {
                    int b, i; if (samp) { const int r2 = row - MP; b = r2 >> 6; i = 64 + (r2 & 63); } else { b = row >> 11; i = (row & 2047) - 1920; }
                    if (i >= 0) { float* dst = out + (samp ? O_V_S : O_V_P) + ((size_t)(b * 128 + i) * 192 + (zcol - 1216)); *(f32x4*)dst = v0; *(f32x4*)(dst + 4) = v1; }
                }
            }
    }
};

template <bool HN = false, bool HM = false> struct EpiH {
    static constexpr bool PERM = true, AFTER_DRAIN = false, INIT_LOADS = true; static constexpr int RELAX = 0, B_AUX = 0, A_BLK = 1;
    const bf16_t* XB; bf16_t* HB; float* SS;
    struct Aux {};
    __device__ __forceinline__ void init(f32x4 (&acc)[2][2][4][2], const Unit& u, int wr, int wc, int fr, int fq) const { acc_from_bf16<HN, HM, true>(acc, XB, u, wr, wc, fr, fq); }
    __device__ __forceinline__ void aux_load(Aux&, const Unit&, int, int, int, int) const {}
    __device__ __forceinline__ void operator()(const f32x4 (&acc)[2][2][4][2], const Aux&, const Unit& u, int wr, int wc, int fr, int fq) const {
        const int col0 = u.pn * BM + (HN ? u.hb * HALF_COLS : 0) + wc * 32 + 8 * fq;
#pragma unroll
        for (int ai = 0; ai < (HM ? 1 : 2); ++ai) {
#pragma unroll
            for (int m = 0; m < 4; ++m) {
                const size_t grow = (size_t)u.pm * BM + (HM ? u.hm : ai) * HALF + wr * 64 + m * 16 + fr;
                float ss = 0.f;
#pragma unroll
                for (int bj = 0; bj < (HN ? 1 : 2); ++bj) { const f32x4 h0 = acc[ai][bj][m][0], h1 = acc[ai][bj][m][1];
                    ss += ((h0[0] * h0[0] + h0[1] * h0[1]) + (h0[2] * h0[2] + h0[3] * h0[3])) + ((h1[0] * h1[0] + h1[1] * h1[1]) + (h1[2] * h1[2] + h1[3] * h1[3]));
                    u32x4 w; w.x = cvt_pk_bf16(h0[0], h0[1]); w.y = cvt_pk_bf16(h0[2], h0[3]); w.z = cvt_pk_bf16(h1[0], h1[1]); w.w = cvt_pk_bf16(h1[2], h1[3]);
                    { const int c = col0 + bj * HALF; *(u32x4*)(HB + ((size_t)u.pm * (DM / BK) + (c >> 6)) * (BM * BK) + img_off((int)(grow & 255), c & 63)) = w; } }
                ss += __shfl_xor(ss, 16); ss += __shfl_xor(ss, 32);
                if (fq == 0) atomicAdd(SS + grow, ss);
            }
        }
    }
};

struct EpiAct {
    static constexpr bool PERM = true, AFTER_DRAIN = false, INIT_LOADS = false; static constexpr int RELAX = 0, B_AUX = 0, A_BLK = 1;
    const float* SS; bf16_t* ACT; PG8_LAS unsigned char* stage;
    struct Aux {};
    __device__ __forceinline__ void init(f32x4 (&acc)[2][2][4][2], const Unit&, int, int, int, int) const { acc_zero(acc); }
    __device__ __forceinline__ void aux_load(Aux&, const Unit& u, int wr, int wc, int fr, int fq) const {
        __builtin_amdgcn_global_load_lds((const unsigned*)(SS + (size_t)u.pm * BM + 4 * (fr + 16 * fq)), (PG8_LAS unsigned*)(stage + (wr * 4 + wc) * 1024), 16, 0, 0);
    }
    __device__ __forceinline__ void operator()(const f32x4 (&acc)[2][2][4][2], const Aux&, const Unit& u, int wr, int wc, int fr, int fq) const {
        const int col0 = u.pn * HALF + wc * 32 + 8 * fq;
        const PG8_LAS float* sl = (const PG8_LAS float*)(stage + (wr * 4 + wc) * 1024) + wr * 64 + fr;
#pragma unroll
        for (int ai = 0; ai < 2; ++ai)
#pragma unroll
            for (int m = 0; m < 4; ++m) {
                const size_t grow = (size_t)u.pm * BM + ai * HALF + wr * 64 + m * 16 + fr;
                const float r2 = __builtin_amdgcn_rcpf(sl[ai * HALF + m * 16] * (1.0f / DM) + EPS), rs = __builtin_amdgcn_sqrtf(r2), c1 = -LOG2E * rs;
                float o[8];
#pragma unroll
                for (int n = 0; n < 2; ++n)
#pragma unroll
                    for (int e = 0; e < 4; ++e) { const float g = acc[ai][0][m][n][e], uu = acc[ai][1][m][n][e];
                        o[4 * n + e] = (g * uu) * (r2 * __builtin_amdgcn_rcpf(1.0f + __builtin_amdgcn_exp2f(c1 * g))); }
                u32x4 w; w.x = cvt_pk_bf16(o[0], o[1]); w.y = cvt_pk_bf16(o[2], o[3]); w.z = cvt_pk_bf16(o[4], o[5]); w.w = cvt_pk_bf16(o[6], o[7]);
                *(u32x4*)(ACT + ((size_t)u.pm * (FF / BK) + (col0 >> 6)) * (BM * BK) + img_off((int)(grow & 255), col0 & 63)) = w;
            }
    }
};

template <bool HN = false, bool HM = false> struct EpiY {
    static constexpr bool PERM = true, AFTER_DRAIN = false, INIT_LOADS = true; static constexpr int RELAX = 0, B_AUX = 0, A_BLK = 1;
    const bf16_t* HB; float* Y; PG8_LAS unsigned char* stage;
    struct Aux {};
    __device__ __forceinline__ void init(f32x4 (&acc)[2][2][4][2], const Unit& u, int wr, int wc, int fr, int fq) const { acc_from_bf16<HN, HM, true>(acc, HB, u, wr, wc, fr, fq); }
    __device__ __forceinline__ void aux_load(Aux&, const Unit&, int, int, int, int) const {}
    __device__ __forceinline__ void operator()(const f32x4 (&acc)[2][2][4][2], const Aux&, const Unit& u, int wr, int wc, int fr, int fq) const {
        const int lane = fr + 16 * fq; PG8_LAS unsigned char* st = stage + (wr * 4 + wc) * 2048;
#pragma unroll
        for (int ai = 0; ai < (HM ? 1 : 2); ++ai) {
#pragma unroll
            for (int m = 0; m < 4; ++m) {
                float* tp = Y + ((size_t)u.pm * BM + (HM ? u.hm : ai) * HALF + wr * 64 + m * 16 + (lane >> 3)) * DM + u.pn * BM + (HN ? u.hb * HALF_COLS : 0) + wc * 32 + 4 * (lane & 7);
#pragma unroll
                for (int bj = 0; bj < (HN ? 1 : 2); ++bj) {
                    *(PG8_LAS f32x4*)(st + fr * 128 + (((2 * fq) ^ (fr & 7)) << 4)) = acc[ai][bj][m][0]; *(PG8_LAS f32x4*)(st + fr * 128 + (((2 * fq + 1) ^ (fr & 7)) << 4)) = acc[ai][bj][m][1];
                    asm volatile("s_waitcnt lgkmcnt(0)" ::: "memory");
#pragma unroll
                    for (int ps = 0; ps < 2; ++ps) { const int r = 8 * ps + (lane >> 3); const f32x4 v = *(const PG8_LAS f32x4*)(st + r * 128 + (((lane & 7) ^ (r & 7)) << 4)); *(f32x4*)(tp + (size_t)(8 * ps) * DM + bj * HALF) = v; }
                    asm volatile("s_waitcnt lgkmcnt(0)" ::: "memory");
                }
            }
        }
    }
};

template <class Epi, class Sched, bool ALIGN_EPI = false, bool SP2 = false, bool HALF_N = false>
__device__ __forceinline__ void gemm_phase(PG8_LAS unsigned char* lds, const Gemm g, const Sched& S, const Epi& E) {
    const int tid = threadIdx.x, wid = __builtin_amdgcn_readfirstlane(tid >> 6), lane = tid & 63, wr = wid >> 2, wc = wid & 3, fr = lane & 15, fq = lane >> 4;
    static_assert(SP2 || !HALF_N, "HALF_N needs the SP2 loop");
    const int K = g.K, nt = K / BK;
    unsigned voffA[2], voffB[2];
#pragma unroll
    for (int i = 0; i < 2; ++i) { int R, C; stage_rc(tid * 16 + i * 8192, R, C); const int Rb = Epi::PERM ? ((R & ~31) + perm32(R & 31)) : R;
        voffA[i] = Epi::A_BLK ? (unsigned)(tid * 16 + i * 8192) : (unsigned)(R * K + C) * 2u; voffB[i] = (unsigned)(tid * 16 + i * 8192); (void)Rb; }
    const size_t kstep = (size_t)(BK * 2);
    const size_t hstep = (size_t)HALF * K * 2;
    const size_t tstep = 2 * hstep;
    const size_t kstepA = Epi::A_BLK ? (size_t)BM * BK * 2 : kstep, hstepA = Epi::A_BLK ? (size_t)HALF * BK * 2 : hstep;
    const size_t kstepB = (size_t)BM * BK * 2, hstepB = (size_t)HALF * BK * 2;
    const unsigned ldsw = (unsigned)wid * 1024u;
    const int aoff = lds_byte(wr * 64 + fr, fq * 8), boff = lds_byte(wc * 32 + fr, fq * 8);
#define PG8_SA(b, h) (((b) * 2 + (h)) * HTB)
#define PG8_SB(b, h) ((4 + (b) * 2 + (h)) * HTB)
#define PG8_STAGE(bufoff, gbase, voff) do { _Pragma("unroll") for (int _i = 0; _i < 2; ++_i) \
        __builtin_amdgcn_global_load_lds((const unsigned*)((const char*)(gbase) + (voff)[_i]), (PG8_LAS unsigned*)(lds + (bufoff) + ldsw + _i * 8192), 16, 0, 0); } while (0)
#define PG8_STAGEB(bufoff, gbase) do { _Pragma("unroll") for (int _i = 0; _i < 2; ++_i) \
        __builtin_amdgcn_global_load_lds((const unsigned*)((const char*)(gbase) + voffB[_i]), (PG8_LAS unsigned*)(lds + (bufoff) + ldsw + _i * 8192), 16, 0, Epi::B_AUX); } while (0)
#define PG8_LDA(dst, b, h) do { _Pragma("unroll") for (int m = 0; m < 4; ++m) _Pragma("unroll") for (int k = 0; k < 2; ++k) dst[m][k] = *(const PG8_LAS bf16x8*)(lds + PG8_SA(b, h) + aoff + m * 2048 + k * 1024); } while (0)
#define PG8_LDB(dst, b, h) do { _Pragma("unroll") for (int n = 0; n < 2; ++n) _Pragma("unroll") for (int k = 0; k < 2; ++k) dst[n][k] = *(const PG8_LAS bf16x8*)(lds + PG8_SB(b, h) + boff + n * 2048 + k * 1024); } while (0)
#define PG8_MMA(ai, bj, At, Bt) do { __builtin_amdgcn_s_setprio(1); _Pragma("unroll") for (int m = 0; m < 4; ++m) _Pragma("unroll") for (int n = 0; n < 2; ++n) _Pragma("unroll") for (int k = 0; k < 2; ++k) \
        acc[ai][bj][m][n] = __builtin_amdgcn_mfma_f32_16x16x32_bf16(Bt[n][k], At[m][k], acc[ai][bj][m][n], 0, 0, 0); __builtin_amdgcn_s_setprio(0); } while (0)
#define PG8_WAIT_V(n) asm volatile("s_waitcnt vmcnt(" #n ")" ::: "memory")
#define PG8_WAIT_VK do { if constexpr (HALF_N) asm volatile("s_waitcnt vmcnt(6)" ::: "memory"); else asm volatile("s_waitcnt vmcnt(8)" ::: "memory"); } while (0)
#define PG8_STAGE_B1(bufoff, gbase) do { if constexpr (!HALF_N) PG8_STAGEB(bufoff, gbase); } while (0)
#define PG8_LDB1(dst, b) do { if constexpr (!HALF_N) PG8_LDB(dst, b, 1); } while (0)
#define PG8_MMA1(ai, At, Bt) do { if constexpr (!HALF_N) PG8_MMA(ai, 1, At, Bt); } while (0)
#define PG8_WAIT_V1 do { if (!HALF_N && Epi::RELAX == 9 && rl) asm volatile("s_waitcnt vmcnt(17)" ::: "memory"); else PG8_WAIT_VK; } while (0)
#define PG8_WAIT_L(n) asm volatile("s_waitcnt lgkmcnt(" #n ")" ::: "memory")
#define PG8_BAR __builtin_amdgcn_s_barrier()
#define PG8_SCHED __builtin_amdgcn_sched_barrier(0)
    Unit cur, nxt; int ui = 0;
    if (!S.next(0, cur)) return;
    f32x4 acc[2][2][4][2];
    typename Epi::Aux aux;
    E.init(acc, cur, wr, wc, fr, fq);
    bf16x8 At[4][2], B0[2][2], B1[2][2];
    const char* cA = (const char*)g.A + (size_t)cur.pm * tstep; const char* cB = (const char*)g.Bt + (size_t)cur.pn * tstep + (HALF_N ? (size_t)cur.hb * hstepB : (size_t)0);
    S.a_ready(cur);
    if constexpr (SP2) {
        PG8_STAGEB(PG8_SB(0, 0), cB); PG8_STAGE_B1(PG8_SB(0, 1), cB + hstepB); PG8_STAGE(PG8_SA(0, 0), cA, voffA); PG8_STAGE(PG8_SA(0, 1), cA + hstepA, voffA);
        if (wr == 1) PG8_BAR;
        PG8_WAIT_V(2); PG8_BAR;
        PG8_STAGEB(PG8_SB(1, 0), cB + kstepB); PG8_STAGE(PG8_SA(1, 0), cA + kstepA, voffA); PG8_STAGE_B1(PG8_SB(1, 1), cB + hstepB + kstepB);
        if constexpr (HALF_N) PG8_WAIT_V(4); else PG8_WAIT_V(6);
        PG8_BAR;
    } else {
        PG8_STAGEB(PG8_SB(0, 0), cB); PG8_STAGE(PG8_SA(0, 0), cA, voffA); PG8_STAGEB(PG8_SB(0, 1), cB + hstepB); PG8_STAGE(PG8_SA(0, 1), cA + hstepA, voffA);
        if (wr == 1) PG8_BAR;
        PG8_WAIT_V(4); PG8_BAR;
        PG8_STAGEB(PG8_SB(1, 0), cB + kstepB); PG8_STAGE(PG8_SA(1, 0), cA + kstepA, voffA); PG8_STAGEB(PG8_SB(1, 1), cB + hstepB + kstepB);
        PG8_WAIT_V(6); PG8_BAR;
    }
    for (;;) {
        if constexpr (Epi::INIT_LOADS) {
#pragma unroll
            for (int a = 0; a < 2; ++a)
#pragma unroll
                for (int b = 0; b < (HALF_N ? 1 : 2); ++b)
#pragma unroll
                    for (int m = 0; m < 4; ++m) asm volatile("" : "+v"(acc[a][b][m][0]), "+v"(acc[a][b][m][1]));
        }
        E.aux_load(aux, cur, wr, wc, fr, fq);
        const bool has_next = S.next(ui + 1, nxt);
        const char* nA = has_next ? (const char*)g.A + (size_t)nxt.pm * tstep : cA; const char* nB = has_next ? (const char*)g.Bt + (size_t)nxt.pn * tstep + (HALF_N ? (size_t)nxt.hb * hstepB : (size_t)0) : cB;
        for (int t = 0; t < nt; t += 2) {
            const bool last = (t == nt - 2);
            const char* a1 = cA + (size_t)(t + 1) * kstepA;
            const char* a2 = last ? nA : cA + (size_t)(t + 2) * kstepA; const char* b2 = last ? nB : cB + (size_t)(t + 2) * kstepB;
            const char* a3 = a2 + kstepA; const char* b3 = b2 + kstepB;
            if (last && has_next) S.a_ready(nxt);
            int rl = __builtin_amdgcn_readfirstlane((int)((t == 0) & (ui > 0))); asm volatile("" : "+s"(rl));
            if constexpr (SP2) {
            PG8_LDB(B0, 0, 0); PG8_LDB1(B1, 0); PG8_SCHED; PG8_LDA(At, 0, 0); PG8_STAGE(PG8_SA(1, 1), a1 + hstepA, voffA);
            PG8_WAIT_V1; PG8_WAIT_L(0); PG8_BAR; PG8_MMA(0, 0, At, B0); PG8_MMA1(0, At, B1); PG8_BAR; PG8_SCHED;
            PG8_LDA(At, 0, 1); PG8_STAGEB(PG8_SB(0, 0), b2); PG8_STAGE_B1(PG8_SB(0, 1), b2 + hstepB); PG8_STAGE(PG8_SA(0, 0), a2, voffA);
            PG8_WAIT_V1; PG8_WAIT_L(0); PG8_BAR; PG8_MMA(1, 0, At, B0); PG8_MMA1(1, At, B1); PG8_BAR; PG8_SCHED;
            PG8_LDB(B0, 1, 0); PG8_LDB1(B1, 1); PG8_SCHED; PG8_LDA(At, 1, 0); PG8_STAGE(PG8_SA(0, 1), a2 + hstepA, voffA);
            PG8_WAIT_VK; PG8_WAIT_L(0); PG8_BAR; PG8_MMA(0, 0, At, B0); PG8_MMA1(0, At, B1); PG8_BAR; PG8_SCHED;
            PG8_LDA(At, 1, 1); PG8_STAGEB(PG8_SB(1, 0), b3); PG8_STAGE_B1(PG8_SB(1, 1), b3 + hstepB); PG8_STAGE(PG8_SA(1, 0), a3, voffA);
            PG8_WAIT_VK; PG8_WAIT_L(0); PG8_BAR; PG8_MMA(1, 0, At, B0); PG8_MMA1(1, At, B1); PG8_BAR; PG8_SCHED;
            } else {
            PG8_LDB(B0, 0, 0); PG8_SCHED; PG8_LDA(At, 0, 0); PG8_STAGE(PG8_SA(1, 1), a1 + hstepA, voffA);
            PG8_WAIT_L(8); PG8_BAR; PG8_WAIT_L(0); PG8_MMA(0, 0, At, B0); PG8_BAR; PG8_SCHED;
            PG8_LDB(B1, 0, 1); PG8_STAGEB(PG8_SB(0, 0), b2);
            PG8_BAR; PG8_WAIT_L(0); PG8_MMA(0, 1, At, B1); PG8_BAR;
            PG8_LDA(At, 0, 1); PG8_STAGE(PG8_SA(0, 0), a2, voffA);
            PG8_BAR; PG8_WAIT_L(0); PG8_MMA(1, 0, At, B0); PG8_BAR; PG8_SCHED;
            PG8_STAGEB(PG8_SB(0, 1), b2 + hstepB);
            PG8_WAIT_V(6); PG8_BAR; PG8_MMA(1, 1, At, B1); PG8_BAR;
            PG8_LDB(B0, 1, 0); PG8_SCHED; PG8_LDA(At, 1, 0); PG8_STAGE(PG8_SA(0, 1), a2 + hstepA, voffA);
            PG8_WAIT_L(8); PG8_BAR; PG8_WAIT_L(0); PG8_MMA(0, 0, At, B0); PG8_BAR; PG8_SCHED;
            PG8_LDB(B1, 1, 1); PG8_STAGEB(PG8_SB(1, 0), b3);
            PG8_BAR; PG8_WAIT_L(0); PG8_MMA(0, 1, At, B1); PG8_BAR;
            PG8_LDA(At, 1, 1); PG8_STAGE(PG8_SA(1, 0), a3, voffA);
            PG8_BAR; PG8_WAIT_L(0); PG8_MMA(1, 0, At, B0); PG8_BAR; PG8_SCHED;
            PG8_STAGEB(PG8_SB(1, 1), b3 + hstepB);
            PG8_WAIT_V(6); PG8_BAR; PG8_MMA(1, 1, At, B1); PG8_BAR;
            }
        }
        if constexpr (ALIGN_EPI) { if (wr == 0) PG8_BAR; }
        if constexpr (!Epi::AFTER_DRAIN) { E(acc, aux, cur, wr, wc, fr, fq); S.done(cur); }
        if (!has_next) break;
        E.init(acc, nxt, wr, wc, fr, fq);
        cur = nxt; cA = nA; cB = nB; ++ui;
        if constexpr (ALIGN_EPI) { if (wr == 1) PG8_BAR; }
    }
    PG8_WAIT_V(0);
    if constexpr (!ALIGN_EPI) { if (wr == 0) PG8_BAR; }
    PG8_BAR;
    if constexpr (Epi::AFTER_DRAIN) { E.fused(acc, cur, wr, wc, fr, fq, lds, wid, lane); S.done(cur); }
}
template <class Epi, class Sched>
__device__ __forceinline__ void gemm_phase_q(PG8_LAS unsigned char* lds, const Gemm g, const Sched& S, const Epi& E) {
    const int tid = threadIdx.x, wid = __builtin_amdgcn_readfirstlane(tid >> 6), lane = tid & 63, wr = wid >> 2, wc = wid & 3, fr = lane & 15, fq = lane >> 4;
    const int K = g.K, nt = K / BK;
    unsigned voffA[2], voffB[2];
#pragma unroll
    for (int i = 0; i < 2; ++i) { int R, C; stage_rc(tid * 16 + i * 8192, R, C); const int Rb = Epi::PERM ? ((R & ~31) + perm32(R & 31)) : R;
        voffA[i] = (unsigned)(R * K + C) * 2u; voffB[i] = (unsigned)(Rb * K + C) * 2u; }
    const size_t kstep = (size_t)(BK * 2), hstep = (size_t)HALF * K * 2, tstep = 2 * hstep;
    const unsigned ldsw = (unsigned)wid * 1024u;
    const int aoff = lds_byte(wr * 64 + fr, fq * 8), boff = lds_byte(wc * 32 + fr, fq * 8);
    Unit cur;
    if (!S.next(0, cur)) return;
    f32x4 acc[2][2][4][2];
    typename Epi::Aux aux;
    E.init(acc, cur, wr, wc, fr, fq);
    bf16x8 At[4][2], B0[2][2];
    const char* cA = (const char*)g.A + (size_t)cur.pm * tstep + (size_t)cur.hm * hstep; const char* cB = (const char*)g.Bt + (size_t)cur.pn * tstep + (size_t)cur.hb * hstep;
    S.a_ready(cur);
    PG8_STAGEB(PG8_SB(0, 0), cB); PG8_STAGE(PG8_SA(0, 0), cA, voffA);
    PG8_STAGEB(PG8_SB(0, 1), cB + kstep); PG8_STAGE(PG8_SA(0, 1), cA + kstep, voffA);
    PG8_STAGEB(PG8_SB(1, 0), cB + 2 * kstep); PG8_STAGE(PG8_SA(1, 0), cA + 2 * kstep, voffA);
    if (wr == 1) PG8_BAR;
    PG8_WAIT_V(8); PG8_BAR;
    PG8_BAR;
    if constexpr (Epi::INIT_LOADS) {
#pragma unroll
        for (int m = 0; m < 4; ++m) asm volatile("" : "+v"(acc[0][0][m][0]), "+v"(acc[0][0][m][1]));
    }
    E.aux_load(aux, cur, wr, wc, fr, fq);
#define PG8_SPQ(s, kt) do { const int _k = (kt) < nt ? (kt) : (kt) - nt; \
        PG8_LDB(B0, (s) >> 1, (s) & 1); PG8_SCHED; PG8_LDA(At, (s) >> 1, (s) & 1); \
        PG8_STAGE(PG8_SB((((s) + 3) & 3) >> 1, ((s) + 3) & 1), cB + (size_t)_k * kstep, voffB); PG8_STAGE(PG8_SA((((s) + 3) & 3) >> 1, ((s) + 3) & 1), cA + (size_t)_k * kstep, voffA); \
        PG8_WAIT_V(8); PG8_WAIT_L(0); PG8_BAR; PG8_MMA(0, 0, At, B0); PG8_BAR; PG8_SCHED; } while (0)
    for (int t = 0; t < nt; t += 4) { PG8_SPQ(0, t + 3); PG8_SPQ(1, t + 4); PG8_SPQ(2, t + 5); PG8_SPQ(3, t + 6); }
#undef PG8_SPQ
    if (wr == 0) PG8_BAR;
    E(acc, aux, cur, wr, wc, fr, fq); S.done(cur);
    PG8_WAIT_V(0);
    PG8_BAR;
#undef PG8_SA
#undef PG8_SB
#undef PG8_STAGE
#undef PG8_STAGEB
#undef PG8_LDA
#undef PG8_LDB
#undef PG8_MMA
#undef PG8_WAIT_V
#undef PG8_WAIT_V1
#undef PG8_WAIT_VK
#undef PG8_STAGE_B1
#undef PG8_LDB1
#undef PG8_MMA1
#undef PG8_WAIT_L
#undef PG8_BAR
#undef PG8_SCHED
}
}
#ifndef PG8_SP2
#define PG8_SP2 true
#endif
#ifndef PG8_ALIGN
#define PG8_ALIGN true
#endif
namespace mixp {
using pg8::bf16_t; using pg8::bf16x8; using pg8::u32x4; using pg8::u32x2; using pg8::ZP; using pg8::MP; using pg8::MT; using pg8::LOG2E;
typedef float f32x16 __attribute__((ext_vector_type(16)));
typedef short v4i16_t __attribute__((ext_vector_type(4)));
#define MX_LAS __attribute__((address_space(3)))
typedef MX_LAS unsigned char* lptr;
constexpr int KR_OFF = 0, VR_OFF = 49152, OST_OFF = 98304;
constexpr int N_ATT_P = 32 * 3 * 32, N_ATT = N_ATT_P + 32 * 3, N_POOL_P = 32 * 32, N_UNITS = N_ATT + N_POOL_P + 32;
typedef float f32x2_t __attribute__((ext_vector_type(2))); typedef __bf16 bf16x2_t __attribute__((ext_vector_type(2)));
__device__ __forceinline__ unsigned pk_bf16(float lo, float hi) { f32x2_t v = {lo, hi}; bf16x2_t b = __builtin_convertvector(v, bf16x2_t); return __builtin_bit_cast(unsigned, b); }
__device__ __forceinline__ float bf_lo(unsigned w) { return __uint_as_float(w << 16); }
__device__ __forceinline__ float bf_hi(unsigned w) { return __uint_as_float(w & 0xffff0000u); }
__device__ __forceinline__ v4i16_t vtr(lptr p) { return __builtin_amdgcn_ds_read_tr16_b64_v4i16((MX_LAS v4i16_t*)p); }

struct AUnit { bool samp; int b, c, kvh, row0; };
__device__ __forceinline__ AUnit pool_decode(int j) { AUnit u; u.samp = j >= N_POOL_P; u.b = u.samp ? j - N_POOL_P : j >> 5; u.c = u.samp ? 0 : (j & 31); u.kvh = 0; u.row0 = u.samp ? MP + u.b * 64 : u.b * 2048 + 64 * u.c; return u; }
__device__ __forceinline__ void glds16(const void* gsrc, unsigned lds_dst) { unsigned keep;
    asm volatile("s_mov_b32 %0, m0\n\ts_mov_b32 m0, %2\n\ts_nop 0\n\tglobal_load_lds_dwordx4 %1, off\n\ts_mov_b32 m0, %0" : "=&s"(keep) : "v"(gsrc), "s"(lds_dst) : "memory"); }
#define MX_GLDS(src, dst) glds16((src), (unsigned)__builtin_amdgcn_readfirstlane((int)(unsigned)(uintptr_t)(dst)))

__device__ __forceinline__ void attn_issue_chunk(lptr ring, int slot, int j, const bf16_t* Z, const bf16_t* CK, const bf16_t* CV, const AUnit& u, int wid, int lane) {
    const int kkey = 8 * wid + (lane >> 3), kch = (lane & 7) ^ ((lane >> 3) & 7);
    const int vdh = wid >> 2, vkey = 16 * (wid & 3) + (lane >> 2), vch = 4 * vdh + (lane & 3);
    const bf16_t *ks, *vs;
    if (u.samp && j < 2) { const size_t o = (size_t)(u.b * 128 + 64 * j) * 192 + 64 * u.kvh; ks = CK + o + (size_t)kkey * 192 + 8 * kch; vs = CV + o + (size_t)vkey * 192 + 8 * vch; }
    else { const bool valid = u.samp || (u.c - 2 + j >= 0); const int rb = valid ? u.row0 - 128 + 64 * j : u.row0;
        ks = Z + (size_t)(16 + u.kvh) * MT * 64 + pg8::zsub_off(rb + kkey, 8 * kch); vs = Z + (size_t)(19 + u.kvh) * MT * 64 + pg8::zsub_off(rb + vkey, 8 * vch); }
    MX_GLDS(ks, ring + KR_OFF + slot * 8192 + wid * 1024);
    MX_GLDS(vs, ring + VR_OFF + slot * 8192 + wid * 1024);
}
__device__ __forceinline__ void attn_qload(bf16x8 (&q)[4], const bf16_t* Z, const AUnit& u, int wid, int lane) {
    const bf16_t* qp = Z + (size_t)(4 + 4 * u.kvh + (wid >> 1)) * MT * 64 + pg8::zsub_off(u.row0 + 32 * (wid & 1) + (lane & 31), 8 * (lane >> 5));
#pragma unroll
    for (int ks = 0; ks < 4; ++ks) q[ks] = __builtin_nontemporal_load((const bf16x8*)(qp + 512 * (ks >> 1) + 16 * (ks & 1)));
}
__device__ __forceinline__ void attn_compute(lptr ring, int sl0, int sl1, int sl2, const bf16x8 (&qr)[4], bf16_t* MIX, float sink2, const AUnit& u, int wid, int lane) {
    const int slb[3] = {sl0 * 8192, sl1 * 8192, sl2 * 8192};
    const int r32 = lane & 31, hi = lane >> 5, g = wid >> 1, qh = wid & 1, hq = 4 * u.kvh + g;
    const float slope2 = __builtin_amdgcn_exp2f(-8.0f * (float)(hq + 1) * (1.0f / 12.0f)) * LOG2E;
    const float qb = (float)(32 * qh + r32 + 128 - 4 * hi);
    const float nsq = -slope2 * qb;
    f32x16 p[6];
#pragma unroll
    for (int kb = 0; kb < 6; ++kb) {
        const bool valid = u.samp || (u.c - 2 + (kb >> 1) >= 0);
#pragma unroll
        for (int r = 0; r < 16; ++r) { const float cst = (float)(32 * kb + (r & 3) + 8 * (r >> 2));
            const float bias = kb < 4 ? __builtin_fmaf(slope2, cst, nsq) : -slope2 * __builtin_fabsf(qb - cst);
            p[kb][r] = valid ? bias : -1e30f; }
#pragma unroll
        for (int ks = 0; ks < 4; ++ks) {
            const bf16x8 kf = *(const MX_LAS bf16x8*)(ring + KR_OFF + slb[kb >> 1] + (32 * (kb & 1) + r32) * 128 + (((2 * ks + hi) ^ (r32 & 7)) << 4));
            p[kb] = __builtin_amdgcn_mfma_f32_32x32x16_bf16(kf, qr[ks], p[kb], 0, 0, 0);
        }
    }
    float sum = 0.f;
#pragma unroll
    for (int kb = 0; kb < 6; ++kb)
#pragma unroll
        for (int r = 0; r < 16; ++r) { p[kb][r] = __builtin_amdgcn_exp2f(p[kb][r]); sum += p[kb][r]; }
    sum += __shfl_xor(sum, 32);
    sum += __builtin_amdgcn_exp2f(sink2);
    const float inv = 1.0f / sum;
    f32x16 o[2];
#pragma unroll
    for (int r = 0; r < 16; ++r) { o[0][r] = 0.f; o[1][r] = 0.f; }
    const lptr vb = ring + VR_OFF + ((lane >> 4) & 1) * 32 + (lane & 3) * 8 + (4 * hi + ((lane & 15) >> 2)) * 64;
#pragma unroll
    for (int kb = 0; kb < 6; ++kb)
#pragma unroll
        for (int s = 0; s < 2; ++s) {
            u32x4 pw;
            pw.x = pk_bf16(p[kb][8 * s + 0], p[kb][8 * s + 1]); pw.y = pk_bf16(p[kb][8 * s + 2], p[kb][8 * s + 3]);
            pw.z = pk_bf16(p[kb][8 * s + 4], p[kb][8 * s + 5]); pw.w = pk_bf16(p[kb][8 * s + 6], p[kb][8 * s + 7]);
            const bf16x8 pf = __builtin_bit_cast(bf16x8, pw);
#pragma unroll
            for (int db = 0; db < 2; ++db) {
                const v4i16_t lo = vtr(vb + slb[kb >> 1] + db * 4096 + (32 * (kb & 1) + 16 * s) * 64), hh = vtr(vb + slb[kb >> 1] + db * 4096 + (32 * (kb & 1) + 16 * s + 8) * 64);
                const bf16x8 vf = (bf16x8){lo[0], lo[1], lo[2], lo[3], hh[0], hh[1], hh[2], hh[3]};
                o[db] = __builtin_amdgcn_mfma_f32_32x32x16_bf16(vf, pf, o[db], 0, 0, 0);
            }
        }
    const lptr st = ring + OST_OFF + wid * 4096;
#pragma unroll
    for (int db = 0; db < 2; ++db)
#pragma unroll
        for (int rg = 0; rg < 4; ++rg) { u32x2 w; w.x = pk_bf16(o[db][4 * rg] * inv, o[db][4 * rg + 1] * inv); w.y = pk_bf16(o[db][4 * rg + 2] * inv, o[db][4 * rg + 3] * inv);
            *(MX_LAS u32x2*)(st + r32 * 128 + (((4 * db + rg) ^ (r32 & 7)) << 4) + 8 * hi) = w; }
    asm volatile("s_waitcnt lgkmcnt(0)" ::: "memory");
    bf16_t* op = MIX + ((size_t)(u.row0 >> 8) * 16 + 4 + hq) * (256 * 64);
#pragma unroll
    for (int i = 0; i < 4; ++i) { const int row = 8 * i + (lane >> 3); const u32x4 v = *(const MX_LAS u32x4*)(st + row * 128 + (((lane & 7) ^ (row & 7)) << 4)); *(u32x4*)(op + pg8::img_off((u.row0 & 255) + 32 * qh + row, 8 * (lane & 7))) = v; }
}

__device__ __forceinline__ void pool_issue(lptr buf, const bf16_t* Z, const bf16_t* CP, const bf16_t* ZERO, const AUnit& u, int wid, int lane) {
#pragma unroll
    for (int j = 0; j < 5; ++j) {
        const int p = wid + 8 * j, ri = 2 * p + (lane >> 5), rc = ri > 78 ? 78 : ri, ch = (lane & 31) ^ (ri & 15);
        const bf16_t* src = Z + (size_t)(ch >> 3) * MT * 64 + pg8::zsub_off(u.row0 + rc - 15, 8 * (ch & 7));
        if (ri < 15) { if (u.samp) src = CP + (size_t)(u.b * 15 + ri) * 256 + 8 * ch; else if (u.c == 0) src = ZERO + 8 * (lane & 31); }
        MX_GLDS(src, buf + p * 1024);
    }
}
__device__ __forceinline__ void pool_compute(lptr buf, const bf16x8 (&wf)[2][4], bf16_t* MIX, const AUnit& u, int wid, int lane) {
    const int r32 = lane & 31, hi = lane >> 5;
    const int g = wid >> 1, hh = wid & 1, W = 2 << g, t = 32 * hh + r32;
    const int pos = u.samp ? 4096 + t : 64 * u.c + t;
    const float icnt = 1.0f / (float)((pos + 1 < W) ? pos + 1 : W);
    bf16x8 df[4];
#pragma unroll
    for (int ks = 0; ks < 4; ++ks) {
        const int chunk = 8 * g + 2 * ks + hi;
        float a[8]; u32x4 cur = (u32x4){0u, 0u, 0u, 0u};
#pragma unroll
        for (int e = 0; e < 8; ++e) a[e] = 0.f;
        for (int i = 0; i < W; ++i) {
            const int ri = t + 15 - i;
            const u32x4 v = *(const MX_LAS u32x4*)(buf + ri * 512 + ((chunk ^ (ri & 15)) << 4));
            a[0] += bf_lo(v.x); a[1] += bf_hi(v.x); a[2] += bf_lo(v.y); a[3] += bf_hi(v.y); a[4] += bf_lo(v.z); a[5] += bf_hi(v.z); a[6] += bf_lo(v.w); a[7] += bf_hi(v.w);
            if (i == 0) cur = v;
        }
        u32x4 dw;
        dw.x = pk_bf16(a[0] * icnt - bf_lo(cur.x), a[1] * icnt - bf_hi(cur.x)); dw.y = pk_bf16(a[2] * icnt - bf_lo(cur.y), a[3] * icnt - bf_hi(cur.y));
        dw.z = pk_bf16(a[4] * icnt - bf_lo(cur.z), a[5] * icnt - bf_hi(cur.z)); dw.w = pk_bf16(a[6] * icnt - bf_lo(cur.w), a[7] * icnt - bf_hi(cur.w));
        df[ks] = __builtin_bit_cast(bf16x8, dw);
    }
    bf16_t* op = MIX + ((size_t)(u.row0 >> 8) * 16 + g) * (256 * 64);
#pragma unroll
    for (int eb = 0; eb < 2; ++eb) {
        f32x16 o;
#pragma unroll
        for (int r = 0; r < 16; ++r) o[r] = 0.f;
#pragma unroll
        for (int ks = 0; ks < 4; ++ks) o = __builtin_amdgcn_mfma_f32_32x32x16_bf16(wf[eb][ks], df[ks], o, 0, 0, 0);
#pragma unroll
        for (int rg = 0; rg < 4; ++rg) { u32x2 w; w.x = pk_bf16(o[4 * rg], o[4 * rg + 1]); w.y = pk_bf16(o[4 * rg + 2], o[4 * rg + 3]); *(u32x2*)(op + pg8::img_off((u.row0 & 255) + t, 32 * eb + 8 * rg + 4 * hi)) = w; }
    }
}

#define MX_SYNC() do { asm volatile("s_waitcnt vmcnt(0) lgkmcnt(0)" ::: "memory"); __builtin_amdgcn_s_barrier(); asm volatile("" ::: "memory"); } while (0)
__device__ __forceinline__ void mix_phase(lptr lds, const bf16_t* Z, const bf16_t* CK, const bf16_t* CV, const bf16_t* CP, const bf16_t* WPt, const bf16_t* ZERO, bf16_t* MIX, const float* sinks, int first, int stride) {
    const int tid = threadIdx.x, lane = tid & 63, wid = __builtin_amdgcn_readfirstlane(tid >> 6);
    constexpr int PBUF = 40960;
    constexpr int NRUN_P = 32 * 3 * 8, NRUN = NRUN_P + 32 * 3;
    int par = 0;
    if (first < NRUN) {
        const int g = wid >> 1;
        float sk0 = sinks[g] * LOG2E, sk1 = sinks[4 + g] * LOG2E, sk2 = sinks[8 + g] * LOG2E;
        asm volatile("" : "+v"(sk0), "+v"(sk1), "+v"(sk2));
        int run = first, st = 0, head = 0;
        auto unit_of = [](int run, int st) { AUnit u; u.samp = run >= NRUN_P; const int rr = u.samp ? run : NRUN_P - 1 - run;     const int a = u.samp ? run - NRUN_P : rr >> 3; u.b = a / 3; u.kvh = a % 3; u.c = u.samp ? 0 : 4 * (rr & 7) + st;
                                              u.row0 = u.samp ? MP + u.b * 64 : u.b * 2048 + 64 * u.c; return u; };
        bf16x8 qn[4];
        AUnit u = unit_of(run, 0);
        int s0 = 0, s1 = 1, s2 = 2; head = 3;
        attn_issue_chunk(lds, 0, 0, Z, CK, CV, u, wid, lane); attn_issue_chunk(lds, 1, 1, Z, CK, CV, u, wid, lane); attn_issue_chunk(lds, 2, 2, Z, CK, CV, u, wid, lane);
        attn_qload(qn, Z, u, wid, lane);
        for (;;) {
            MX_SYNC();
            bf16x8 qr[4];
#pragma unroll
            for (int ks = 0; ks < 4; ++ks) qr[ks] = qn[ks];
            asm volatile("" : "+v"(qr[0]), "+v"(qr[1]), "+v"(qr[2]), "+v"(qr[3]));
            int nrun = run, nst = st + 1; const int len = (run >= NRUN_P) ? 1 : 4;
            if (nst == len) { nrun = run + stride; nst = 0; }
            const bool more = nrun < NRUN;
            int n0 = s1, n1 = s2, n2 = head;
            AUnit un = u;
            if (more) {
                un = unit_of(nrun, nst);
                if (nst == 0) { n0 = head; n1 = head + 1 >= 6 ? head - 5 : head + 1; n2 = head + 2 >= 6 ? head - 4 : head + 2;
                    attn_issue_chunk(lds, n0, 0, Z, CK, CV, un, wid, lane); attn_issue_chunk(lds, n1, 1, Z, CK, CV, un, wid, lane); attn_issue_chunk(lds, n2, 2, Z, CK, CV, un, wid, lane);
                    head = head + 3 >= 6 ? head - 3 : head + 3; }
                else { attn_issue_chunk(lds, n2, 2, Z, CK, CV, un, wid, lane); head = head + 1 >= 6 ? 0 : head + 1; }
                attn_qload(qn, Z, un, wid, lane);
            }
            attn_compute(lds, s0, s1, s2, qr, MIX, u.kvh == 0 ? sk0 : (u.kvh == 1 ? sk1 : sk2), u, wid, lane);
            if (!more) break;
            run = nrun; st = nst; u = un; s0 = n0; s1 = n1; s2 = n2;
        }
    }
    MX_SYNC();
    int pj = first >= 96 ? first - 96 : first + stride - 96; par = 0;
    if (pj < N_POOL_P + 32) {
        bf16x8 wf[2][4];
#pragma unroll
        for (int eb = 0; eb < 2; ++eb)
#pragma unroll
            for (int ks = 0; ks < 4; ++ks) wf[eb][ks] = *(const bf16x8*)(WPt + (size_t)(((wid >> 1) * 64 + 32 * eb + (lane & 31)) * 64 + 16 * ks + 8 * (lane >> 5)));
        pool_issue(lds, Z, CP, ZERO, pool_decode(pj), wid, lane);
        for (; pj < N_POOL_P + 32; pj += stride, par ^= 1) {
            const AUnit u = pool_decode(pj);
            MX_SYNC();
            if (pj + stride < N_POOL_P + 32) pool_issue(lds + (par ^ 1) * PBUF, Z, CP, ZERO, pool_decode(pj + stride), wid, lane);
            pool_compute(lds + par * PBUF, wf, MIX, u, wid, lane);
        }
    }
    MX_SYNC();
}
#undef MX_SYNC
#undef MX_GLDS
#undef MX_LAS
}
constexpr int NWAVES = 8;
#ifndef MK_N_LAUNCHES
#define MK_N_LAUNCHES 1
#endif
constexpr int N_LAUNCHES = MK_N_LAUNCHES;
constexpr int PER_PHASE = 6;
#ifndef MK_P5_LAG
#define MK_P5_LAG 900
#endif
constexpr int P5_LAG = MK_P5_LAG;

constexpr size_t MiB = 1u << 20;
constexpr size_t WS_CTL = 0, CTL_ZERO_BYTES = 64 * 1024, WS_ZERO = 512 * 1024, WS_SS = 1 * MiB;
constexpr size_t WS_WIN = 2 * MiB, WS_WOUT = 5 * MiB, WS_WGU = 7 * MiB, WS_WD = 18 * MiB;
constexpr size_t WS_WP = 24 * MiB, WS_CK = 25 * MiB, WS_CV = 27 * MiB, WS_CP = 29 * MiB;
constexpr size_t WS_RX = 30 * MiB;
constexpr size_t WS_XB = 32 * MiB;
constexpr size_t WS_Z = 164 * MiB;
constexpr size_t WS_MIX = 346 * MiB;
constexpr size_t WS_ACT = 478 * MiB;
constexpr size_t WS_HB = 842 * MiB;
constexpr size_t WS_END = 974 * MiB;
static_assert(WS_SS + (size_t)67584 * 4 <= WS_WIN && WS_WD + (size_t)1024 * 2816 * 2 <= WS_WP && WS_XB + (size_t)67584 * 1024 * 2 <= WS_Z && WS_Z + (size_t)67584 * 1408 * 2 <= WS_MIX &&
              WS_MIX + (size_t)67584 * 1024 * 2 <= WS_ACT && WS_ACT + (size_t)67584 * 2816 * 2 <= WS_HB && WS_HB + (size_t)67584 * 1024 * 2 <= WS_END && WS_RX + (size_t)67584 * 4 <= WS_XB, "d_ws map");
constexpr int CW_TMO = 0, CW_CODE = 1;
constexpr int CW_BAR = 4096;
constexpr int RING_OFF = 0, RING_BYTES = 131072;
constexpr int LDSCTL_OFF = RING_BYTES, MISC_OFF = LDSCTL_OFF + 320;
constexpr int STAGE_OFF = LDSCTL_OFF + 1024;
constexpr int JUNK_OFF = STAGE_OFF + 16384;
constexpr int LDS_BYTES = STAGE_OFF + 16384;
static_assert(MISC_OFF + 128 <= LDS_BYTES, "LDS map");

#define GAS __attribute__((address_space(1)))
#define LAS __attribute__((address_space(3)))
typedef unsigned short bf16;
typedef unsigned v4u __attribute__((ext_vector_type(4)));
typedef float f32x4 __attribute__((ext_vector_type(4)));
typedef short bf16x8 __attribute__((ext_vector_type(8)));
typedef GAS unsigned gu32;
typedef GAS unsigned long long gu64;
#define RLX_AGENT __ATOMIC_RELAXED, __HIP_MEMORY_SCOPE_AGENT
#define LDS_WAIT() asm volatile("s_waitcnt lgkmcnt(0)" ::: "memory")
#define VM_WAIT() asm volatile("s_waitcnt vmcnt(0)" ::: "memory")
__device__ __forceinline__ unsigned long long rt() { return __builtin_amdgcn_s_memrealtime(); }
__device__ __forceinline__ unsigned f2bf(float f) { unsigned u = __builtin_bit_cast(unsigned, f); return (u + 0x7fffu + ((u >> 16) & 1u)) >> 16; }
__device__ __forceinline__ unsigned pk2(float lo, float hi) { return f2bf(lo) | (f2bf(hi) << 16); }

#define XB_TMO      128
#define XB_XCNT(j)  (256  + 64 * (j))
#define XB_XSUB(j)  (1280 + 64 * (j))
#define XB_XGEN(j)  (2304 + 64 * (j))
#define XB_TOP      3328
#define XB_TOPGEN   3392
#define XCD_BAR_WORDS 3456
#define XB_SPIN_CAP (1u << 18)

__device__ __forceinline__ unsigned xb_ld(unsigned* p)              { return __hip_atomic_load(p, __ATOMIC_RELAXED, __HIP_MEMORY_SCOPE_AGENT); }
__device__ __forceinline__ unsigned xb_add(unsigned* p, unsigned v) { return __hip_atomic_fetch_add(p, v, __ATOMIC_RELAXED, __HIP_MEMORY_SCOPE_AGENT); }
__device__ __forceinline__ unsigned xb_xcc_id() { return (unsigned)__builtin_amdgcn_s_getreg((3 << 11) | 20) & 0xFu; }
#define XB_SPIN(cond, bar) do { unsigned _sp = 0; while (cond) { __builtin_amdgcn_s_sleep(1); \
    if ((++_sp & 255u) == 0u) { if (xb_ld(&(bar)[XB_TMO])) break; if (_sp > XB_SPIN_CAP) { atomicAdd(&(bar)[XB_TMO], 1u); break; } } } } while (0)

struct XcdBarrier {
    unsigned* bar; unsigned x;
    volatile LAS unsigned* st;
};

__device__ __forceinline__ XcdBarrier xcd_barrier_post(unsigned* bar, volatile LAS unsigned* st) {
    XcdBarrier b; b.bar = bar; b.x = xb_xcc_id(); b.st = st;
    if (threadIdx.x == 0) (void)xb_add(&bar[XB_XCNT(b.x)], 1u);
    return b;
}
__device__ __forceinline__ void xcd_barrier_complete(unsigned* bar, unsigned x, unsigned& nloc, unsigned& nx) {
    const unsigned G = gridDim.x * gridDim.y * gridDim.z;
    unsigned sum, cnt, mine, sp = 0u;
    for (;;) {
        sum = 0u; cnt = 0u; mine = 0u;
#pragma unroll
        for (unsigned j = 0; j < 16; ++j) { const unsigned c = xb_ld(&bar[XB_XCNT(j)]); sum += c; cnt += (c > 0u) ? 1u : 0u; mine = (j == x) ? c : mine; }
        if (sum == G) break;
        __builtin_amdgcn_s_sleep(1);
        if ((++sp & 255u) == 0u) { if (xb_ld(&bar[XB_TMO])) break; if (sp > XB_SPIN_CAP) { atomicAdd(&bar[XB_TMO], 1u); break; } }
    }
    nloc = mine > 0u ? mine : 1u; nx = cnt > 0u ? cnt : 1u;
}

__device__ __forceinline__ void xcd_barrier(const XcdBarrier& b) {
    asm volatile("s_waitcnt vmcnt(0)" ::: "memory");
    __syncthreads();
    if (threadIdx.x == 0) {
        unsigned* bar = b.bar;
        __builtin_amdgcn_s_waitcnt(0);
        unsigned nloc = b.st[0], nx = b.st[1];
        if (nloc == 0u) { xcd_barrier_complete(bar, b.x, nloc, nx); b.st[0] = nloc; b.st[1] = nx; }
        const unsigned old = xb_add(&bar[XB_XSUB(b.x)], 1u);
        const unsigned gen = old / nloc;
        if (old + 1u == (gen + 1u) * nloc) {
            __builtin_amdgcn_fence(__ATOMIC_RELEASE, "agent");
            asm volatile("s_waitcnt vmcnt(0)" ::: "memory");
            const unsigned og = xb_add(&bar[XB_TOP], 1u);
            const unsigned tg = og / nx;
            if (og + 1u == (tg + 1u) * nx) xb_add(&bar[XB_TOPGEN], 1u);
            else XB_SPIN(xb_ld(&bar[XB_TOPGEN]) == tg, bar);
            __builtin_amdgcn_fence(__ATOMIC_ACQUIRE, "agent");
            xb_add(&bar[XB_XGEN(b.x)], 1u);
            asm volatile("s_waitcnt vmcnt(0)" ::: "memory");
        } else {
            XB_SPIN(xb_ld(&bar[XB_XGEN(b.x)]) == gen, bar);
            __builtin_amdgcn_fence(__ATOMIC_ACQUIRE, "agent");
            asm volatile("s_waitcnt vmcnt(0)" ::: "memory");
        }
    }
    __syncthreads();
}
struct Frame {
    LAS unsigned char* lds;
    volatile LAS unsigned* MISC;
    gu32* ctl;
    int tid, lane, wave;
    int vcu, G;
};

__device__ __forceinline__ float wave_sum(float v) {
#pragma unroll
    for (int o = 1; o < 64; o <<= 1) v += __shfl_xor(v, o);
    return v;
}
__device__ __forceinline__ int p0_drow(int mode, int n0) {
    if (mode == 1) { const int lc = n0 & 255, dd = lc & 63; return n0 >= 1280 ? n0 : (n0 & ~255) + 128 * (dd >> 5) + 32 * (lc >> 6); }
    if (mode == 2) return 256 * (n0 >> 7) + (n0 & 127);
    if (mode == 3) return 256 * (n0 >> 7) + 128 + (n0 & 127);
    return n0;
}
__device__ __forceinline__ void p0_transpose_item(const float* W, const float* gain, int K, int N, bf16* WT, int kt, int b, int n0, int mode, LAS float* scr, int lane) {
    const int k0 = 64 * kt + 32 * b;
    const GAS f32x4* src = (const GAS f32x4*)(W + (size_t)(k0 + (lane >> 5)) * N + n0) + (lane & 31);
    f32x4 v[16];
#pragma unroll
    for (int i = 0; i < 16; ++i) v[i] = __builtin_nontemporal_load(src + (size_t)(2 * i) * (N >> 2));
    const int pb = lane * 16, ob = pb ^ (((pb >> 9) & 1) << 5), rr = ob >> 6, cc = (ob & 63) >> 1;
    f32x4 g0 = (f32x4){1.f, 1.f, 1.f, 1.f}, g1 = g0;
    if (gain) { g0 = *(const GAS f32x4*)(gain + k0 + cc); g1 = *(const GAS f32x4*)(gain + k0 + cc + 4); }
#pragma unroll
    for (int i = 0; i < 16; ++i) *(LAS f32x4*)(scr + (2 * i + (lane >> 5)) * 128 + 4 * (lane & 31)) = v[i];
    LDS_WAIT(); asm volatile("" ::: "memory");
#pragma unroll
    for (int g = 0; g < 4; ++g) {
        const int drow0 = p0_drow(mode, n0 + 32 * g);
        GAS unsigned char* base = (GAS unsigned char*)WT + ((size_t)((drow0 >> 8) * (K >> 6) + kt) * 2 + ((drow0 >> 7) & 1)) * pg8::HTB + (size_t)(((drow0 & 127) >> 4) * 2 + b) * 1024 + pb;
#pragma unroll
        for (int a = 0; a < 2; ++a) { const LAS float* t = scr + cc * 128 + 32 * g + pg8::perm32(16 * a + rr);
            v4u o; o.x = pk2(t[0 * 128] * g0.x, t[1 * 128] * g0.y); o.y = pk2(t[2 * 128] * g0.z, t[3 * 128] * g0.w); o.z = pk2(t[4 * 128] * g1.x, t[5 * 128] * g1.y); o.w = pk2(t[6 * 128] * g1.z, t[7 * 128] * g1.w);
            *(GAS v4u*)(base + a * 2048) = o; }
    }
    LDS_WAIT(); asm volatile("" ::: "memory");
}
__device__ __forceinline__ void x_rows2_to_bf16(const float* xa, const float* xb, bf16* oa, bf16* ob, float* ra, float* rb, int lane) {
    const GAS f32x4* pa = (const GAS f32x4*)xa + lane; const GAS f32x4* pb = (const GAS f32x4*)xb + lane;
    f32x4 va[4], vb[4]; float sa = 0.f, sb = 0.f;
#pragma unroll
    for (int j = 0; j < 4; ++j) { va[j] = __builtin_nontemporal_load(pa + 64 * j); vb[j] = __builtin_nontemporal_load(pb + 64 * j); }
#pragma unroll
    for (int j = 0; j < 4; ++j) { sa += (va[j].x * va[j].x + va[j].y * va[j].y) + (va[j].z * va[j].z + va[j].w * va[j].w); sb += (vb[j].x * vb[j].x + vb[j].y * vb[j].y) + (vb[j].z * vb[j].z + vb[j].w * vb[j].w); }
    GAS unsigned long long* qa = (GAS unsigned long long*)oa + lane; GAS unsigned long long* qb = (GAS unsigned long long*)ob + lane;
#pragma unroll
    for (int j = 0; j < 4; ++j) { qa[64 * j] = (unsigned long long)pk2(va[j].x, va[j].y) | ((unsigned long long)pk2(va[j].z, va[j].w) << 32);
                                  qb[64 * j] = (unsigned long long)pk2(vb[j].x, vb[j].y) | ((unsigned long long)pk2(vb[j].z, vb[j].w) << 32); }
    const float r1 = 1.f / sqrtf(wave_sum(sa) * (1.f / 1024.f) + 1e-6f), r2 = 1.f / sqrtf(wave_sum(sb) * (1.f / 1024.f) + 1e-6f);
    if (lane == 0) { *ra = r1; *rb = r2; }
}
struct P0Args { const float *xp, *xs, *cpool, *ck, *cv, *norm_mix, *w_in, *w_pool, *pool_scale, *w_out, *norm_ffn, *w_gate, *w_up, *w_down; float* out;
                bf16 *Win_t, *Wout_t, *Wgu_t, *Wd_t, *WPt, *CK, *CV, *CP, *XB; float* RX; float* SS; float* ZERO; };
__device__ __forceinline__ void p0_prologue(Frame& F, const P0Args& A) {
    LAS float* scr = (LAS float*)(F.lds + RING_OFF + F.wave * 16384);
    const int gw = F.vcu * NWAVES + F.wave, NGW = F.G * NWAVES;
    constexpr int I_IN = 32 * 11, I_OUT = 32 * 8, I_G = 32 * 22, I_D = 88 * 8, NITEMS = I_IN + I_OUT + 2 * I_G + I_D;
    for (int it = gw; it < NITEMS; it += NGW) {
        int r = it;
        if (r < I_IN) { const int kh = r / 11, nb = r % 11; p0_transpose_item(A.w_in, A.norm_mix, 1024, 1408, A.Win_t, kh >> 1, kh & 1, 128 * nb, 1, scr, F.lane); continue; } r -= I_IN;
        if (r < I_OUT) { const int kh = r / 8, nb = r % 8; p0_transpose_item(A.w_out, nullptr, 1024, 1024, A.Wout_t, kh >> 1, kh & 1, 128 * nb, 0, scr, F.lane); continue; } r -= I_OUT;
        if (r < I_G) { const int kh = r / 22, nb = r % 22; p0_transpose_item(A.w_gate, A.norm_ffn, 1024, 2816, A.Wgu_t, kh >> 1, kh & 1, 128 * nb, 2, scr, F.lane); continue; } r -= I_G;
        if (r < I_G) { const int kh = r / 22, nb = r % 22; p0_transpose_item(A.w_up, A.norm_ffn, 1024, 2816, A.Wgu_t, kh >> 1, kh & 1, 128 * nb, 3, scr, F.lane); continue; } r -= I_G;
        { const int kh = r / 8, nb = r % 8; p0_transpose_item(A.w_down, nullptr, 2816, 1024, A.Wd_t, kh >> 1, kh & 1, 128 * nb, 0, scr, F.lane); }
    }
    __syncthreads();
    {
        constexpr int RS = 2112, NG = pg8::MT / 16;
        LAS unsigned char* stg = F.lds + RING_OFF;
        f32x4 va[4], vb[4];
        int grp = F.vcu;
        auto issue = [&](int g) { const int r = 16 * g + 2 * F.wave; const float* xa = r < pg8::MP ? A.xp + (size_t)r * 1024 : A.xs + (size_t)(r - pg8::MP) * 1024;
            const GAS f32x4* pa = (const GAS f32x4*)xa + F.lane;
#pragma unroll
            for (int j = 0; j < 4; ++j) { va[j] = __builtin_nontemporal_load(pa + 64 * j); vb[j] = __builtin_nontemporal_load(pa + 256 + 64 * j); } };
        if (grp < NG) issue(grp);
        for (; grp < NG; grp += F.G) {
            const int r = 16 * grp + 2 * F.wave;
            float sa = 0.f, sb = 0.f;
#pragma unroll
            for (int j = 0; j < 4; ++j) { sa += (va[j].x * va[j].x + va[j].y * va[j].y) + (va[j].z * va[j].z + va[j].w * va[j].w); sb += (vb[j].x * vb[j].x + vb[j].y * vb[j].y) + (vb[j].z * vb[j].z + vb[j].w * vb[j].w); }
            LAS unsigned long long* la = (LAS unsigned long long*)(stg + (2 * F.wave) * RS) + F.lane; LAS unsigned long long* lb = (LAS unsigned long long*)(stg + (2 * F.wave + 1) * RS) + F.lane;
#pragma unroll
            for (int j = 0; j < 4; ++j) { la[64 * j] = (unsigned long long)pk2(va[j].x, va[j].y) | ((unsigned long long)pk2(va[j].z, va[j].w) << 32);
                                          lb[64 * j] = (unsigned long long)pk2(vb[j].x, vb[j].y) | ((unsigned long long)pk2(vb[j].z, vb[j].w) << 32); }
            if (grp + F.G < NG) issue(grp + F.G);
            const float r1 = 1.f / sqrtf(wave_sum(sa) * (1.f / 1024.f) + 1e-6f), r2 = 1.f / sqrtf(wave_sum(sb) * (1.f / 1024.f) + 1e-6f);
            if (F.lane == 0) { A.RX[r] = r1; A.RX[r + 1] = r2; }
            __syncthreads();
            GAS unsigned char* blk = (GAS unsigned char*)A.XB + ((size_t)(grp >> 4) * 16 * 2 + ((grp >> 3) & 1)) * pg8::HTB + (size_t)(grp & 7) * 2048;
            const int pb = F.lane * 16, ob = pb ^ (((pb >> 9) & 1) << 5), rr = ob >> 6, cc = (ob & 63) >> 1;
#pragma unroll
            for (int q = 0; q < 4; ++q) { const int st = F.wave + 8 * q, kt = st >> 1, ch = st & 1;
                const v4u val = *(const LAS v4u*)(stg + rr * RS + (kt * 64 + ch * 32 + cc) * 2);
                *(GAS v4u*)(blk + (size_t)kt * (2 * pg8::HTB) + ch * 1024 + pb) = val; }
            __syncthreads();
        }
    }
    const int gt = gw * 64 + F.lane, NGT = NGW * 64;
    for (int i = gt; i < 4 * 64 * 64; i += NGT) { const int g = i >> 12, e = (i >> 6) & 63, c = i & 63;
        A.WPt[i] = (bf16)f2bf(A.w_pool[(g * 64 + c) * 64 + e] * A.pool_scale[64 * g + e]); }
    for (int i = gt; i < 32 * 128 * 192 / 4; i += NGT) {
        const f32x4 k4 = ((const GAS f32x4*)A.ck)[i], v4 = ((const GAS f32x4*)A.cv)[i];
        ((GAS unsigned long long*)A.CK)[i] = (unsigned long long)pk2(k4.x, k4.y) | ((unsigned long long)pk2(k4.z, k4.w) << 32);
        ((GAS unsigned long long*)A.CV)[i] = (unsigned long long)pk2(v4.x, v4.y) | ((unsigned long long)pk2(v4.z, v4.w) << 32);
        const int b = i / (128 * 48), rr = (i / 48) & 127, q = i % 48;
        if (rr >= 64) { const size_t o = ((size_t)(b * 128 + rr - 64) * 192) / 4 + q; ((GAS f32x4*)(A.out + pg8::O_K_S))[o] = k4; ((GAS f32x4*)(A.out + pg8::O_V_S))[o] = v4; }
    }
    for (int i = gt; i < 67584 / 4; i += NGT) ((GAS f32x4*)A.SS)[i] = (f32x4){0.f, 0.f, 0.f, 0.f};
    if (gt < 64) ((GAS f32x4*)A.ZERO)[gt] = (f32x4){0.f, 0.f, 0.f, 0.f};
    for (int i = gt; i < 32 * 15 * 256 / 4; i += NGT) { const f32x4 p4 = ((const GAS f32x4*)A.cpool)[i]; ((GAS unsigned long long*)A.CP)[i] = (unsigned long long)pk2(p4.x, p4.y) | ((unsigned long long)pk2(p4.z, p4.w) << 32); }
}

struct Args { const float* in[17]; float* out; unsigned char* ws; int ph_lo, ph_hi, li, pad; };
__global__ void __launch_bounds__(NWAVES * 64, 2) mk_fwd(Args args) {
    extern __shared__ __attribute__((aligned(16))) unsigned char lds[];
    Frame F;
    F.lds = (LAS unsigned char*)lds;
    F.MISC = (volatile LAS unsigned*)(F.lds + MISC_OFF);
    F.tid = threadIdx.x; F.lane = F.tid & 63; F.wave = __builtin_amdgcn_readfirstlane(F.tid >> 6);
    F.G = gridDim.x; { const int bx = blockIdx.x; F.vcu = (F.G % 8 == 0) ? (bx % 8) * (F.G / 8) + bx / 8 : bx; }
#define GRID_BAR(seam) do { if (N_LAUNCHES == PER_PHASE) { if (F.tid == 0) __hip_atomic_store(F.ctl + CW_TMO, 0xBADBA0u | (unsigned)(seam), RLX_AGENT); } \
    else { xcd_barrier(bar); } } while (0)
    unsigned char* ws = args.ws;
    F.ctl = (gu32*)(ws + WS_CTL);
    float* const out = args.out;
    bf16* const Win_t = (bf16*)(ws + WS_WIN); bf16* const Wout_t = (bf16*)(ws + WS_WOUT); bf16* const Wgu_t = (bf16*)(ws + WS_WGU); bf16* const Wd_t = (bf16*)(ws + WS_WD);
    bf16* const WPt = (bf16*)(ws + WS_WP); bf16* const CKb = (bf16*)(ws + WS_CK); bf16* const CVb = (bf16*)(ws + WS_CV); bf16* const CPb = (bf16*)(ws + WS_CP);
    bf16* const XB = (bf16*)(ws + WS_XB); bf16* const HB = (bf16*)(ws + WS_HB); bf16* const Z = (bf16*)(ws + WS_Z); bf16* const MIX = (bf16*)(ws + WS_MIX); bf16* const ACT = (bf16*)(ws + WS_ACT);
    float* const SS = (float*)(ws + WS_SS); float* const RX = (float*)(ws + WS_RX);
    for (int u = F.tid; u < (LDS_BYTES - LDSCTL_OFF) / 4; u += NWAVES * 64) ((LAS unsigned*)(F.lds + LDSCTL_OFF))[u] = 0u;
    __syncthreads();
    const int bli = (N_LAUNCHES == PER_PHASE) ? 0 : args.li;
    XcdBarrier bar; bar.bar = (unsigned*)(F.ctl + CW_BAR) + bli * XCD_BAR_WORDS; bar.x = 0; bar.st = nullptr;
    if (N_LAUNCHES != PER_PHASE)
        bar = xcd_barrier_post((unsigned*)(F.ctl + CW_BAR) + bli * XCD_BAR_WORDS, F.MISC + 8);

    const int lo = args.ph_lo, hi = args.ph_hi;
#define IN(k) (lo <= (k) && (k) < hi)
#define BOTH(k) (IN(k) && IN((k) + 1))

    if (IN(0)) {
        P0Args A{args.in[0], args.in[1], args.in[2], args.in[3], args.in[4], args.in[5], args.in[6], args.in[7], args.in[8], args.in[12], args.in[13], args.in[14], args.in[15], args.in[16], out,
                 Win_t, Wout_t, Wgu_t, Wd_t, WPt, CKb, CVb, CPb, XB, RX, SS, (float*)(ws + WS_ZERO)};
        p0_prologue(F, A);
        if (BOTH(0)) GRID_BAR(0);
    }
    if (IN(1)) {
        pg8::Gemm g{XB, Win_t, pg8::MT, 1536, 1024};
        pg8::StaticOrder S; S.init(pg8::MT, 1280, F.G, (int)blockIdx.x);
        { pg8::BalancedFullOrder Sb; Sb.init(pg8::MT, 1280, F.G, (int)blockIdx.x); pg8::EpiZ E{Z, args.in[9], args.in[10], out, RX};
          pg8::gemm_phase<pg8::EpiZ, pg8::BalancedFullOrder, PG8_ALIGN, PG8_SP2>(F.lds + RING_OFF, g, Sb, E); }
        { pg8::BalancedHalfOrder T{5, 0, (int)blockIdx.x, F.G, S.nM, S.nwg % F.G}; pg8::EpiZv E{Z, out, RX};
          pg8::gemm_phase<pg8::EpiZv, pg8::BalancedHalfOrder, PG8_ALIGN, PG8_SP2, true>(F.lds + RING_OFF, g, T, E); }
        if (BOTH(1)) GRID_BAR(1);
    }
    if (IN(2)) {
        mixp::mix_phase(F.lds + RING_OFF, Z, CKb, CVb, CPb, WPt, (const bf16*)(ws + WS_ZERO), MIX, args.in[11], (int)blockIdx.x, F.G);
        if (BOTH(2)) GRID_BAR(2);
    }
    if (IN(3)) {
        pg8::Gemm g{MIX, Wout_t, pg8::MT, 1024, 1024}; pg8::StaticOrder S; S.init(pg8::MT, 1024, F.G, (int)blockIdx.x);
        const int full = (S.nwg / F.G) * F.G;
        { pg8::StaticOrder Sa = S; Sa.hi = full; pg8::EpiH<false> E{XB, HB, SS};
          pg8::gemm_phase<pg8::EpiH<false>, pg8::StaticOrder, PG8_ALIGN, PG8_SP2>(F.lds + RING_OFF, g, Sa, E); }
        { pg8::TailHalfOrder T{S, full, (int)blockIdx.x}; pg8::EpiH<true> E{XB, HB, SS};
          pg8::gemm_phase<pg8::EpiH<true>, pg8::TailHalfOrder, PG8_ALIGN, PG8_SP2, true>(F.lds + RING_OFF, g, T, E); }
        if (BOTH(3)) GRID_BAR(3);
    }
    if (IN(4)) {
        pg8::Gemm g{HB, Wgu_t, pg8::MT, 5632, 1024}; pg8::StaticOrder S; S.init(pg8::MT, 5632, F.G, (int)blockIdx.x);
        S.rev = 1;
        pg8::EpiAct E{SS, ACT, F.lds + STAGE_OFF};
        pg8::gemm_phase<pg8::EpiAct, pg8::StaticOrder, PG8_ALIGN, PG8_SP2>(F.lds + RING_OFF, g, S, E);
        if (BOTH(4)) GRID_BAR(4);
    }
    if (IN(5)) {
        pg8::Gemm g{ACT, Wd_t, pg8::MT, 1024, 2816}; pg8::StaticOrder S; S.init(pg8::MT, 1024, F.G, (int)blockIdx.x);
        const int full = (S.nwg / F.G) * F.G;
        { pg8::StaticOrder Sa = S; Sa.hi = full; pg8::EpiY<false> E{HB, out, F.lds + STAGE_OFF};
          pg8::gemm_phase<pg8::EpiY<false>, pg8::StaticOrder, PG8_ALIGN, PG8_SP2>(F.lds + RING_OFF, g, Sa, E); }
        { pg8::TailHalfOrder T{S, full, (int)blockIdx.x}; pg8::EpiY<true> E{HB, out, F.lds + STAGE_OFF};
          pg8::gemm_phase<pg8::EpiY<true>, pg8::TailHalfOrder, PG8_ALIGN, PG8_SP2, true>(F.lds + RING_OFF, g, T, E); }
    }
#undef IN
#undef BOTH
}

extern "C" void kernel_launch(void* const* d_in, const int* in_sizes, int n_in, void* d_out, int out_size, void* d_ws, size_t ws_size, hipStream_t stream) {
    static int grid = 0;
    if (grid == 0) {
        if (n_in != 17 || in_sizes[0] != 65536 * 1024 || out_size != (int)pg8::O_END || ws_size < WS_END) { fprintf(stderr, "kernel_launch: shape mismatch: n_in %d, in0 %d, out %d, ws %zu (need >= %zu); nothing launched\n", n_in, n_in > 0 ? in_sizes[0] : -1, out_size, ws_size, (size_t)WS_END); grid = -1; return; }
        int dev = 0, cus = 0, per_cu = 0;
        if (hipGetDevice(&dev) != hipSuccess || hipDeviceGetAttribute(&cus, hipDeviceAttributeMultiprocessorCount, dev) != hipSuccess) { fprintf(stderr, "kernel_launch: hipGetDevice / hipDeviceGetAttribute failed; nothing launched\n"); grid = -1; return; }
        if (hipFuncSetAttribute((const void*)mk_fwd, hipFuncAttributeMaxDynamicSharedMemorySize, LDS_BYTES) != hipSuccess) { fprintf(stderr, "kernel_launch: hipFuncSetAttribute failed; nothing launched\n"); grid = -1; return; }
        if (hipOccupancyMaxActiveBlocksPerMultiprocessor(&per_cu, (const void*)mk_fwd, NWAVES * 64, LDS_BYTES) != hipSuccess || per_cu < 1)
            fprintf(stderr, "kernel_launch: note: the occupancy query reports %d workgroups per CU\n", per_cu);
        (void)hipGetLastError();
        grid = cus;
    }
    if (grid < 0) return;
    if (hipMemsetAsync((char*)d_ws + WS_CTL, 0, CTL_ZERO_BYTES, stream) != hipSuccess) { fprintf(stderr, "kernel_launch: hipMemsetAsync of the control words failed; nothing launched\n"); return; }
    Args a{};
    for (int i = 0; i < 17; ++i) a.in[i] = (const float*)d_in[i];
    a.out = (float*)d_out; a.ws = (unsigned char*)d_ws;
    static_assert(((N_LAUNCHES >= 1 && N_LAUNCHES <= 3) || N_LAUNCHES == PER_PHASE) && (CW_BAR + 3 * XCD_BAR_WORDS) * 4 <= (int)CTL_ZERO_BYTES, "-DMK_N_LAUNCHES must be 1, 2, 3 or 6");
    const int cuts3[4] = {0, N_LAUNCHES == 3 ? 1 : (N_LAUNCHES == 2 ? 4 : PER_PHASE), N_LAUNCHES == 3 ? 4 : PER_PHASE, PER_PHASE};
    for (int li = 0; li < N_LAUNCHES; ++li) {
        a.ph_lo = (N_LAUNCHES == PER_PHASE) ? li : cuts3[li]; a.ph_hi = (N_LAUNCHES == PER_PHASE) ? li + 1 : cuts3[li + 1]; a.li = li;
        hipLaunchKernelGGL(mk_fwd, dim3(grid), dim3(NWAVES * 64), LDS_BYTES, stream, a);
        const hipError_t le = hipPeekAtLastError();
        if (le != hipSuccess) { fprintf(stderr, "kernel_launch: launch %d failed: %s (grid %d x %d threads, %d B LDS)\n", li, hipGetErrorName(le), grid, NWAVES * 64, LDS_BYTES); break; }
    }
}
```

```cpp
#include <hip/hip_runtime.h>
#include <cstdio>
#include <cstdint>
namespace pg8 {
#define PG8_LAS __attribute__((address_space(3)))
typedef unsigned short bf16_t;
typedef short bf16x8 __attribute__((ext_vector_type(8)));
typedef float f32x4 __attribute__((ext_vector_type(4)));
typedef unsigned u32x4 __attribute__((ext_vector_type(4)));
constexpr int BM = 256, BK = 64, HALF = 128, HTB = HALF * BK * 2  , STAGE_BYTES = 8 * HTB, NXCD = 8, WGM = 8;

__host__ __device__ __forceinline__ int lds_byte(int r, int c) { const int st = (r >> 4) * 2 + (c >> 5), rr = r & 15, cc = c & 31, ob = rr * 64 + cc * 2; return st * 1024 + (ob ^ (((ob >> 9) & 1) << 5)); }
__host__ __device__ __forceinline__ int img_off(int r, int c) { return ((r >> 7) * HTB + lds_byte(r & 127, c)) >> 1; }
__host__ __device__ __forceinline__ void stage_rc(int b, int& R, int& C) { const int st = b / 1024, sb = b % 1024, swz = sb ^ (((sb >> 9) & 1) << 5); R = (st >> 1) * 16 + swz / 64; C = (st & 1) * 32 + (swz % 64) / 2; }
__host__ __device__ __forceinline__ int inv_perm32(int x) { return 16 * ((x >> 2) & 1) + 4 * (x >> 3) + (x & 3); }
__host__ __device__ __forceinline__ int perm32(int rho) { const int n = rho >> 4, i = rho & 15; return 8 * (i >> 2) + 4 * n + (i & 3); }

struct Unit { int pm, pn, hb, hm; };
struct Gemm { const bf16_t* A; const bf16_t* Bt; int M, N, K; };

struct StaticOrder {
    int nM, nN, nwg, G, c, lo, hi, rev, wgm;
    __host__ __device__ void init(int M, int N, int G_, int c_) { nM = M / BM; nN = N / BM; nwg = nM * nN; G = G_; c = c_; lo = 0; hi = nwg; rev = 0; wgm = WGM; }
    __host__ __device__ bool next(int i, Unit& u) const {
        const long L = (long)lo + (long)i * G + c; if (L >= hi) return false;
        int wgid = (int)L; { const int q = nwg / NXCD, r = nwg % NXCD, xcd = wgid % NXCD, off = wgid / NXCD; wgid = (xcd < r ? xcd * (q + 1) : r * (q + 1) + (xcd - r) * q) + off; }
        const int nig = wgm * nN, gid = wgid / nig, fm = gid * wgm, gsz = (nM - fm) < wgm ? (nM - fm) : wgm;
        u.pm = fm + ((wgid % nig) % gsz); u.pn = (wgid % nig) / gsz; u.hb = 0; u.hm = 0; if (rev) u.pm = nM - 1 - u.pm; return true;
    }
    __host__ __device__ void tile_of(int L, Unit& u) const { StaticOrder t = *this; t.lo = L; t.hi = L + 1; t.c = 0; (void)t.next(0, u); }
    __device__ __forceinline__ void a_ready(const Unit&) const {}
    __device__ __forceinline__ void done(const Unit&) const {}
};
struct BalancedFullOrder : StaticOrder {
    __host__ __device__ bool next(int i, Unit& u) const {
        if (G != 256 || nwg != 1320) return StaticOrder::next(i, u);
        int L; if (i < 4) L = i * G + c; else if (i == 4 && c < 208) L = 4 * G + c; else if (i == 5 && c < 88) L = 4 * G + 208 + c; else return false;
        StaticOrder t = *this; t.lo = L; t.hi = L + 1; t.c = 0; return t.StaticOrder::next(0, u);
    }
};
struct BalancedHalfOrder {
    int pn, hb, c, G, nM, busy;
    __host__ __device__ bool next(int i, Unit& u) const { int j;
        if (G != 256 || nM != 264) { if (c < busy) return false; j = (c - busy) + (G - busy) * i; if (j >= nM) return false; u.pm = j; u.pn = pn; u.hb = hb; u.hm = 0; return true; }
        if (c < 88) return false; if (c < 208) { if (i > 0) return false; j = c - 88; } else { if (i > 2) return false; j = 120 + 3 * (c - 208) + i; }
        u.pm = j; u.pn = pn; u.hb = hb; u.hm = 0; return true; }
    __device__ __forceinline__ void a_ready(const Unit&) const {}
    __device__ __forceinline__ void done(const Unit&) const {}
};
struct TailHalfOrder {
    StaticOrder S; int lo, c;
    __host__ __device__ bool next(int i, Unit& u) const { if (i > 0) return false; const int L = lo + (c >> 1); if (L >= S.nwg) return false; S.tile_of(L, u); u.hb = c & 1; return true; }
    __device__ __forceinline__ void a_ready(const Unit&) const {}
    __device__ __forceinline__ void done(const Unit&) const {}
};
struct TailQuarterOrder {
    StaticOrder S; int lo, c;
    __host__ __device__ bool next(int i, Unit& u) const { if (i > 0) return false; const int L = lo + (c >> 2); if (L >= S.nwg) return false; S.tile_of(L, u); u.hb = c & 1; u.hm = (c >> 1) & 1; return true; }
    __device__ __forceinline__ void a_ready(const Unit&) const {}
    __device__ __forceinline__ void done(const Unit&) const {}
};
typedef float f32x2 __attribute__((ext_vector_type(2))); typedef __bf16 bf16x2_t __attribute__((ext_vector_type(2)));
__device__ __forceinline__ unsigned cvt_pk_bf16(float lo, float hi) { f32x2 v = {lo, hi}; bf16x2_t b = __builtin_convertvector(v, bf16x2_t); return __builtin_bit_cast(unsigned, b); }
typedef unsigned u32x2 __attribute__((ext_vector_type(2)));
constexpr float LOG2E = 1.4426950408889634f;
constexpr float C2 = 0.125f * LOG2E;
constexpr float EPS = 1e-6f;
constexpr int HALF_COLS = 128;
constexpr int DM = 1024, ZP = 1408, FF = 2816;
constexpr int MP = 65536, MS = 2048, MT = MP + MS;
constexpr size_t O_POOL_P = 69206016, O_K_P = 69328896, O_V_P = 70115328, O_POOL_S = 70901760, O_K_S = 71024640, O_V_S = 71811072, O_END = 72597504;

__host__ __device__ __forceinline__ size_t zsub_off(int row, int c) { return ((size_t)(row >> 4) * 2 + (c >> 5)) * 512 + (row & 15) * 32 + (c & 31); }
__device__ __forceinline__ void acc_zero(f32x4 (&acc)[2][2][4][2]) {
#pragma unroll
    for (int a = 0; a < 2; ++a)
#pragma unroll
        for (int b = 0; b < 2; ++b)
#pragma unroll
            for (int m = 0; m < 4; ++m)
#pragma unroll
                for (int n = 0; n < 2; ++n) acc[a][b][m][n] = (f32x4){0.f, 0.f, 0.f, 0.f};
}
__device__ __forceinline__ float bf_lo(unsigned w) { return __uint_as_float(w << 16); }
__device__ __forceinline__ float bf_hi(unsigned w) { return __uint_as_float(w & 0xffff0000u); }
template <bool HN = false, bool HM = false, bool BLK = false>
__device__ __forceinline__ void acc_from_bf16(f32x4 (&acc)[2][2][4][2], const bf16_t* R, const Unit& u, int wr, int wc, int fr, int fq) {
    const int r0 = (HM ? u.hm * HALF : 0) + wr * 64 + fr, c0 = u.pn * BM + (HN ? u.hb * HALF_COLS : 0) + wc * 32 + 8 * fq;
    const bf16_t* rp = BLK ? R + (size_t)u.pm * (1024 / BK) * (BM * BK) : R + ((size_t)u.pm * BM + r0) * 1024 + c0;
#pragma unroll
    for (int ai = 0; ai < (HM ? 1 : 2); ++ai)
#pragma unroll
        for (int m = 0; m < 4; ++m)
#pragma unroll
            for (int bj = 0; bj < (HN ? 1 : 2); ++bj) { const int c = c0 + bj * HALF;
                const u32x4 w = BLK ? *(const u32x4*)(rp + (size_t)(c >> 6) * (BM * BK) + img_off(r0 + ai * HALF + m * 16, c & 63)) : *(const u32x4*)(rp + (size_t)(ai * HALF + m * 16) * 1024 + bj * HALF);
                acc[ai][bj][m][0] = (f32x4){bf_lo(w.x), bf_hi(w.x), bf_lo(w.y), bf_hi(w.y)}; acc[ai][bj][m][1] = (f32x4){bf_lo(w.z), bf_hi(w.z), bf_lo(w.w), bf_hi(w.w)}; }
}

struct EpiZ {
    static constexpr bool PERM = true, AFTER_DRAIN = false, INIT_LOADS = false; static constexpr int RELAX = 0, B_AUX = 0, A_BLK = 1;
    bf16_t* Z; const float* qn; const float* kn; float* out; const float* RX; PG8_LAS unsigned char* stage;
    struct Aux {};
    __device__ __forceinline__ void init(f32x4 (&acc)[2][2][4][2], const Unit&, int, int, int, int) const { acc_zero(acc); }
    __device__ __forceinline__ void aux_load(Aux&, const Unit& u, int wr, int wc, int fr, int fq) const {
        __builtin_amdgcn_global_load_lds((const unsigned*)(RX + (size_t)u.pm * BM + 4 * (fr + 16 * fq)), (PG8_LAS unsigned*)(stage + (wr * 4 + wc) * 1024), 16, 0, 0);
    }
    __device__ __forceinline__ void operator()(const f32x4 (&acc)[2][2][4][2], const Aux&, const Unit& u, int wr, int wc, int fr, int fq) const {
        const int zcol = u.pn * 256 + wc * 64;
        if (zcol >= ZP) return;
        const int kind = (zcol >= 256 && zcol < 1024) ? 1 : ((zcol >= 1024 && zcol < 1216) ? 2 : 0);
        f32x4 sc[2][2];
#pragma unroll
        for (int bj = 0; bj < 2; ++bj)
#pragma unroll
            for (int n = 0; n < 2; ++n) {
                if (kind == 1) sc[bj][n] = *(const f32x4*)(qn + 32 * bj + 8 * fq + 4 * n) * C2;
                else if (kind == 2) sc[bj][n] = *(const f32x4*)(kn + 32 * bj + 8 * fq + 4 * n);
                else sc[bj][n] = (f32x4){1.f, 1.f, 1.f, 1.f};
            }
        const bool samp = u.pm >= 256;
        const int cm = (!samp && (u.pm & 7) != 7) ? 0 : (zcol < 256 ? 1 : (zcol >= 1216 ? 3 : (zcol >= 1024 ? 2 : 0)));
        const int rowbase = u.pm * BM + wr * 64 + fr;
        const PG8_LAS float* sl = (const PG8_LAS float*)(stage + (wr * 4 + wc) * 1024) + wr * 64 + fr;
#pragma unroll
        for (int ai = 0; ai < 2; ++ai)
#pragma unroll
            for (int m = 0; m < 4; ++m) {
                const int row = rowbase + ai * HALF + m * 16;
                const float rx = sl[ai * HALF + m * 16];
                float rs = rx;
                if (kind) {
                    float ss = 0.f;
#pragma unroll
                    for (int bj = 0; bj < 2; ++bj)
#pragma unroll
                        for (int n = 0; n < 2; ++n) { const f32x4 x = acc[ai][bj][m][n]; ss += (x[0] * x[0] + x[1] * x[1]) + (x[2] * x[2] + x[3] * x[3]); }
                    ss += __shfl_xor(ss, 16); ss += __shfl_xor(ss, 32);
                    rs = rx / sqrtf(ss * (rx * rx) * (1.0f / 64.0f) + EPS);
                }
                f32x4 v[2][2];
#pragma unroll
                for (int bj = 0; bj < 2; ++bj)
#pragma unroll
                    for (int n = 0; n < 2; ++n) v[bj][n] = acc[ai][bj][m][n] * rs * sc[bj][n];
                bf16_t* zp = Z + (size_t)(zcol >> 6) * MT * 64 + zsub_off(row, 8 * fq);
#pragma unroll
                for (int bj = 0; bj < 2; ++bj) { u32x4 w; w.x = cvt_pk_bf16(v[bj][0][0], v[bj][0][1]); w.y = cvt_pk_bf16(v[bj][0][2], v[bj][0][3]); w.z = cvt_pk_bf16(v[bj][1][0], v[bj][1][1]); w.w = cvt_pk_bf16(v[bj][1][2], v[bj][1][3]);
                    *(u32x4*)(zp + 512 * bj) = w; }
                if (cm) {
                    int b, t, T; if (samp) { const int r2 = row - MP; b = r2 >> 6; t = r2 & 63; T = 64; } else { b = row >> 11; t = row & 2047; T = 2048; }
                    float* dst = nullptr;
                    if (cm == 1) { const int i = t - (T - 15); if (i >= 0) dst = out + (samp ? O_POOL_S : O_POOL_P) + ((size_t)(b * 15 + i) * 256 + zcol); }
                    else { const int i = samp ? 64 + t : t - (T - 128); if (i >= 0) dst = out + (cm == 2 ? (samp ? O_K_S : O_K_P) : (samp ? O_V_S : O_V_P)) + ((size_t)(b * 128 + i) * 192 + (zcol - (cm == 2 ? 1024 : 1216))); }
                    if (dst) {
#pragma unroll
                        for (int bj = 0; bj < 2; ++bj)
#pragma unroll
                            for (int n = 0; n < 2; ++n) *(f32x4*)(dst + 32 * bj + 8 * fq + 4 * n) = v[bj][n];
                    }
                }
            }
    }
};

struct EpiZv {
    static constexpr bool PERM = true, AFTER_DRAIN = false, INIT_LOADS = false; static constexpr int RELAX = 0, B_AUX = 0, A_BLK = 1;
    bf16_t* Z; float* out; const float* RX; PG8_LAS unsigned char* stage;
    struct Aux {};
    __device__ __forceinline__ void init(f32x4 (&acc)[2][2][4][2], const Unit&, int, int, int, int) const { acc_zero(acc); }
    __device__ __forceinline__ void aux_load(Aux&, const Unit& u, int wr, int wc, int fr, int fq) const {
        __builtin_amdgcn_global_load_lds((const unsigned*)(RX + (size_t)u.pm * BM + 4 * (fr + 16 * fq)), (PG8_LAS unsigned*)(stage + (wr * 4 + wc) * 1024), 16, 0, 0);
    }
    __device__ __forceinline__ void operator()(const f32x4 (&acc)[2][2][4][2], const Aux&, const Unit& u, int wr, int wc, int fr, int fq) const {
        const int zcol = 1280 + 32 * wc + 8 * fq;
        const bool samp = u.pm >= 256, cache = samp || (u.pm & 7) == 7;
        const int rowbase = u.pm * BM + wr * 64 + fr;
        const PG8_LAS float* sl = (const PG8_LAS float*)(stage + (wr * 4 + wc) * 1024) + wr * 64 + fr;
#pragma unroll
        for (int ai = 0; ai < 2; ++ai)
#pragma unroll
            for (int m = 0; m < 4; ++m) {
                const int row = rowbase + ai * HALF + m * 16;
                const float rx = sl[ai * HALF + m * 16];
                const f32x4 v0 = acc[ai][0][m][0] * rx, v1 = acc[ai][0][m][1] * rx;
                u32x4 w; w.x = cvt_pk_bf16(v0[0], v0[1]); w.y = cvt_pk_bf16(v0[2], v0[3]); w.z = cvt_pk_bf16(v1[0], v1[1]); w.w = cvt_pk_bf16(v1[2], v1[3]);
                *(u32x4*)(Z + (size_t)(zcol >> 6) * MT * 64 + zsub_off(row, zcol & 63)) = w;
                if (cache) {
                    int b, i; if (samp) { const int r2 = row - MP; b = r2 >> 6; i = 64 + (r2 & 63); } else { b = row >> 11; i = (row & 2047) - 1920; }
                    if (i >= 0) { float* dst = out + (samp ? O_V_S : O_V_P) + ((size_t)(b * 128 + i) * 192 + (zcol - 1216)); *(f32x4*)dst = v0; *(f32x4*)(dst + 4) = v1; }
                }
            }
    }
};

template <bool HN = false, bool HM = false> struct EpiH {
    static constexpr bool PERM = true, AFTER_DRAIN = false, INIT_LOADS = true; static constexpr int RELAX = 0, B_AUX = 0, A_BLK = 1;
    const bf16_t* XB; bf16_t* HB; float* SS;
    struct Aux {};
    __device__ __forceinline__ void init(f32x4 (&acc)[2][2][4][2], const Unit& u, int wr, int wc, int fr, int fq) const { acc_from_bf16<HN, HM, true>(acc, XB, u, wr, wc, fr, fq); }
    __device__ __forceinline__ void aux_load(Aux&, const Unit&, int, int, int, int) const {}
    __device__ __forceinline__ void operator()(const f32x4 (&acc)[2][2][4][2], const Aux&, const Unit& u, int wr, int wc, int fr, int fq) const {
        const int col0 = u.pn * BM + (HN ? u.hb * HALF_COLS : 0) + wc * 32 + 8 * fq;
#pragma unroll
        for (int ai = 0; ai < (HM ? 1 : 2); ++ai) {
#pragma unroll
            for (int m = 0; m < 4; ++m) {
                const size_t grow = (size_t)u.pm * BM + (HM ? u.hm : ai) * HALF + wr * 64 + m * 16 + fr;
                float ss = 0.f;
#pragma unroll
                for (int bj = 0; bj < (HN ? 1 : 2); ++bj) { const f32x4 h0 = acc[ai][bj][m][0], h1 = acc[ai][bj][m][1];
                    ss += ((h0[0] * h0[0] + h0[1] * h0[1]) + (h0[2] * h0[2] + h0[3] * h0[3])) + ((h1[0] * h1[0] + h1[1] * h1[1]) + (h1[2] * h1[2] + h1[3] * h1[3]));
                    u32x4 w; w.x = cvt_pk_bf16(h0[0], h0[1]); w.y = cvt_pk_bf16(h0[2], h0[3]); w.z = cvt_pk_bf16(h1[0], h1[1]); w.w = cvt_pk_bf16(h1[2], h1[3]);
                    { const int c = col0 + bj * HALF; *(u32x4*)(HB + ((size_t)u.pm * (DM / BK) + (c >> 6)) * (BM * BK) + img_off((int)(grow & 255), c & 63)) = w; } }
                ss += __shfl_xor(ss, 16); ss += __shfl_xor(ss, 32);
                if (fq == 0) atomicAdd(SS + grow, ss);
            }
        }
    }
};

struct EpiAct {
    static constexpr bool PERM = true, AFTER_DRAIN = false, INIT_LOADS = false; static constexpr int RELAX = 0, B_AUX = 0, A_BLK = 1;
    const float* SS; bf16_t* ACT; PG8_LAS unsigned char* stage;
    struct Aux {};
    __device__ __forceinline__ void init(f32x4 (&acc)[2][2][4][2], const Unit&, int, int, int, int) const { acc_zero(acc); }
    __device__ __forceinline__ void aux_load(Aux&, const Unit& u, int wr, int wc, int fr, int fq) const {
        __builtin_amdgcn_global_load_lds((const unsigned*)(SS + (size_t)u.pm * BM + 4 * (fr + 16 * fq)), (PG8_LAS unsigned*)(stage + (wr * 4 + wc) * 1024), 16, 0, 0);
    }
    __device__ __forceinline__ void operator()(const f32x4 (&acc)[2][2][4][2], const Aux&, const Unit& u, int wr, int wc, int fr, int fq) const {
        const int col0 = u.pn * HALF + wc * 32 + 8 * fq;
        const PG8_LAS float* sl = (const PG8_LAS float*)(stage + (wr * 4 + wc) * 1024) + wr * 64 + fr;
#pragma unroll
        for (int ai = 0; ai < 2; ++ai)
#pragma unroll
            for (int m = 0; m < 4; ++m) {
                const size_t grow = (size_t)u.pm * BM + ai * HALF + wr * 64 + m * 16 + fr;
                const float r2 = __builtin_amdgcn_rcpf(sl[ai * HALF + m * 16] * (1.0f / DM) + EPS), rs = __builtin_amdgcn_sqrtf(r2), c1 = -LOG2E * rs;
                float o[8];
#pragma unroll
                for (int n = 0; n < 2; ++n)
#pragma unroll
                    for (int e = 0; e < 4; ++e) { const float g = acc[ai][0][m][n][e], uu = acc[ai][1][m][n][e];
                        o[4 * n + e] = (g * uu) * (r2 * __builtin_amdgcn_rcpf(1.0f + __builtin_amdgcn_exp2f(c1 * g))); }
                u32x4 w; w.x = cvt_pk_bf16(o[0], o[1]); w.y = cvt_pk_bf16(o[2], o[3]); w.z = cvt_pk_bf16(o[4], o[5]); w.w = cvt_pk_bf16(o[6], o[7]);
                *(u32x4*)(ACT + ((size_t)u.pm * (FF / BK) + (col0 >> 6)) * (BM * BK) + img_off((int)(grow & 255), col0 & 63)) = w;
            }
    }
};

template <bool HN = false, bool HM = false> struct EpiY {
    static constexpr bool PERM = true, AFTER_DRAIN = false, INIT_LOADS = true; static constexpr int RELAX = 0, B_AUX = 0, A_BLK = 1;
    const bf16_t* HB; float* Y; PG8_LAS unsigned char* stage;
    struct Aux {};
    __device__ __forceinline__ void init(f32x4 (&acc)[2][2][4][2], const Unit& u, int wr, int wc, int fr, int fq) const { acc_from_bf16<HN, HM, true>(acc, HB, u, wr, wc, fr, fq); }
    __device__ __forceinline__ void aux_load(Aux&, const Unit&, int, int, int, int) const {}
    __device__ __forceinline__ void operator()(const f32x4 (&acc)[2][2][4][2], const Aux&, const Unit& u, int wr, int wc, int fr, int fq) const {
        const int lane = fr + 16 * fq; PG8_LAS unsigned char* st = stage + (wr * 4 + wc) * 2048;
#pragma unroll
        for (int ai = 0; ai < (HM ? 1 : 2); ++ai) {
#pragma unroll
            for (int m = 0; m < 4; ++m) {
                float* tp = Y + ((size_t)u.pm * BM + (HM ? u.hm : ai) * HALF + wr * 64 + m * 16 + (lane >> 3)) * DM + u.pn * BM + (HN ? u.hb * HALF_COLS : 0) + wc * 32 + 4 * (lane & 7);
#pragma unroll
                for (int bj = 0; bj < (HN ? 1 : 2); ++bj) {
                    *(PG8_LAS f32x4*)(st + fr * 128 + (((2 * fq) ^ (fr & 7)) << 4)) = acc[ai][bj][m][0]; *(PG8_LAS f32x4*)(st + fr * 128 + (((2 * fq + 1) ^ (fr & 7)) << 4)) = acc[ai][bj][m][1];
                    asm volatile("s_waitcnt lgkmcnt(0)" ::: "memory");
#pragma unroll
                    for (int ps = 0; ps < 2; ++ps) { const int r = 8 * ps + (lane >> 3); const f32x4 v = *(const PG8_LAS f32x4*)(st + r * 128 + (((lane & 7) ^ (r & 7)) << 4)); *(f32x4*)(tp + (size_t)(8 * ps) * DM + bj * HALF) = v; }
                    asm volatile("s_waitcnt lgkmcnt(0)" ::: "memory");
                }
            }
        }
    }
};

template <class Epi, class Sched, bool ALIGN_EPI = false, bool SP2 = false, bool HALF_N = false>
__device__ __forceinline__ void gemm_phase(PG8_LAS unsigned char* lds, const Gemm g, const Sched& S, const Epi& E) {
    const int tid = threadIdx.x, wid = __builtin_amdgcn_readfirstlane(tid >> 6), lane = tid & 63, wr = wid >> 2, wc = wid & 3, fr = lane & 15, fq = lane >> 4;
    static_assert(SP2 || !HALF_N, "HALF_N needs the SP2 loop");
    const int K = g.K, nt = K / BK;
    unsigned voffA[2], voffB[2];
#pragma unroll
    for (int i = 0; i < 2; ++i) { int R, C; stage_rc(tid * 16 + i * 8192, R, C); const int Rb = Epi::PERM ? ((R & ~31) + perm32(R & 31)) : R;
        voffA[i] = Epi::A_BLK ? (unsigned)(tid * 16 + i * 8192) : (unsigned)(R * K + C) * 2u; voffB[i] = (unsigned)(tid * 16 + i * 8192); (void)Rb; }
    const size_t kstep = (size_t)(BK * 2);
    const size_t hstep = (size_t)HALF * K * 2;
    const size_t tstep = 2 * hstep;
    const size_t kstepA = Epi::A_BLK ? (size_t)BM * BK * 2 : kstep, hstepA = Epi::A_BLK ? (size_t)HALF * BK * 2 : hstep;
    const size_t kstepB = (size_t)BM * BK * 2, hstepB = (size_t)HALF * BK * 2;
    const unsigned ldsw = (unsigned)wid * 1024u;
    const int aoff = lds_byte(wr * 64 + fr, fq * 8), boff = lds_byte(wc * 32 + fr, fq * 8);
#define PG8_SA(b, h) (((b) * 2 + (h)) * HTB)
#define PG8_SB(b, h) ((4 + (b) * 2 + (h)) * HTB)
#define PG8_STAGE(bufoff, gbase, voff) do { _Pragma("unroll") for (int _i = 0; _i < 2; ++_i) \
        __builtin_amdgcn_global_load_lds((const unsigned*)((const char*)(gbase) + (voff)[_i]), (PG8_LAS unsigned*)(lds + (bufoff) + ldsw + _i * 8192), 16, 0, 0); } while (0)
#define PG8_STAGEB(bufoff, gbase) do { _Pragma("unroll") for (int _i = 0; _i < 2; ++_i) \
        __builtin_amdgcn_global_load_lds((const unsigned*)((const char*)(gbase) + voffB[_i]), (PG8_LAS unsigned*)(lds + (bufoff) + ldsw + _i * 8192), 16, 0, Epi::B_AUX); } while (0)
#define PG8_LDA(dst, b, h) do { _Pragma("unroll") for (int m = 0; m < 4; ++m) _Pragma("unroll") for (int k = 0; k < 2; ++k) dst[m][k] = *(const PG8_LAS bf16x8*)(lds + PG8_SA(b, h) + aoff + m * 2048 + k * 1024); } while (0)
#define PG8_LDB(dst, b, h) do { _Pragma("unroll") for (int n = 0; n < 2; ++n) _Pragma("unroll") for (int k = 0; k < 2; ++k) dst[n][k] = *(const PG8_LAS bf16x8*)(lds + PG8_SB(b, h) + boff + n * 2048 + k * 1024); } while (0)
#define PG8_MMA(ai, bj, At, Bt) do { __builtin_amdgcn_s_setprio(1); _Pragma("unroll") for (int m = 0; m < 4; ++m) _Pragma("unroll") for (int n = 0; n < 2; ++n) _Pragma("unroll") for (int k = 0; k < 2; ++k) \
        acc[ai][bj][m][n] = __builtin_amdgcn_mfma_f32_16x16x32_bf16(Bt[n][k], At[m][k], acc[ai][bj][m][n], 0, 0, 0); __builtin_amdgcn_s_setprio(0); } while (0)
#define PG8_WAIT_V(n) asm volatile("s_waitcnt vmcnt(" #n ")" ::: "memory")
#define PG8_WAIT_VK do { if constexpr (HALF_N) asm volatile("s_waitcnt vmcnt(6)" ::: "memory"); else asm volatile("s_waitcnt vmcnt(8)" ::: "memory"); } while (0)
#define PG8_STAGE_B1(bufoff, gbase) do { if constexpr (!HALF_N) PG8_STAGEB(bufoff, gbase); } while (0)
#define PG8_LDB1(dst, b) do { if constexpr (!HALF_N) PG8_LDB(dst, b, 1); } while (0)
#define PG8_MMA1(ai, At, Bt) do { if constexpr (!HALF_N) PG8_MMA(ai, 1, At, Bt); } while (0)
#define PG8_WAIT_V1 do { if (!HALF_N && Epi::RELAX == 9 && rl) asm volatile("s_waitcnt vmcnt(17)" ::: "memory"); else PG8_WAIT_VK; } while (0)
#define PG8_WAIT_L(n) asm volatile("s_waitcnt lgkmcnt(" #n ")" ::: "memory")
#define PG8_BAR __builtin_amdgcn_s_barrier()
#define PG8_SCHED __builtin_amdgcn_sched_barrier(0)
    Unit cur, nxt; int ui = 0;
    if (!S.next(0, cur)) return;
    f32x4 acc[2][2][4][2];
    typename Epi::Aux aux;
    E.init(acc, cur, wr, wc, fr, fq);
    bf16x8 At[4][2], B0[2][2], B1[2][2];
    const char* cA = (const char*)g.A + (size_t)cur.pm * tstep; const char* cB = (const char*)g.Bt + (size_t)cur.pn * tstep + (HALF_N ? (size_t)cur.hb * hstepB : (size_t)0);
    S.a_ready(cur);
    if constexpr (SP2) {
        PG8_STAGEB(PG8_SB(0, 0), cB); PG8_STAGE_B1(PG8_SB(0, 1), cB + hstepB); PG8_STAGE(PG8_SA(0, 0), cA, voffA); PG8_STAGE(PG8_SA(0, 1), cA + hstepA, voffA);
        if (wr == 1) PG8_BAR;
        PG8_WAIT_V(2); PG8_BAR;
        PG8_STAGEB(PG8_SB(1, 0), cB + kstepB); PG8_STAGE(PG8_SA(1, 0), cA + kstepA, voffA); PG8_STAGE_B1(PG8_SB(1, 1), cB + hstepB + kstepB);
        if constexpr (HALF_N) PG8_WAIT_V(4); else PG8_WAIT_V(6);
        PG8_BAR;
    } else {
        PG8_STAGEB(PG8_SB(0, 0), cB); PG8_STAGE(PG8_SA(0, 0), cA, voffA); PG8_STAGEB(PG8_SB(0, 1), cB + hstepB); PG8_STAGE(PG8_SA(0, 1), cA + hstepA, voffA);
        if (wr == 1) PG8_BAR;
        PG8_WAIT_V(4); PG8_BAR;
        PG8_STAGEB(PG8_SB(1, 0), cB + kstepB); PG8_STAGE(PG8_SA(1, 0), cA + kstepA, voffA); PG8_STAGEB(PG8_SB(1, 1), cB + hstepB + kstepB);
        PG8_WAIT_V(6); PG8_BAR;
    }
    for (;;) {
        if constexpr (Epi::INIT_LOADS) {
#pragma unroll
            for (int a = 0; a < 2; ++a)
#pragma unroll
                for (int b = 0; b < (HALF_N ? 1 : 2); ++b)
#pragma unroll
                    for (int m = 0; m < 4; ++m) asm volatile("" : "+v"(acc[a][b][m][0]), "+v"(acc[a][b][m][1]));
        }
        E.aux_load(aux, cur, wr, wc, fr, fq);
        const bool has_next = S.next(ui + 1, nxt);
        const char* nA = has_next ? (const char*)g.A + (size_t)nxt.pm * tstep : cA; const char* nB = has_next ? (const char*)g.Bt + (size_t)nxt.pn * tstep + (HALF_N ? (size_t)nxt.hb * hstepB : (size_t)0) : cB;
        for (int t = 0; t < nt; t += 2) {
            const bool last = (t == nt - 2);
            const char* a1 = cA + (size_t)(t + 1) * kstepA;
            const char* a2 = last ? nA : cA + (size_t)(t + 2) * kstepA; const char* b2 = last ? nB : cB + (size_t)(t + 2) * kstepB;
            const char* a3 = a2 + kstepA; const char* b3 = b2 + kstepB;
            if (last && has_next) S.a_ready(nxt);
            int rl = __builtin_amdgcn_readfirstlane((int)((t == 0) & (ui > 0))); asm volatile("" : "+s"(rl));
            if constexpr (SP2) {
            PG8_LDB(B0, 0, 0); PG8_LDB1(B1, 0); PG8_SCHED; PG8_LDA(At, 0, 0); PG8_STAGE(PG8_SA(1, 1), a1 + hstepA, voffA);
            PG8_WAIT_V1; PG8_WAIT_L(0); PG8_BAR; PG8_MMA(0, 0, At, B0); PG8_MMA1(0, At, B1); PG8_BAR; PG8_SCHED;
            PG8_LDA(At, 0, 1); PG8_STAGEB(PG8_SB(0, 0), b2); PG8_STAGE_B1(PG8_SB(0, 1), b2 + hstepB); PG8_STAGE(PG8_SA(0, 0), a2, voffA);
            PG8_WAIT_V1; PG8_WAIT_L(0); PG8_BAR; PG8_MMA(1, 0, At, B0); PG8_MMA1(1, At, B1); PG8_BAR; PG8_SCHED;
            PG8_LDB(B0, 1, 0); PG8_LDB1(B1, 1); PG8_SCHED; PG8_LDA(At, 1, 0); PG8_STAGE(PG8_SA(0, 1), a2 + hstepA, voffA);
            PG8_WAIT_VK; PG8_WAIT_L(0); PG8_BAR; PG8_MMA(0, 0, At, B0); PG8_MMA1(0, At, B1); PG8_BAR; PG8_SCHED;
            PG8_LDA(At, 1, 1); PG8_STAGEB(PG8_SB(1, 0), b3); PG8_STAGE_B1(PG8_SB(1, 1), b3 + hstepB); PG8_STAGE(PG8_SA(1, 0), a3, voffA);
            PG8_WAIT_VK; PG8_WAIT_L(0); PG8_BAR; PG8_MMA(1, 0, At, B0); PG8_MMA1(1, At, B1); PG8_BAR; PG8_SCHED;
            } else {
            PG8_LDB(B0, 0, 0); PG8_SCHED; PG8_LDA(At, 0, 0); PG8_STAGE(PG8_SA(1, 1), a1 + hstepA, voffA);
            PG8_WAIT_L(8); PG8_BAR; PG8_WAIT_L(0); PG8_MMA(0, 0, At, B0); PG8_BAR; PG8_SCHED;
            PG8_LDB(B1, 0, 1); PG8_STAGEB(PG8_SB(0, 0), b2);
            PG8_BAR; PG8_WAIT_L(0); PG8_MMA(0, 1, At, B1); PG8_BAR;
            PG8_LDA(At, 0, 1); PG8_STAGE(PG8_SA(0, 0), a2, voffA);
            PG8_BAR; PG8_WAIT_L(0); PG8_MMA(1, 0, At, B0); PG8_BAR; PG8_SCHED;
            PG8_STAGEB(PG8_SB(0, 1), b2 + hstepB);
            PG8_WAIT_V(6); PG8_BAR; PG8_MMA(1, 1, At, B1); PG8_BAR;
            PG8_LDB(B0, 1, 0); PG8_SCHED; PG8_LDA(At, 1, 0); PG8_STAGE(PG8_SA(0, 1), a2 + hstepA, voffA);
            PG8_WAIT_L(8); PG8_BAR; PG8_WAIT_L(0); PG8_MMA(0, 0, At, B0); PG8_BAR; PG8_SCHED;
            PG8_LDB(B1, 1, 1); PG8_STAGEB(PG8_SB(1, 0), b3);
            PG8_BAR; PG8_WAIT_L(0); PG8_MMA(0, 1, At, B1); PG8_BAR;
            PG8_LDA(At, 1, 1); PG8_STAGE(PG8_SA(1, 0), a3, voffA);
            PG8_BAR; PG8_WAIT_L(0); PG8_MMA(1, 0, At, B0); PG8_BAR; PG8_SCHED;
            PG8_STAGEB(PG8_SB(1, 1), b3 + hstepB);
            PG8_WAIT_V(6); PG8_BAR; PG8_MMA(1, 1, At, B1); PG8_BAR;
            }
        }
        if constexpr (ALIGN_EPI) { if (wr == 0) PG8_BAR; }
        if constexpr (!Epi::AFTER_DRAIN) { E(acc, aux, cur, wr, wc, fr, fq); S.done(cur); }
        if (!has_next) break;
        E.init(acc, nxt, wr, wc, fr, fq);
        cur = nxt; cA = nA; cB = nB; ++ui;
        if constexpr (ALIGN_EPI) { if (wr == 1) PG8_BAR; }
    }
    PG8_WAIT_V(0);
    if constexpr (!ALIGN_EPI) { if (wr == 0) PG8_BAR; }
    PG8_BAR;
    if constexpr (Epi::AFTER_DRAIN) { E.fused(acc, cur, wr, wc, fr, fq, lds, wid, lane); S.done(cur); }
}
template <class Epi, class Sched>
__device__ __forceinline__ void gemm_phase_q(PG8_LAS unsigned char* lds, const Gemm g, const Sched& S, const Epi& E) {
    const int tid = threadIdx.x, wid = __builtin_amdgcn_readfirstlane(tid >> 6), lane = tid & 63, wr = wid >> 2, wc = wid & 3, fr = lane & 15, fq = lane >> 4;
    const int K = g.K, nt = K / BK;
    unsigned voffA[2], voffB[2];
#pragma unroll
    for (int i = 0; i < 2; ++i) { int R, C; stage_rc(tid * 16 + i * 8192, R, C); const int Rb = Epi::PERM ? ((R & ~31) + perm32(R & 31)) : R;
        voffA[i] = (unsigned)(R * K + C) * 2u; voffB[i] = (unsigned)(Rb * K + C) * 2u; }
    const size_t kstep = (size_t)(BK * 2), hstep = (size_t)HALF * K * 2, tstep = 2 * hstep;
    const unsigned ldsw = (unsigned)wid * 1024u;
    const int aoff = lds_byte(wr * 64 + fr, fq * 8), boff = lds_byte(wc * 32 + fr, fq * 8);
    Unit cur;
    if (!S.next(0, cur)) return;
    f32x4 acc[2][2][4][2];
    typename Epi::Aux aux;
    E.init(acc, cur, wr, wc, fr, fq);
    bf16x8 At[4][2], B0[2][2];
    const char* cA = (const char*)g.A + (size_t)cur.pm * tstep + (size_t)cur.hm * hstep; const char* cB = (const char*)g.Bt + (size_t)cur.pn * tstep + (size_t)cur.hb * hstep;
    S.a_ready(cur);
    PG8_STAGEB(PG8_SB(0, 0), cB); PG8_STAGE(PG8_SA(0, 0), cA, voffA);
    PG8_STAGEB(PG8_SB(0, 1), cB + kstep); PG8_STAGE(PG8_SA(0, 1), cA + kstep, voffA);
    PG8_STAGEB(PG8_SB(1, 0), cB + 2 * kstep); PG8_STAGE(PG8_SA(1, 0), cA + 2 * kstep, voffA);
    if (wr == 1) PG8_BAR;
    PG8_WAIT_V(8); PG8_BAR;
    PG8_BAR;
    if constexpr (Epi::INIT_LOADS) {
#pragma unroll
        for (int m = 0; m < 4; ++m) asm volatile("" : "+v"(acc[0][0][m][0]), "+v"(acc[0][0][m][1]));
    }
    E.aux_load(aux, cur, wr, wc, fr, fq);
#define PG8_SPQ(s, kt) do { const int _k = (kt) < nt ? (kt) : (kt) - nt; \
        PG8_LDB(B0, (s) >> 1, (s) & 1); PG8_SCHED; PG8_LDA(At, (s) >> 1, (s) & 1); \
        PG8_STAGE(PG8_SB((((s) + 3) & 3) >> 1, ((s) + 3) & 1), cB + (size_t)_k * kstep, voffB); PG8_STAGE(PG8_SA((((s) + 3) & 3) >> 1, ((s) + 3) & 1), cA + (size_t)_k * kstep, voffA); \
        PG8_WAIT_V(8); PG8_WAIT_L(0); PG8_BAR; PG8_MMA(0, 0, At, B0); PG8_BAR; PG8_SCHED; } while (0)
    for (int t = 0; t < nt; t += 4) { PG8_SPQ(0, t + 3); PG8_SPQ(1, t + 4); PG8_SPQ(2, t + 5); PG8_SPQ(3, t + 6); }
#undef PG8_SPQ
    if (wr == 0) PG8_BAR;
    E(acc, aux, cur, wr, wc, fr, fq); S.done(cur);
    PG8_WAIT_V(0);
    PG8_BAR;
#undef PG8_SA
#undef PG8_SB
#undef PG8_STAGE
#undef PG8_STAGEB
#undef PG8_LDA
#undef PG8_LDB
#undef PG8_MMA
#undef PG8_WAIT_V
#undef PG8_WAIT_V1
#undef PG8_WAIT_VK
#undef PG8_STAGE_B1
#undef PG8_LDB1
#undef PG8_MMA1
#undef PG8_WAIT_L
#undef PG8_BAR
#undef PG8_SCHED
}
}
#ifndef PG8_SP2
#define PG8_SP2 true
#endif
#ifndef PG8_ALIGN
#define PG8_ALIGN true
#endif
namespace mixp {
using pg8::bf16_t; using pg8::bf16x8; using pg8::u32x4; using pg8::u32x2; using pg8::ZP; using pg8::MP; using pg8::MT; using pg8::LOG2E;
typedef float f32x16 __attribute__((ext_vector_type(16)));
typedef short v4i16_t __attribute__((ext_vector_type(4)));
#define MX_LAS __attribute__((address_space(3)))
typedef MX_LAS unsigned char* lptr;
constexpr int KR_OFF = 0, VR_OFF = 49152, OST_OFF = 98304;
constexpr int N_ATT_P = 32 * 3 * 32, N_ATT = N_ATT_P + 32 * 3, N_POOL_P = 32 * 32, N_UNITS = N_ATT + N_POOL_P + 32;
typedef float f32x2_t __attribute__((ext_vector_type(2))); typedef __bf16 bf16x2_t __attribute__((ext_vector_type(2)));
__device__ __forceinline__ unsigned pk_bf16(float lo, float hi) { f32x2_t v = {lo, hi}; bf16x2_t b = __builtin_convertvector(v, bf16x2_t); return __builtin_bit_cast(unsigned, b); }
__device__ __forceinline__ float bf_lo(unsigned w) { return __uint_as_float(w << 16); }
__device__ __forceinline__ float bf_hi(unsigned w) { return __uint_as_float(w & 0xffff0000u); }
__device__ __forceinline__ v4i16_t vtr(lptr p) { return __builtin_amdgcn_ds_read_tr16_b64_v4i16((MX_LAS v4i16_t*)p); }

struct AUnit { bool samp; int b, c, kvh, row0; };
__device__ __forceinline__ AUnit pool_decode(int j) { AUnit u; u.samp = j >= N_POOL_P; u.b = u.samp ? j - N_POOL_P : j >> 5; u.c = u.samp ? 0 : (j & 31); u.kvh = 0; u.row0 = u.samp ? MP + u.b * 64 : u.b * 2048 + 64 * u.c; return u; }
__device__ __forceinline__ void glds16(const void* gsrc, unsigned lds_dst) { unsigned keep;
    asm volatile("s_mov_b32 %0, m0\n\ts_mov_b32 m0, %2\n\ts_nop 0\n\tglobal_load_lds_dwordx4 %1, off\n\ts_mov_b32 m0, %0" : "=&s"(keep) : "v"(gsrc), "s"(lds_dst) : "memory"); }
#define MX_GLDS(src, dst) glds16((src), (unsigned)__builtin_amdgcn_readfirstlane((int)(unsigned)(uintptr_t)(dst)))

__device__ __forceinline__ void attn_issue_chunk(lptr ring, int slot, int j, const bf16_t* Z, const bf16_t* CK, const bf16_t* CV, const AUnit& u, int wid, int lane) {
    const int kkey = 8 * wid + (lane >> 3), kch = (lane & 7) ^ ((lane >> 3) & 7);
    const int vdh = wid >> 2, vkey = 16 * (wid & 3) + (lane >> 2), vch = 4 * vdh + (lane & 3);
    const bf16_t *ks, *vs;
    if (u.samp && j < 2) { const size_t o = (size_t)(u.b * 128 + 64 * j) * 192 + 64 * u.kvh; ks = CK + o + (size_t)kkey * 192 + 8 * kch; vs = CV + o + (size_t)vkey * 192 + 8 * vch; }
    else { const bool valid = u.samp || (u.c - 2 + j >= 0); const int rb = valid ? u.row0 - 128 + 64 * j : u.row0;
        ks = Z + (size_t)(16 + u.kvh) * MT * 64 + pg8::zsub_off(rb + kkey, 8 * kch); vs = Z + (size_t)(19 + u.kvh) * MT * 64 + pg8::zsub_off(rb + vkey, 8 * vch); }
    MX_GLDS(ks, ring + KR_OFF + slot * 8192 + wid * 1024);
    MX_GLDS(vs, ring + VR_OFF + slot * 8192 + wid * 1024);
}
__device__ __forceinline__ void attn_qload(bf16x8 (&q)[4], const bf16_t* Z, const AUnit& u, int wid, int lane) {
    const bf16_t* qp = Z + (size_t)(4 + 4 * u.kvh + (wid >> 1)) * MT * 64 + pg8::zsub_off(u.row0 + 32 * (wid & 1) + (lane & 31), 8 * (lane >> 5));
#pragma unroll
    for (int ks = 0; ks < 4; ++ks) q[ks] = __builtin_nontemporal_load((const bf16x8*)(qp + 512 * (ks >> 1) + 16 * (ks & 1)));
}
__device__ __forceinline__ void attn_compute(lptr ring, int sl0, int sl1, int sl2, const bf16x8 (&qr)[4], bf16_t* MIX, float sink2, const AUnit& u, int wid, int lane) {
    const int slb[3] = {sl0 * 8192, sl1 * 8192, sl2 * 8192};
    const int r32 = lane & 31, hi = lane >> 5, g = wid >> 1, qh = wid & 1, hq = 4 * u.kvh + g;
    const float slope2 = __builtin_amdgcn_exp2f(-8.0f * (float)(hq + 1) * (1.0f / 12.0f)) * LOG2E;
    const float qb = (float)(32 * qh + r32 + 128 - 4 * hi);
    const float nsq = -slope2 * qb;
    f32x16 p[6];
#pragma unroll
    for (int kb = 0; kb < 6; ++kb) {
        const bool valid = u.samp || (u.c - 2 + (kb >> 1) >= 0);
#pragma unroll
        for (int r = 0; r < 16; ++r) { const float cst = (float)(32 * kb + (r & 3) + 8 * (r >> 2));
            const float bias = kb < 4 ? __builtin_fmaf(slope2, cst, nsq) : -slope2 * __builtin_fabsf(qb - cst);
            p[kb][r] = valid ? bias : -1e30f; }
#pragma unroll
        for (int ks = 0; ks < 4; ++ks) {
            const bf16x8 kf = *(const MX_LAS bf16x8*)(ring + KR_OFF + slb[kb >> 1] + (32 * (kb & 1) + r32) * 128 + (((2 * ks + hi) ^ (r32 & 7)) << 4));
            p[kb] = __builtin_amdgcn_mfma_f32_32x32x16_bf16(kf, qr[ks], p[kb], 0, 0, 0);
        }
    }
    float sum = 0.f;
#pragma unroll
    for (int kb = 0; kb < 6; ++kb)
#pragma unroll
        for (int r = 0; r < 16; ++r) { p[kb][r] = __builtin_amdgcn_exp2f(p[kb][r]); sum += p[kb][r]; }
    sum += __shfl_xor(sum, 32);
    sum += __builtin_amdgcn_exp2f(sink2);
    const float inv = 1.0f / sum;
    f32x16 o[2];
#pragma unroll
    for (int r = 0; r < 16; ++r) { o[0][r] = 0.f; o[1][r] = 0.f; }
    const lptr vb = ring + VR_OFF + ((lane >> 4) & 1) * 32 + (lane & 3) * 8 + (4 * hi + ((lane & 15) >> 2)) * 64;
#pragma unroll
    for (int kb = 0; kb < 6; ++kb)
#pragma unroll
        for (int s = 0; s < 2; ++s) {
            u32x4 pw;
            pw.x = pk_bf16(p[kb][8 * s + 0], p[kb][8 * s + 1]); pw.y = pk_bf16(p[kb][8 * s + 2], p[kb][8 * s + 3]);
            pw.z = pk_bf16(p[kb][8 * s + 4], p[kb][8 * s + 5]); pw.w = pk_bf16(p[kb][8 * s + 6], p[kb][8 * s + 7]);
            const bf16x8 pf = __builtin_bit_cast(bf16x8, pw);
#pragma unroll
            for (int db = 0; db < 2; ++db) {
                const v4i16_t lo = vtr(vb + slb[kb >> 1] + db * 4096 + (32 * (kb & 1) + 16 * s) * 64), hh = vtr(vb + slb[kb >> 1] + db * 4096 + (32 * (kb & 1) + 16 * s + 8) * 64);
                const bf16x8 vf = (bf16x8){lo[0], lo[1], lo[2], lo[3], hh[0], hh[1], hh[2], hh[3]};
                o[db] = __builtin_amdgcn_mfma_f32_32x32x16_bf16(vf, pf, o[db], 0, 0, 0);
            }
        }
    const lptr st = ring + OST_OFF + wid * 4096;
#pragma unroll
    for (int db = 0; db < 2; ++db)
#pragma unroll
        for (int rg = 0; rg < 4; ++rg) { u32x2 w; w.x = pk_bf16(o[db][4 * rg] * inv, o[db][4 * rg + 1] * inv); w.y = pk_bf16(o[db][4 * rg + 2] * inv, o[db][4 * rg + 3] * inv);
            *(MX_LAS u32x2*)(st + r32 * 128 + (((4 * db + rg) ^ (r32 & 7)) << 4) + 8 * hi) = w; }
    asm volatile("s_waitcnt lgkmcnt(0)" ::: "memory");
    bf16_t* op = MIX + ((size_t)(u.row0 >> 8) * 16 + 4 + hq) * (256 * 64);
#pragma unroll
    for (int i = 0; i < 4; ++i) { const int row = 8 * i + (lane >> 3); const u32x4 v = *(const MX_LAS u32x4*)(st + row * 128 + (((lane & 7) ^ (row & 7)) << 4)); *(u32x4*)(op + pg8::img_off((u.row0 & 255) + 32 * qh + row, 8 * (lane & 7))) = v; }
}

__device__ __forceinline__ void pool_issue(lptr buf, const bf16_t* Z, const bf16_t* CP, const bf16_t* ZERO, const AUnit& u, int wid, int lane) {
#pragma unroll
    for (int j = 0; j < 5; ++j) {
        const int p = wid + 8 * j, ri = 2 * p + (lane >> 5), rc = ri > 78 ? 78 : ri, ch = (lane & 31) ^ (ri & 15);
        const bf16_t* src = Z + (size_t)(ch >> 3) * MT * 64 + pg8::zsub_off(u.row0 + rc - 15, 8 * (ch & 7));
        if (ri < 15) { if (u.samp) src = CP + (size_t)(u.b * 15 + ri) * 256 + 8 * ch; else if (u.c == 0) src = ZERO + 8 * (lane & 31); }
        MX_GLDS(src, buf + p * 1024);
    }
}
__device__ __forceinline__ void pool_compute(lptr buf, const bf16x8 (&wf)[2][4], bf16_t* MIX, const AUnit& u, int wid, int lane) {
    const int r32 = lane & 31, hi = lane >> 5;
    const int g = wid >> 1, hh = wid & 1, W = 2 << g, t = 32 * hh + r32;
    const int pos = u.samp ? 4096 + t : 64 * u.c + t;
    const float icnt = 1.0f / (float)((pos + 1 < W) ? pos + 1 : W);
    bf16x8 df[4];
#pragma unroll
    for (int ks = 0; ks < 4; ++ks) {
        const int chunk = 8 * g + 2 * ks + hi;
        float a[8]; u32x4 cur = (u32x4){0u, 0u, 0u, 0u};
#pragma unroll
        for (int e = 0; e < 8; ++e) a[e] = 0.f;
        for (int i = 0; i < W; ++i) {
            const int ri = t + 15 - i;
            const u32x4 v = *(const MX_LAS u32x4*)(buf + ri * 512 + ((chunk ^ (ri & 15)) << 4));
            a[0] += bf_lo(v.x); a[1] += bf_hi(v.x); a[2] += bf_lo(v.y); a[3] += bf_hi(v.y); a[4] += bf_lo(v.z); a[5] += bf_hi(v.z); a[6] += bf_lo(v.w); a[7] += bf_hi(v.w);
            if (i == 0) cur = v;
        }
        u32x4 dw;
        dw.x = pk_bf16(a[0] * icnt - bf_lo(cur.x), a[1] * icnt - bf_hi(cur.x)); dw.y = pk_bf16(a[2] * icnt - bf_lo(cur.y), a[3] * icnt - bf_hi(cur.y));
        dw.z = pk_bf16(a[4] * icnt - bf_lo(cur.z), a[5] * icnt - bf_hi(cur.z)); dw.w = pk_bf16(a[6] * icnt - bf_lo(cur.w), a[7] * icnt - bf_hi(cur.w));
        df[ks] = __builtin_bit_cast(bf16x8, dw);
    }
    bf16_t* op = MIX + ((size_t)(u.row0 >> 8) * 16 + g) * (256 * 64);
#pragma unroll
    for (int eb = 0; eb < 2; ++eb) {
        f32x16 o;
#pragma unroll
        for (int r = 0; r < 16; ++r) o[r] = 0.f;
#pragma unroll
        for (int ks = 0; ks < 4; ++ks) o = __builtin_amdgcn_mfma_f32_32x32x16_bf16(wf[eb][ks], df[ks], o, 0, 0, 0);
#pragma unroll
        for (int rg = 0; rg < 4; ++rg) { u32x2 w; w.x = pk_bf16(o[4 * rg], o[4 * rg + 1]); w.y = pk_bf16(o[4 * rg + 2], o[4 * rg + 3]); *(u32x2*)(op + pg8::img_off((u.row0 & 255) + t, 32 * eb + 8 * rg + 4 * hi)) = w; }
    }
}

#define MX_SYNC() do { asm volatile("s_waitcnt vmcnt(0) lgkmcnt(0)" ::: "memory"); __builtin_amdgcn_s_barrier(); asm volatile("" ::: "memory"); } while (0)
__device__ __forceinline__ void mix_phase(lptr lds, const bf16_t* Z, const bf16_t* CK, const bf16_t* CV, const bf16_t* CP, const bf16_t* WPt, const bf16_t* ZERO, bf16_t* MIX, const float* sinks, int first, int stride) {
    const int tid = threadIdx.x, lane = tid & 63, wid = __builtin_amdgcn_readfirstlane(tid >> 6);
    constexpr int PBUF = 40960;
    constexpr int NRUN_P = 32 * 3 * 8, NRUN = NRUN_P + 32 * 3;
    int par = 0;
    if (first < NRUN) {
        const int g = wid >> 1;
        float sk0 = sinks[g] * LOG2E, sk1 = sinks[4 + g] * LOG2E, sk2 = sinks[8 + g] * LOG2E;
        asm volatile("" : "+v"(sk0), "+v"(sk1), "+v"(sk2));
        int run = first, st = 0, head = 0;
        auto unit_of = [](int run, int st) { AUnit u; u.samp = run >= NRUN_P; const int rr = u.samp ? run : NRUN_P - 1 - run;     const int a = u.samp ? run - NRUN_P : rr >> 3; u.b = a / 3; u.kvh = a % 3; u.c = u.samp ? 0 : 4 * (rr & 7) + st;
                                              u.row0 = u.samp ? MP + u.b * 64 : u.b * 2048 + 64 * u.c; return u; };
        bf16x8 qn[4];
        AUnit u = unit_of(run, 0);
        int s0 = 0, s1 = 1, s2 = 2; head = 3;
        attn_issue_chunk(lds, 0, 0, Z, CK, CV, u, wid, lane); attn_issue_chunk(lds, 1, 1, Z, CK, CV, u, wid, lane); attn_issue_chunk(lds, 2, 2, Z, CK, CV, u, wid, lane);
        attn_qload(qn, Z, u, wid, lane);
        for (;;) {
            MX_SYNC();
            bf16x8 qr[4];
#pragma unroll
            for (int ks = 0; ks < 4; ++ks) qr[ks] = qn[ks];
            asm volatile("" : "+v"(qr[0]), "+v"(qr[1]), "+v"(qr[2]), "+v"(qr[3]));
            int nrun = run, nst = st + 1; const int len = (run >= NRUN_P) ? 1 : 4;
            if (nst == len) { nrun = run + stride; nst = 0; }
            const bool more = nrun < NRUN;
            int n0 = s1, n1 = s2, n2 = head;
            AUnit un = u;
            if (more) {
                un = unit_of(nrun, nst);
                if (nst == 0) { n0 = head; n1 = head + 1 >= 6 ? head - 5 : head + 1; n2 = head + 2 >= 6 ? head - 4 : head + 2;
                    attn_issue_chunk(lds, n0, 0, Z, CK, CV, un, wid, lane); attn_issue_chunk(lds, n1, 1, Z, CK, CV, un, wid, lane); attn_issue_chunk(lds, n2, 2, Z, CK, CV, un, wid, lane);
                    head = head + 3 >= 6 ? head - 3 : head + 3; }
                else { attn_issue_chunk(lds, n2, 2, Z, CK, CV, un, wid, lane); head = head + 1 >= 6 ? 0 : head + 1; }
                attn_qload(qn, Z, un, wid, lane);
            }
            attn_compute(lds, s0, s1, s2, qr, MIX, u.kvh == 0 ? sk0 : (u.kvh == 1 ? sk1 : sk2), u, wid, lane);
            if (!more) break;
            run = nrun; st = nst; u = un; s0 = n0; s1 = n1; s2 = n2;
        }
    }
    MX_SYNC();
    int pj = first >= 96 ? first - 96 : first + stride - 96; par = 0;
    if (pj < N_POOL_P + 32) {
        bf16x8 wf[2][4];
#pragma unroll
        for (int eb = 0; eb < 2; ++eb)
#pragma unroll
            for (int ks = 0; ks < 4; ++ks) wf[eb][ks] = *(const bf16x8*)(WPt + (size_t)(((wid >> 1) * 64 + 32 * eb + (lane & 31)) * 64 + 16 * ks + 8 * (lane >> 5)));
        pool_issue(lds, Z, CP, ZERO, pool_decode(pj), wid, lane);
        for (; pj < N_POOL_P + 32; pj += stride, par ^= 1) {
            const AUnit u = pool_decode(pj);
            MX_SYNC();
            if (pj + stride < N_POOL_P + 32) pool_issue(lds + (par ^ 1) * PBUF, Z, CP, ZERO, pool_decode(pj + stride), wid, lane);
            pool_compute(lds + par * PBUF, wf, MIX, u, wid, lane);
        }
    }
    MX_SYNC();
}
#undef MX_SYNC
#undef MX_GLDS
#undef MX_LAS
}
constexpr int NWAVES = 8;
#ifndef MK_N_LAUNCHES
#define MK_N_LAUNCHES 1
#endif
constexpr int N_LAUNCHES = MK_N_LAUNCHES;
constexpr int PER_PHASE = 6;
#ifndef MK_P5_LAG
#define MK_P5_LAG 900
#endif
constexpr int P5_LAG = MK_P5_LAG;

constexpr size_t MiB = 1u << 20;
constexpr size_t WS_CTL = 0, CTL_ZERO_BYTES = 64 * 1024, WS_ZERO = 512 * 1024, WS_SS = 1 * MiB;
constexpr size_t WS_WIN = 2 * MiB, WS_WOUT = 5 * MiB, WS_WGU = 7 * MiB, WS_WD = 18 * MiB;
constexpr size_t WS_WP = 24 * MiB, WS_CK = 25 * MiB, WS_CV = 27 * MiB, WS_CP = 29 * MiB;
constexpr size_t WS_RX = 30 * MiB;
constexpr size_t WS_XB = 32 * MiB;
constexpr size_t WS_Z = 164 * MiB;
constexpr size_t WS_MIX = 346 * MiB;
constexpr size_t WS_ACT = 478 * MiB;
constexpr size_t WS_HB = 842 * MiB;
constexpr size_t WS_END = 974 * MiB;
static_assert(WS_SS + (size_t)67584 * 4 <= WS_WIN && WS_WD + (size_t)1024 * 2816 * 2 <= WS_WP && WS_XB + (size_t)67584 * 1024 * 2 <= WS_Z && WS_Z + (size_t)67584 * 1408 * 2 <= WS_MIX &&
              WS_MIX + (size_t)67584 * 1024 * 2 <= WS_ACT && WS_ACT + (size_t)67584 * 2816 * 2 <= WS_HB && WS_HB + (size_t)67584 * 1024 * 2 <= WS_END && WS_RX + (size_t)67584 * 4 <= WS_XB, "d_ws map");
constexpr int CW_TMO = 0, CW_CODE = 1;
constexpr int CW_BAR = 4096;
constexpr int RING_OFF = 0, RING_BYTES = 131072;
constexpr int LDSCTL_OFF = RING_BYTES, MISC_OFF = LDSCTL_OFF + 320;
constexpr int STAGE_OFF = LDSCTL_OFF + 1024;
constexpr int JUNK_OFF = STAGE_OFF + 16384;
constexpr int LDS_BYTES = STAGE_OFF + 16384;
static_assert(MISC_OFF + 128 <= LDS_BYTES, "LDS map");

#define GAS __attribute__((address_space(1)))
#define LAS __attribute__((address_space(3)))
typedef unsigned short bf16;
typedef unsigned v4u __attribute__((ext_vector_type(4)));
typedef float f32x4 __attribute__((ext_vector_type(4)));
typedef short bf16x8 __attribute__((ext_vector_type(8)));
typedef GAS unsigned gu32;
typedef GAS unsigned long long gu64;
#define RLX_AGENT __ATOMIC_RELAXED, __HIP_MEMORY_SCOPE_AGENT
#define LDS_WAIT() asm volatile("s_waitcnt lgkmcnt(0)" ::: "memory")
#define VM_WAIT() asm volatile("s_waitcnt vmcnt(0)" ::: "memory")
__device__ __forceinline__ unsigned long long rt() { return __builtin_amdgcn_s_memrealtime(); }
__device__ __forceinline__ unsigned f2bf(float f) { unsigned u = __builtin_bit_cast(unsigned, f); return (u + 0x7fffu + ((u >> 16) & 1u)) >> 16; }
__device__ __forceinline__ unsigned pk2(float lo, float hi) { return f2bf(lo) | (f2bf(hi) << 16); }

#define XB_TMO      128
#define XB_XCNT(j)  (256  + 64 * (j))
#define XB_XSUB(j)  (1280 + 64 * (j))
#define XB_XGEN(j)  (2304 + 64 * (j))
#define XB_TOP      3328
#define XB_TOPGEN   3392
#define XCD_BAR_WORDS 3456
#define XB_SPIN_CAP (1u << 18)

__device__ __forceinline__ unsigned xb_ld(unsigned* p)              { return __hip_atomic_load(p, __ATOMIC_RELAXED, __HIP_MEMORY_SCOPE_AGENT); }
__device__ __forceinline__ unsigned xb_add(unsigned* p, unsigned v) { return __hip_atomic_fetch_add(p, v, __ATOMIC_RELAXED, __HIP_MEMORY_SCOPE_AGENT); }
__device__ __forceinline__ unsigned xb_xcc_id() { return (unsigned)__builtin_amdgcn_s_getreg((3 << 11) | 20) & 0xFu; }
#define XB_SPIN(cond, bar) do { unsigned _sp = 0; while (cond) { __builtin_amdgcn_s_sleep(1); \
    if ((++_sp & 255u) == 0u) { if (xb_ld(&(bar)[XB_TMO])) break; if (_sp > XB_SPIN_CAP) { atomicAdd(&(bar)[XB_TMO], 1u); break; } } } } while (0)

struct XcdBarrier {
    unsigned* bar; unsigned x;
    volatile LAS unsigned* st;
};

__device__ __forceinline__ XcdBarrier xcd_barrier_post(unsigned* bar, volatile LAS unsigned* st) {
    XcdBarrier b; b.bar = bar; b.x = xb_xcc_id(); b.st = st;
    if (threadIdx.x == 0) (void)xb_add(&bar[XB_XCNT(b.x)], 1u);
    return b;
}
__device__ __forceinline__ void xcd_barrier_complete(unsigned* bar, unsigned x, unsigned& nloc, unsigned& nx) {
    const unsigned G = gridDim.x * gridDim.y * gridDim.z;
    unsigned sum, cnt, mine, sp = 0u;
    for (;;) {
        sum = 0u; cnt = 0u; mine = 0u;
#pragma unroll
        for (unsigned j = 0; j < 16; ++j) { const unsigned c = xb_ld(&bar[XB_XCNT(j)]); sum += c; cnt += (c > 0u) ? 1u : 0u; mine = (j == x) ? c : mine; }
        if (sum == G) break;
        __builtin_amdgcn_s_sleep(1);
        if ((++sp & 255u) == 0u) { if (xb_ld(&bar[XB_TMO])) break; if (sp > XB_SPIN_CAP) { atomicAdd(&bar[XB_TMO], 1u); break; } }
    }
    nloc = mine > 0u ? mine : 1u; nx = cnt > 0u ? cnt : 1u;
}

__device__ __forceinline__ void xcd_barrier(const XcdBarrier& b) {
    asm volatile("s_waitcnt vmcnt(0)" ::: "memory");
    __syncthreads();
    if (threadIdx.x == 0) {
        unsigned* bar = b.bar;
        __builtin_amdgcn_s_waitcnt(0);
        unsigned nloc = b.st[0], nx = b.st[1];
        if (nloc == 0u) { xcd_barrier_complete(bar, b.x, nloc, nx); b.st[0] = nloc; b.st[1] = nx; }
        const unsigned old = xb_add(&bar[XB_XSUB(b.x)], 1u);
        const unsigned gen = old / nloc;
        if (old + 1u == (gen + 1u) * nloc) {
            __builtin_amdgcn_fence(__ATOMIC_RELEASE, "agent");
            asm volatile("s_waitcnt vmcnt(0)" ::: "memory");
            const unsigned og = xb_add(&bar[XB_TOP], 1u);
            const unsigned tg = og / nx;
            if (og + 1u == (tg + 1u) * nx) xb_add(&bar[XB_TOPGEN], 1u);
            else XB_SPIN(xb_ld(&bar[XB_TOPGEN]) == tg, bar);
            __builtin_amdgcn_fence(__ATOMIC_ACQUIRE, "agent");
            xb_add(&bar[XB_XGEN(b.x)], 1u);
            asm volatile("s_waitcnt vmcnt(0)" ::: "memory");
        } else {
            XB_SPIN(xb_ld(&bar[XB_XGEN(b.x)]) == gen, bar);
            __builtin_amdgcn_fence(__ATOMIC_ACQUIRE, "agent");
            asm volatile("s_waitcnt vmcnt(0)" ::: "memory");
        }
    }
    __syncthreads();
}
struct Frame {
    LAS unsigned char* lds;
    volatile LAS unsigned* MISC;
    gu32* ctl;
    int tid, lane, wave;
    int vcu, G;
};

__device__ __forceinline__ float wave_sum(float v) {
#pragma unroll
    for (int o = 1; o < 64; o <<= 1) v += __shfl_xor(v, o);
    return v;
}
__device__ __forceinline__ int p0_drow(int mode, int n0) {
    if (mode == 1) { const int lc = n0 & 255, dd = lc & 63; return n0 >= 1280 ? n0 : (n0 & ~255) + 128 * (dd >> 5) + 32 * (lc >> 6); }
    if (mode == 2) return 256 * (n0 >> 7) + (n0 & 127);
    if (mode == 3) return 256 * (n0 >> 7) + 128 + (n0 & 127);
    return n0;
}
__device__ __forceinline__ void p0_transpose_item(const float* W, const float* gain, int K, int N, bf16* WT, int kt, int b, int n0, int mode, LAS float* scr, int lane) {
    const int k0 = 64 * kt + 32 * b;
    const GAS f32x4* src = (const GAS f32x4*)(W + (size_t)(k0 + (lane >> 5)) * N + n0) + (lane & 31);
    f32x4 v[16];
#pragma unroll
    for (int i = 0; i < 16; ++i) v[i] = __builtin_nontemporal_load(src + (size_t)(2 * i) * (N >> 2));
    const int pb = lane * 16, ob = pb ^ (((pb >> 9) & 1) << 5), rr = ob >> 6, cc = (ob & 63) >> 1;
    f32x4 g0 = (f32x4){1.f, 1.f, 1.f, 1.f}, g1 = g0;
    if (gain) { g0 = *(const GAS f32x4*)(gain + k0 + cc); g1 = *(const GAS f32x4*)(gain + k0 + cc + 4); }
#pragma unroll
    for (int i = 0; i < 16; ++i) *(LAS f32x4*)(scr + (2 * i + (lane >> 5)) * 128 + 4 * (lane & 31)) = v[i];
    LDS_WAIT(); asm volatile("" ::: "memory");
#pragma unroll
    for (int g = 0; g < 4; ++g) {
        const int drow0 = p0_drow(mode, n0 + 32 * g);
        GAS unsigned char* base = (GAS unsigned char*)WT + ((size_t)((drow0 >> 8) * (K >> 6) + kt) * 2 + ((drow0 >> 7) & 1)) * pg8::HTB + (size_t)(((drow0 & 127) >> 4) * 2 + b) * 1024 + pb;
#pragma unroll
        for (int a = 0; a < 2; ++a) { const LAS float* t = scr + cc * 128 + 32 * g + pg8::perm32(16 * a + rr);
            v4u o; o.x = pk2(t[0 * 128] * g0.x, t[1 * 128] * g0.y); o.y = pk2(t[2 * 128] * g0.z, t[3 * 128] * g0.w); o.z = pk2(t[4 * 128] * g1.x, t[5 * 128] * g1.y); o.w = pk2(t[6 * 128] * g1.z, t[7 * 128] * g1.w);
            *(GAS v4u*)(base + a * 2048) = o; }
    }
    LDS_WAIT(); asm volatile("" ::: "memory");
}
__device__ __forceinline__ void x_rows2_to_bf16(const float* xa, const float* xb, bf16* oa, bf16* ob, float* ra, float* rb, int lane) {
    const GAS f32x4* pa = (const GAS f32x4*)xa + lane; const GAS f32x4* pb = (const GAS f32x4*)xb + lane;
    f32x4 va[4], vb[4]; float sa = 0.f, sb = 0.f;
#pragma unroll
    for (int j = 0; j < 4; ++j) { va[j] = __builtin_nontemporal_load(pa + 64 * j); vb[j] = __builtin_nontemporal_load(pb + 64 * j); }
#pragma unroll
    for (int j = 0; j < 4; ++j) { sa += (va[j].x * va[j].x + va[j].y * va[j].y) + (va[j].z * va[j].z + va[j].w * va[j].w); sb += (vb[j].x * vb[j].x + vb[j].y * vb[j].y) + (vb[j].z * vb[j].z + vb[j].w * vb[j].w); }
    GAS unsigned long long* qa = (GAS unsigned long long*)oa + lane; GAS unsigned long long* qb = (GAS unsigned long long*)ob + lane;
#pragma unroll
    for (int j = 0; j < 4; ++j) { qa[64 * j] = (unsigned long long)pk2(va[j].x, va[j].y) | ((unsigned long long)pk2(va[j].z, va[j].w) << 32);
                                  qb[64 * j] = (unsigned long long)pk2(vb[j].x, vb[j].y) | ((unsigned long long)pk2(vb[j].z, vb[j].w) << 32); }
    const float r1 = 1.f / sqrtf(wave_sum(sa) * (1.f / 1024.f) + 1e-6f), r2 = 1.f / sqrtf(wave_sum(sb) * (1.f / 1024.f) + 1e-6f);
    if (lane == 0) { *ra = r1; *rb = r2; }
}
struct P0Args { const float *xp, *xs, *cpool, *ck, *cv, *norm_mix, *w_in, *w_pool, *pool_scale, *w_out, *norm_ffn, *w_gate, *w_up, *w_down; float* out;
                bf16 *Win_t, *Wout_t, *Wgu_t, *Wd_t, *WPt, *CK, *CV, *CP, *XB; float* RX; float* SS; float* ZERO; };
__device__ __forceinline__ void p0_prologue(Frame& F, const P0Args& A) {
    LAS float* scr = (LAS float*)(F.lds + RING_OFF + F.wave * 16384);
    const int gw = F.vcu * NWAVES + F.wave, NGW = F.G * NWAVES;
    constexpr int I_IN = 32 * 11, I_OUT = 32 * 8, I_G = 32 * 22, I_D = 88 * 8, NITEMS = I_IN + I_OUT + 2 * I_G + I_D;
    for (int it = gw; it < NITEMS; it += NGW) {
        int r = it;
        if (r < I_IN) { const int kh = r / 11, nb = r % 11; p0_transpose_item(A.w_in, A.norm_mix, 1024, 1408, A.Win_t, kh >> 1, kh & 1, 128 * nb, 1, scr, F.lane); continue; } r -= I_IN;
        if (r < I_OUT) { const int kh = r / 8, nb = r % 8; p0_transpose_item(A.w_out, nullptr, 1024, 1024, A.Wout_t, kh >> 1, kh & 1, 128 * nb, 0, scr, F.lane); continue; } r -= I_OUT;
        if (r < I_G) { const int kh = r / 22, nb = r % 22; p0_transpose_item(A.w_gate, A.norm_ffn, 1024, 2816, A.Wgu_t, kh >> 1, kh & 1, 128 * nb, 2, scr, F.lane); continue; } r -= I_G;
        if (r < I_G) { const int kh = r / 22, nb = r % 22; p0_transpose_item(A.w_up, A.norm_ffn, 1024, 2816, A.Wgu_t, kh >> 1, kh & 1, 128 * nb, 3, scr, F.lane); continue; } r -= I_G;
        { const int kh = r / 8, nb = r % 8; p0_transpose_item(A.w_down, nullptr, 2816, 1024, A.Wd_t, kh >> 1, kh & 1, 128 * nb, 0, scr, F.lane); }
    }
    __syncthreads();
    {
        constexpr int RS = 2112, NG = pg8::MT / 16;
        LAS unsigned char* stg = F.lds + RING_OFF;
        f32x4 va[4], vb[4];
        int grp = F.vcu;
        auto issue = [&](int g) { const int r = 16 * g + 2 * F.wave; const float* xa = r < pg8::MP ? A.xp + (size_t)r * 1024 : A.xs + (size_t)(r - pg8::MP) * 1024;
            const GAS f32x4* pa = (const GAS f32x4*)xa + F.lane;
#pragma unroll
            for (int j = 0; j < 4; ++j) { va[j] = __builtin_nontemporal_load(pa + 64 * j); vb[j] = __builtin_nontemporal_load(pa + 256 + 64 * j); } };
        if (grp < NG) issue(grp);
        for (; grp < NG; grp += F.G) {
            const int r = 16 * grp + 2 * F.wave;
            float sa = 0.f, sb = 0.f;
#pragma unroll
            for (int j = 0; j < 4; ++j) { sa += (va[j].x * va[j].x + va[j].y * va[j].y) + (va[j].z * va[j].z + va[j].w * va[j].w); sb += (vb[j].x * vb[j].x + vb[j].y * vb[j].y) + (vb[j].z * vb[j].z + vb[j].w * vb[j].w); }
            LAS unsigned long long* la = (LAS unsigned long long*)(stg + (2 * F.wave) * RS) + F.lane; LAS unsigned long long* lb = (LAS unsigned long long*)(stg + (2 * F.wave + 1) * RS) + F.lane;
#pragma unroll
            for (int j = 0; j < 4; ++j) { la[64 * j] = (unsigned long long)pk2(va[j].x, va[j].y) | ((unsigned long long)pk2(va[j].z, va[j].w) << 32);
                                          lb[64 * j] = (unsigned long long)pk2(vb[j].x, vb[j].y) | ((unsigned long long)pk2(vb[j].z, vb[j].w) << 32); }
            if (grp + F.G < NG) issue(grp + F.G);
            const float r1 = 1.f / sqrtf(wave_sum(sa) * (1.f / 1024.f) + 1e-6f), r2 = 1.f / sqrtf(wave_sum(sb) * (1.f / 1024.f) + 1e-6f);
            if (F.lane == 0) { A.RX[r] = r1; A.RX[r + 1] = r2; }
            __syncthreads();
            GAS unsigned char* blk = (GAS unsigned char*)A.XB + ((size_t)(grp >> 4) * 16 * 2 + ((grp >> 3) & 1)) * pg8::HTB + (size_t)(grp & 7) * 2048;
            const int pb = F.lane * 16, ob = pb ^ (((pb >> 9) & 1) << 5), rr = ob >> 6, cc = (ob & 63) >> 1;
#pragma unroll
            for (int q = 0; q < 4; ++q) { const int st = F.wave + 8 * q, kt = st >> 1, ch = st & 1;
                const v4u val = *(const LAS v4u*)(stg + rr * RS + (kt * 64 + ch * 32 + cc) * 2);
                *(GAS v4u*)(blk + (size_t)kt * (2 * pg8::HTB) + ch * 1024 + pb) = val; }
            __syncthreads();
        }
    }
    const int gt = gw * 64 + F.lane, NGT = NGW * 64;
    for (int i = gt; i < 4 * 64 * 64; i += NGT) { const int g = i >> 12, e = (i >> 6) & 63, c = i & 63;
        A.WPt[i] = (bf16)f2bf(A.w_pool[(g * 64 + c) * 64 + e] * A.pool_scale[64 * g + e]); }
    for (int i = gt; i < 32 * 128 * 192 / 4; i += NGT) {
        const f32x4 k4 = ((const GAS f32x4*)A.ck)[i], v4 = ((const GAS f32x4*)A.cv)[i];
        ((GAS unsigned long long*)A.CK)[i] = (unsigned long long)pk2(k4.x, k4.y) | ((unsigned long long)pk2(k4.z, k4.w) << 32);
        ((GAS unsigned long long*)A.CV)[i] = (unsigned long long)pk2(v4.x, v4.y) | ((unsigned long long)pk2(v4.z, v4.w) << 32);
        const int b = i / (128 * 48), rr = (i / 48) & 127, q = i % 48;
        if (rr >= 64) { const size_t o = ((size_t)(b * 128 + rr - 64) * 192) / 4 + q; ((GAS f32x4*)(A.out + pg8::O_K_S))[o] = k4; ((GAS f32x4*)(A.out + pg8::O_V_S))[o] = v4; }
    }
    for (int i = gt; i < 67584 / 4; i += NGT) ((GAS f32x4*)A.SS)[i] = (f32x4){0.f, 0.f, 0.f, 0.f};
    if (gt < 64) ((GAS f32x4*)A.ZERO)[gt] = (f32x4){0.f, 0.f, 0.f, 0.f};
    for (int i = gt; i < 32 * 15 * 256 / 4; i += NGT) { const f32x4 p4 = ((const GAS f32x4*)A.cpool)[i]; ((GAS unsigned long long*)A.CP)[i] = (unsigned long long)pk2(p4.x, p4.y) | ((unsigned long long)pk2(p4.z, p4.w) << 32); }
}

struct Args { const float* in[17]; float* out; unsigned char* ws; int ph_lo, ph_hi, li, pad; };
__global__ void __launch_bounds__(NWAVES * 64, 2) mk_fwd(Args args) {
    extern __shared__ __attribute__((aligned(16))) unsigned char lds[];
    Frame F;
    F.lds = (LAS unsigned char*)lds;
    F.MISC = (volatile LAS unsigned*)(F.lds + MISC_OFF);
    F.tid = threadIdx.x; F.lane = F.tid & 63; F.wave = __builtin_amdgcn_readfirstlane(F.tid >> 6);
    F.G = gridDim.x; { const int bx = blockIdx.x; F.vcu = (F.G % 8 == 0) ? (bx % 8) * (F.G / 8) + bx / 8 : bx; }
#define GRID_BAR(seam) do { if (N_LAUNCHES == PER_PHASE) { if (F.tid == 0) __hip_atomic_store(F.ctl + CW_TMO, 0xBADBA0u | (unsigned)(seam), RLX_AGENT); } \
    else { xcd_barrier(bar); } } while (0)
    unsigned char* ws = args.ws;
    F.ctl = (gu32*)(ws + WS_CTL);
    float* const out = args.out;
    bf16* const Win_t = (bf16*)(ws + WS_WIN); bf16* const Wout_t = (bf16*)(ws + WS_WOUT); bf16* const Wgu_t = (bf16*)(ws + WS_WGU); bf16* const Wd_t = (bf16*)(ws + WS_WD);
    bf16* const WPt = (bf16*)(ws + WS_WP); bf16* const CKb = (bf16*)(ws + WS_CK); bf16* const CVb = (bf16*)(ws + WS_CV); bf16* const CPb = (bf16*)(ws + WS_CP);
    bf16* const XB = (bf16*)(ws + WS_XB); bf16* const HB = (bf16*)(ws + WS_HB); bf16* const Z = (bf16*)(ws + WS_Z); bf16* const MIX = (bf16*)(ws + WS_MIX); bf16* const ACT = (bf16*)(ws + WS_ACT);
    float* const SS = (float*)(ws + WS_SS); float* const RX = (float*)(ws + WS_RX);
    for (int u = F.tid; u < (LDS_BYTES - LDSCTL_OFF) / 4; u += NWAVES * 64) ((LAS unsigned*)(F.lds + LDSCTL_OFF))[u] = 0u;
    __syncthreads();
    const int bli = (N_LAUNCHES == PER_PHASE) ? 0 : args.li;
    XcdBarrier bar; bar.bar = (unsigned*)(F.ctl + CW_BAR) + bli * XCD_BAR_WORDS; bar.x = 0; bar.st = nullptr;
    if (N_LAUNCHES != PER_PHASE)
        bar = xcd_barrier_post((unsigned*)(F.ctl + CW_BAR) + bli * XCD_BAR_WORDS, F.MISC + 8);

    const int lo = args.ph_lo, hi = args.ph_hi;
#define IN(k) (lo <= (k) && (k) < hi)
#define BOTH(k) (IN(k) && IN((k) + 1))

    if (IN(0)) {
        P0Args A{args.in[0], args.in[1], args.in[2], args.in[3], args.in[4], args.in[5], args.in[6], args.in[7], args.in[8], args.in[12], args.in[13], args.in[14], args.in[15], args.in[16], out,
                 Win_t, Wout_t, Wgu_t, Wd_t, WPt, CKb, CVb, CPb, XB, RX, SS, (float*)(ws + WS_ZERO)};
        p0_prologue(F, A);
        if (BOTH(0)) GRID_BAR(0);
    }
    if (IN(1)) {
        pg8::Gemm g{XB, Win_t, pg8::MT, 1536, 1024};
        pg8::StaticOrder S; S.init(pg8::MT, 1280, F.G, (int)blockIdx.x);
        { pg8::BalancedFullOrder Sb; Sb.init(pg8::MT, 1280, F.G, (int)blockIdx.x); pg8::EpiZ E{Z, args.in[9], args.in[10], out, RX, F.lds + STAGE_OFF};
          pg8::gemm_phase<pg8::EpiZ, pg8::BalancedFullOrder, PG8_ALIGN, PG8_SP2>(F.lds + RING_OFF, g, Sb, E); }
        { pg8::BalancedHalfOrder T{5, 0, (int)blockIdx.x, F.G, S.nM, S.nwg % F.G}; pg8::EpiZv E{Z, out, RX, F.lds + STAGE_OFF};
          pg8::gemm_phase<pg8::EpiZv, pg8::BalancedHalfOrder, PG8_ALIGN, PG8_SP2, true>(F.lds + RING_OFF, g, T, E); }
        if (BOTH(1)) GRID_BAR(1);
    }
    if (IN(2)) {
        mixp::mix_phase(F.lds + RING_OFF, Z, CKb, CVb, CPb, WPt, (const bf16*)(ws + WS_ZERO), MIX, args.in[11], (int)blockIdx.x, F.G);
        if (BOTH(2)) GRID_BAR(2);
    }
    if (IN(3)) {
        pg8::Gemm g{MIX, Wout_t, pg8::MT, 1024, 1024}; pg8::StaticOrder S; S.init(pg8::MT, 1024, F.G, (int)blockIdx.x);
        const int full = (S.nwg / F.G) * F.G;
        { pg8::StaticOrder Sa = S; Sa.hi = full; pg8::EpiH<false> E{XB, HB, SS};
          pg8::gemm_phase<pg8::EpiH<false>, pg8::StaticOrder, PG8_ALIGN, PG8_SP2>(F.lds + RING_OFF, g, Sa, E); }
        { pg8::TailHalfOrder T{S, full, (int)blockIdx.x}; pg8::EpiH<true> E{XB, HB, SS};
          pg8::gemm_phase<pg8::EpiH<true>, pg8::TailHalfOrder, PG8_ALIGN, PG8_SP2, true>(F.lds + RING_OFF, g, T, E); }
        if (BOTH(3)) GRID_BAR(3);
    }
    if (IN(4)) {
        pg8::Gemm g{HB, Wgu_t, pg8::MT, 5632, 1024}; pg8::StaticOrder S; S.init(pg8::MT, 5632, F.G, (int)blockIdx.x);
        S.rev = 1;
        pg8::EpiAct E{SS, ACT, F.lds + STAGE_OFF};
        pg8::gemm_phase<pg8::EpiAct, pg8::StaticOrder, PG8_ALIGN, PG8_SP2>(F.lds + RING_OFF, g, S, E);
        if (BOTH(4)) GRID_BAR(4);
    }
    if (IN(5)) {
        pg8::Gemm g{ACT, Wd_t, pg8::MT, 1024, 2816}; pg8::StaticOrder S; S.init(pg8::MT, 1024, F.G, (int)blockIdx.x);
        const int full = (S.nwg / F.G) * F.G;
        { pg8::StaticOrder Sa = S; Sa.hi = full; pg8::EpiY<false> E{HB, out, F.lds + STAGE_OFF};
          pg8::gemm_phase<pg8::EpiY<false>, pg8::StaticOrder, PG8_ALIGN, PG8_SP2>(F.lds + RING_OFF, g, Sa, E); }
        { pg8::TailHalfOrder T{S, full, (int)blockIdx.x}; pg8::EpiY<true> E{HB, out, F.lds + STAGE_OFF};
          pg8::gemm_phase<pg8::EpiY<true>, pg8::TailHalfOrder, PG8_ALIGN, PG8_SP2, true>(F.lds + RING_OFF, g, T, E); }
    }
#undef IN
#undef BOTH
}

extern "C" void kernel_launch(void* const* d_in, const int* in_sizes, int n_in, void* d_out, int out_size, void* d_ws, size_t ws_size, hipStream_t stream) {
    static int grid = 0;
    if (grid == 0) {
        if (n_in != 17 || in_sizes[0] != 65536 * 1024 || out_size != (int)pg8::O_END || ws_size < WS_END) { fprintf(stderr, "kernel_launch: shape mismatch: n_in %d, in0 %d, out %d, ws %zu (need >= %zu); nothing launched\n", n_in, n_in > 0 ? in_sizes[0] : -1, out_size, ws_size, (size_t)WS_END); grid = -1; return; }
        int dev = 0, cus = 0, per_cu = 0;
        if (hipGetDevice(&dev) != hipSuccess || hipDeviceGetAttribute(&cus, hipDeviceAttributeMultiprocessorCount, dev) != hipSuccess) { fprintf(stderr, "kernel_launch: hipGetDevice / hipDeviceGetAttribute failed; nothing launched\n"); grid = -1; return; }
        if (hipFuncSetAttribute((const void*)mk_fwd, hipFuncAttributeMaxDynamicSharedMemorySize, LDS_BYTES) != hipSuccess) { fprintf(stderr, "kernel_launch: hipFuncSetAttribute failed; nothing launched\n"); grid = -1; return; }
        if (hipOccupancyMaxActiveBlocksPerMultiprocessor(&per_cu, (const void*)mk_fwd, NWAVES * 64, LDS_BYTES) != hipSuccess || per_cu < 1)
            fprintf(stderr, "kernel_launch: note: the occupancy query reports %d workgroups per CU\n", per_cu);
        (void)hipGetLastError();
        grid = cus;
    }
    if (grid < 0) return;
    if (hipMemsetAsync((char*)d_ws + WS_CTL, 0, CTL_ZERO_BYTES, stream) != hipSuccess) { fprintf(stderr, "kernel_launch: hipMemsetAsync of the control words failed; nothing launched\n"); return; }
    Args a{};
    for (int i = 0; i < 17; ++i) a.in[i] = (const float*)d_in[i];
    a.out = (float*)d_out; a.ws = (unsigned char*)d_ws;
    static_assert(((N_LAUNCHES >= 1 && N_LAUNCHES <= 3) || N_LAUNCHES == PER_PHASE) && (CW_BAR + 3 * XCD_BAR_WORDS) * 4 <= (int)CTL_ZERO_BYTES, "-DMK_N_LAUNCHES must be 1, 2, 3 or 6");
    const int cuts3[4] = {0, N_LAUNCHES == 3 ? 1 : (N_LAUNCHES == 2 ? 4 : PER_PHASE), N_LAUNCHES == 3 ? 4 : PER_PHASE, PER_PHASE};
    for (int li = 0; li < N_LAUNCHES; ++li) {
        a.ph_lo = (N_LAUNCHES == PER_PHASE) ? li : cuts3[li]; a.ph_hi = (N_LAUNCHES == PER_PHASE) ? li + 1 : cuts3[li + 1]; a.li = li;
        hipLaunchKernelGGL(mk_fwd, dim3(grid), dim3(NWAVES * 64), LDS_BYTES, stream, a);
        const hipError_t le = hipPeekAtLastError();
        if (le != hipSuccess) { fprintf(stderr, "kernel_launch: launch %d failed: %s (grid %d x %d threads, %d B LDS)\n", li, hipGetErrorName(le), grid, NWAVES * 64, LDS_BYTES); break; }
    }
}
```

```cpp
#include <hip/hip_runtime.h>
#include <cstdio>
#include <cstdint>
namespace pg8 {
#define PG8_LAS __attribute__((address_space(3)))
typedef unsigned short bf16_t;
typedef short bf16x8 __attribute__((ext_vector_type(8)));
typedef float f32x4 __attribute__((ext_vector_type(4)));
typedef unsigned u32x4 __attribute__((ext_vector_type(4)));
constexpr int BM = 256, BK = 64, HALF = 128, HTB = HALF * BK * 2  , STAGE_BYTES = 8 * HTB, NXCD = 8, WGM = 8;

__host__ __device__ __forceinline__ int lds_byte(int r, int c) { const int st = (r >> 4) * 2 + (c >> 5), rr = r & 15, cc = c & 31, ob = rr * 64 + cc * 2; return st * 1024 + (ob ^ (((ob >> 9) & 1) << 5)); }
__host__ __device__ __forceinline__ int img_off(int r, int c) { return ((r >> 7) * HTB + lds_byte(r & 127, c)) >> 1; }
__host__ __device__ __forceinline__ void stage_rc(int b, int& R, int& C) { const int st = b / 1024, sb = b % 1024, swz = sb ^ (((sb >> 9) & 1) << 5); R = (st >> 1) * 16 + swz / 64; C = (st & 1) * 32 + (swz % 64) / 2; }
__host__ __device__ __forceinline__ int inv_perm32(int x) { return 16 * ((x >> 2) & 1) + 4 * (x >> 3) + (x & 3); }
__host__ __device__ __forceinline__ int perm32(int rho) { const int n = rho >> 4, i = rho & 15; return 8 * (i >> 2) + 4 * n + (i & 3); }

struct Unit { int pm, pn, hb, hm; };
struct Gemm { const bf16_t* A; const bf16_t* Bt; int M, N, K; };

struct StaticOrder {
    int nM, nN, nwg, G, c, lo, hi, rev, wgm;
    __host__ __device__ void init(int M, int N, int G_, int c_) { nM = M / BM; nN = N / BM; nwg = nM * nN; G = G_; c = c_; lo = 0; hi = nwg; rev = 0; wgm = WGM; }
    __host__ __device__ bool next(int i, Unit& u) const {
        const long L = (long)lo + (long)i * G + c; if (L >= hi) return false;
        int wgid = (int)L; { const int q = nwg / NXCD, r = nwg % NXCD, xcd = wgid % NXCD, off = wgid / NXCD; wgid = (xcd < r ? xcd * (q + 1) : r * (q + 1) + (xcd - r) * q) + off; }
        const int nig = wgm * nN, gid = wgid / nig, fm = gid * wgm, gsz = (nM - fm) < wgm ? (nM - fm) : wgm;
        u.pm = fm + ((wgid % nig) % gsz); u.pn = (wgid % nig) / gsz; u.hb = 0; u.hm = 0; if (rev) u.pm = nM - 1 - u.pm; return true;
    }
    __host__ __device__ void tile_of(int L, Unit& u) const { StaticOrder t = *this; t.lo = L; t.hi = L + 1; t.c = 0; (void)t.next(0, u); }
    __device__ __forceinline__ void a_ready(const Unit&) const {}
    __device__ __forceinline__ void done(const Unit&) const {}
};
struct BalancedFullOrder : StaticOrder {
    __host__ __device__ bool next(int i, Unit& u) const {
        if (G != 256 || nwg != 1320) return StaticOrder::next(i, u);
        int L; if (i < 4) L = i * G + c; else if (i == 4 && c < 208) L = 4 * G + c; else if (i == 5 && c < 88) L = 4 * G + 208 + c; else return false;
        StaticOrder t = *this; t.lo = L; t.hi = L + 1; t.c = 0; return t.StaticOrder::next(0, u);
    }
};
struct BalancedHalfOrder {
    int pn, hb, c, G, nM, busy;
    __host__ __device__ bool next(int i, Unit& u) const { int j;
        if (G != 256 || nM != 264) { if (c < busy) return false; j = (c - busy) + (G - busy) * i; if (j >= nM) return false; u.pm = j; u.pn = pn; u.hb = hb; u.hm = 0; return true; }
        if (c < 88) return false; if (c < 208) { if (i > 0) return false; j = c - 88; } else { if (i > 2) return false; j = 120 + 3 * (c - 208) + i; }
        u.pm = j; u.pn = pn; u.hb = hb; u.hm = 0; return true; }
    __device__ __forceinline__ void a_ready(const Unit&) const {}
    __device__ __forceinline__ void done(const Unit&) const {}
};
struct TailHalfOrder {
    StaticOrder S; int lo, c;
    __host__ __device__ bool next(int i, Unit& u) const { if (i > 0) return false; const int L = lo + (c >> 1); if (L >= S.nwg) return false; S.tile_of(L, u); u.hb = c & 1; return true; }
    __device__ __forceinline__ void a_ready(const Unit&) const {}
    __device__ __forceinline__ void done(const Unit&) const {}
};
struct TailQuarterOrder {
    StaticOrder S; int lo, c;
    __host__ __device__ bool next(int i, Unit& u) const { if (i > 0) return false; const int L = lo + (c >> 2); if (L >= S.nwg) return false; S.tile_of(L, u); u.hb = c & 1; u.hm = (c >> 1) & 1; return true; }
    __device__ __forceinline__ void a_ready(const Unit&) const {}
    __device__ __forceinline__ void done(const Unit&) const {}
};
typedef float f32x2 __attribute__((ext_vector_type(2))); typedef __bf16 bf16x2_t __attribute__((ext_vector_type(2)));
__device__ __forceinline__ unsigned cvt_pk_bf16(float lo, float hi) { f32x2 v = {lo, hi}; bf16x2_t b = __builtin_convertvector(v, bf16x2_t); return __builtin_bit_cast(unsigned, b); }
typedef unsigned u32x2 __attribute__((ext_vector_type(2)));
constexpr float LOG2E = 1.4426950408889634f;
constexpr float C2 = 0.125f * LOG2E;
constexpr float EPS = 1e-6f;
constexpr int HALF_COLS = 128;
constexpr int DM = 1024, ZP = 1408, FF = 2816;
constexpr int MP = 65536, MS = 2048, MT = MP + MS;
constexpr size_t O_POOL_P = 69206016, O_K_P = 69328896, O_V_P = 70115328, O_POOL_S = 70901760, O_K_S = 71024640, O_V_S = 71811072, O_END = 72597504;

__host__ __device__ __forceinline__ size_t zsub_off(int row, int c) { return ((size_t)(row >> 4) * 2 + (c >> 5)) * 512 + (row & 15) * 32 + (c & 31); }
__device__ __forceinline__ void acc_zero(f32x4 (&acc)[2][2][4][2]) {
#pragma unroll
    for (int a = 0; a < 2; ++a)
#pragma unroll
        for (int b = 0; b < 2; ++b)
#pragma unroll
            for (int m = 0; m < 4; ++m)
#pragma unroll
                for (int n = 0; n < 2; ++n) acc[a][b][m][n] = (f32x4){0.f, 0.f, 0.f, 0.f};
}
__device__ __forceinline__ float bf_lo(unsigned w) { return __uint_as_float(w << 16); }
__device__ __forceinline__ float bf_hi(unsigned w) { return __uint_as_float(w & 0xffff0000u); }
template <bool HN = false, bool HM = false, bool BLK = false>
__device__ __forceinline__ void acc_from_bf16(f32x4 (&acc)[2][2][4][2], const bf16_t* R, const Unit& u, int wr, int wc, int fr, int fq) {
    const int r0 = (HM ? u.hm * HALF : 0) + wr * 64 + fr, c0 = u.pn * BM + (HN ? u.hb * HALF_COLS : 0) + wc * 32 + 8 * fq;
    const bf16_t* rp = BLK ? R + (size_t)u.pm * (1024 / BK) * (BM * BK) : R + ((size_t)u.pm * BM + r0) * 1024 + c0;
#pragma unroll
    for (int ai = 0; ai < (HM ? 1 : 2); ++ai)
#pragma unroll
        for (int m = 0; m < 4; ++m)
#pragma unroll
            for (int bj = 0; bj < (HN ? 1 : 2); ++bj) { const int c = c0 + bj * HALF;
                const u32x4 w = BLK ? *(const u32x4*)(rp + (size_t)(c >> 6) * (BM * BK) + img_off(r0 + ai * HALF + m * 16, c & 63)) : *(const u32x4*)(rp + (size_t)(ai * HALF + m * 16) * 1024 + bj * HALF);
                acc[ai][bj][m][0] = (f32x4){bf_lo(w.x), bf_hi(w.x), bf_lo(w.y), bf_hi(w.y)}; acc[ai][bj][m][1] = (f32x4){bf_lo(w.z), bf_hi(w.z), bf_lo(w.w), bf_hi(w.w)}; }
}

struct EpiZ {
    static constexpr bool PERM = true, AFTER_DRAIN = false, INIT_LOADS = false; static constexpr int RELAX = 0, B_AUX = 0, A_BLK = 1;
    bf16_t* Z; const float* qn; const float* kn; float* out; const float* RX; PG8_LAS unsigned char* stage;
    struct Aux {};
    __device__ __forceinline__ void init(f32x4 (&acc)[2][2][4][2], const Unit&, int, int, int, int) const { acc_zero(acc); }
    __device__ __forceinline__ void aux_load(Aux&, const Unit& u, int wr, int wc, int fr, int fq) const {
        __builtin_amdgcn_global_load_lds((const unsigned*)(RX + (size_t)u.pm * BM + 4 * (fr + 16 * fq)), (PG8_LAS unsigned*)(stage + (wr * 4 + wc) * 1024), 16, 0, 0);
    }
    __device__ __forceinline__ void operator()(const f32x4 (&acc)[2][2][4][2], const Aux&, const Unit& u, int wr, int wc, int fr, int fq) const {
        const int zcol = u.pn * 256 + wc * 64;
        if (zcol >= ZP) return;
        const int kind = (zcol >= 256 && zcol < 1024) ? 1 : ((zcol >= 1024 && zcol < 1216) ? 2 : 0);
        f32x4 sc[2][2];
#pragma unroll
        for (int bj = 0; bj < 2; ++bj)
#pragma unroll
            for (int n = 0; n < 2; ++n) {
                if (kind == 1) sc[bj][n] = *(const f32x4*)(qn + 32 * bj + 8 * fq + 4 * n) * C2;
                else if (kind == 2) sc[bj][n] = *(const f32x4*)(kn + 32 * bj + 8 * fq + 4 * n);
                else sc[bj][n] = (f32x4){1.f, 1.f, 1.f, 1.f};
            }
        const bool samp = u.pm >= 256;
        const int cm = (!samp && (u.pm & 7) != 7) ? 0 : (zcol < 256 ? 1 : (zcol >= 1216 ? 3 : (zcol >= 1024 ? 2 : 0)));
        const int rowbase = u.pm * BM + wr * 64 + fr;
        const PG8_LAS float* sl = (const PG8_LAS float*)(stage + (wr * 4 + wc) * 1024) + wr * 64 + fr;
#pragma unroll
        for (int ai = 0; ai < 2; ++ai)
#pragma unroll
            for (int m = 0; m < 4; ++m) {
                const int row = rowbase + ai * HALF + m * 16;
                const float rx = sl[ai * HALF + m * 16];
                float rs = rx;
                if (kind) {
                    float ss = 0.f;
#pragma unroll
                    for (int bj = 0; bj < 2; ++bj)
#pragma unroll
                        for (int n = 0; n < 2; ++n) { const f32x4 x = acc[ai][bj][m][n]; ss += (x[0] * x[0] + x[1] * x[1]) + (x[2] * x[2] + x[3] * x[3]); }
                    ss += __shfl_xor(ss, 16); ss += __shfl_xor(ss, 32);
                    rs = rx / sqrtf(ss * (rx * rx) * (1.0f / 64.0f) + EPS);
                }
                f32x4 v[2][2];
#pragma unroll
                for (int bj = 0; bj < 2; ++bj)
#pragma unroll
                    for (int n = 0; n < 2; ++n) v[bj][n] = acc[ai][bj][m][n] * rs * sc[bj][n];
                bf16_t* zp = Z + (size_t)(zcol >> 6) * MT * 64 + zsub_off(row, 8 * fq);
#pragma unroll
                for (int bj = 0; bj < 2; ++bj) { u32x4 w; w.x = cvt_pk_bf16(v[bj][0][0], v[bj][0][1]); w.y = cvt_pk_bf16(v[bj][0][2], v[bj][0][3]); w.z = cvt_pk_bf16(v[bj][1][0], v[bj][1][1]); w.w = cvt_pk_bf16(v[bj][1][2], v[bj][1][3]);
                    *(u32x4*)(zp + 512 * bj) = w; }
                if (cm) {
                    int b, t, T; if (samp) { const int r2 = row - MP; b = r2 >> 6; t = r2 & 63; T = 64; } else { b = row >> 11; t = row & 2047; T = 2048; }
                    float* dst = nullptr;
                    if (cm == 1) { const int i = t - (T - 15); if (i >= 0) dst = out + (samp ? O_POOL_S : O_POOL_P) + ((size_t)(b * 15 + i) * 256 + zcol); }
                    else { const int i = samp ? 64 + t : t - (T - 128); if (i >= 0) dst = out + (cm == 2 ? (samp ? O_K_S : O_K_P) : (samp ? O_V_S : O_V_P)) + ((size_t)(b * 128 + i) * 192 + (zcol - (cm == 2 ? 1024 : 1216))); }
                    if (dst) {
#pragma unroll
                        for (int bj = 0; bj < 2; ++bj)
#pragma unroll
                            for (int n = 0; n < 2; ++n) *(f32x4*)(dst + 32 * bj + 8 * fq + 4 * n) = v[bj][n];
                    }
                }
            }
    }
};

struct EpiZv {
    static constexpr bool PERM = true, AFTER_DRAIN = false, INIT_LOADS = false; static constexpr int RELAX = 0, B_AUX = 0, A_BLK = 1;
    bf16_t* Z; float* out; const float* RX; PG8_LAS unsigned char* stage;
    struct Aux {};
    __device__ __forceinline__ void init(f32x4 (&acc)[2][2][4][2], const Unit&, int, int, int, int) const { acc_zero(acc); }
    __device__ __forceinline__ void aux_load(Aux&, const Unit& u, int wr, int wc, int fr, int fq) const {
        __builtin_amdgcn_global_load_lds((const unsigned*)(RX + (size_t)u.pm * BM + 4 * (fr + 16 * fq)), (PG8_LAS unsigned*)(stage + (wr * 4 + wc) * 1024), 16, 0, 0);
    }
    __device__ __forceinline__ void operator()(const f32x4 (&acc)[2][2][4][2], const Aux&, const Unit& u, int wr, int wc, int fr, int fq) const {
        const int zcol = 1280 + 32 * wc + 8 * fq;
        const bool samp = u.pm >= 256, cache = samp || (u.pm & 7) == 7;
        const int rowbase = u.pm * BM + wr * 64 + fr;
        const PG8_LAS float* sl = (const PG8_LAS float*)(stage + (wr * 4 + wc) * 1024) + wr * 64 + fr;
#pragma unroll
        for (int ai = 0; ai < 2; ++ai)
#pragma unroll
            for (int m = 0; m < 4; ++m) {
                const int row = rowbase + ai * HALF + m * 16;
                const float rx = sl[ai * HALF + m * 16];
                const f32x4 v0 = acc[ai][0][m][0] * rx, v1 = acc[ai][0][m][1] * rx;
                u32x4 w; w.x = cvt_pk_bf16(v0[0], v0[1]); w.y = cvt_pk_bf16(v0[2], v0[3]); w.z = cvt_pk_bf16(v1[0], v1[1]); w.w = cvt_pk_bf16(v1[2], v1[3]);
                *(u32x4*)(Z + (size_t)(zcol >> 6) * MT * 64 + zsub_off(row, zcol & 63)) = w;
                if (cache) {
                    int b, i; if (samp) { const int r2 = row - MP; b = r2 >> 6; i = 64 + (r2 & 63); } else { b = row >> 11; i = (row & 2047) - 1920; }
                    if (i >= 0) { float* dst = out + (samp ? O_V_S : O_V_P) + ((size_t)(b * 128 + i) * 192 + (zcol - 1216)); *(f32x4*)dst = v0; *(f32x4*)(dst + 4) = v1; }
                }
            }
    }
};

template <bool HN = false, bool HM = false> struct EpiH {
    static constexpr bool PERM = true, AFTER_DRAIN = false, INIT_LOADS = true; static constexpr int RELAX = 0, B_AUX = 0, A_BLK = 1;
    const bf16_t* XB; bf16_t* HB; float* SS;
    struct Aux {};
    __device__ __forceinline__ void init(f32x4 (&acc)[2][2][4][2], const Unit& u, int wr, int wc, int fr, int fq) const { acc_from_bf16<HN, HM, true>(acc, XB, u, wr, wc, fr, fq); }
    __device__ __forceinline__ void aux_load(Aux&, const Unit&, int, int, int, int) const {}
    __device__ __forceinline__ void operator()(const f32x4 (&acc)[2][2][4][2], const Aux&, const Unit& u, int wr, int wc, int fr, int fq) const {
        const int col0 = u.pn * BM + (HN ? u.hb * HALF_COLS : 0) + wc * 32 + 8 * fq;
#pragma unroll
        for (int ai = 0; ai < (HM ? 1 : 2); ++ai) {
#pragma unroll
            for (int m = 0; m < 4; ++m) {
                const size_t grow = (size_t)u.pm * BM + (HM ? u.hm : ai) * HALF + wr * 64 + m * 16 + fr;
                float ss = 0.f;
#pragma unroll
                for (int bj = 0; bj < (HN ? 1 : 2); ++bj) { const f32x4 h0 = acc[ai][bj][m][0], h1 = acc[ai][bj][m][1];
                    ss += ((h0[0] * h0[0] + h0[1] * h0[1]) + (h0[2] * h0[2] + h0[3] * h0[3])) + ((h1[0] * h1[0] + h1[1] * h1[1]) + (h1[2] * h1[2] + h1[3] * h1[3]));
                    u32x4 w; w.x = cvt_pk_bf16(h0[0], h0[1]); w.y = cvt_pk_bf16(h0[2], h0[3]); w.z = cvt_pk_bf16(h1[0], h1[1]); w.w = cvt_pk_bf16(h1[2], h1[3]);
                    { const int c = col0 + bj * HALF; *(u32x4*)(HB + ((size_t)u.pm * (DM / BK) + (c >> 6)) * (BM * BK) + img_off((int)(grow & 255), c & 63)) = w; } }
                ss += __shfl_xor(ss, 16); ss += __shfl_xor(ss, 32);
                if (fq == 0) atomicAdd(SS + grow, ss);
            }
        }
    }
};

struct EpiAct {
    static constexpr bool PERM = true, AFTER_DRAIN = false, INIT_LOADS = false; static constexpr int RELAX = 0, B_AUX = 0, A_BLK = 1;
    const float* SS; bf16_t* ACT; PG8_LAS unsigned char* stage;
    struct Aux {};
    __device__ __forceinline__ void init(f32x4 (&acc)[2][2][4][2], const Unit&, int, int, int, int) const { acc_zero(acc); }
    __device__ __forceinline__ void aux_load(Aux&, const Unit& u, int wr, int wc, int fr, int fq) const {
        __builtin_amdgcn_global_load_lds((const unsigned*)(SS + (size_t)u.pm * BM + 4 * (fr + 16 * fq)), (PG8_LAS unsigned*)(stage + (wr * 4 + wc) * 1024), 16, 0, 0);
    }
    __device__ __forceinline__ void operator()(const f32x4 (&acc)[2][2][4][2], const Aux&, const Unit& u, int wr, int wc, int fr, int fq) const {
        const int col0 = u.pn * HALF + wc * 32 + 8 * fq;
        const PG8_LAS float* sl = (const PG8_LAS float*)(stage + (wr * 4 + wc) * 1024) + wr * 64 + fr;
#pragma unroll
        for (int ai = 0; ai < 2; ++ai)
#pragma unroll
            for (int m = 0; m < 4; ++m) {
                const size_t grow = (size_t)u.pm * BM + ai * HALF + wr * 64 + m * 16 + fr;
                const float r2 = __builtin_amdgcn_rcpf(sl[ai * HALF + m * 16] * (1.0f / DM) + EPS), rs = __builtin_amdgcn_sqrtf(r2), c1 = -LOG2E * rs;
                float o[8];
#pragma unroll
                for (int n = 0; n < 2; ++n)
#pragma unroll
                    for (int e = 0; e < 4; ++e) { const float g = acc[ai][0][m][n][e], uu = acc[ai][1][m][n][e];
                        o[4 * n + e] = (g * uu) * (r2 * __builtin_amdgcn_rcpf(1.0f + __builtin_amdgcn_exp2f(c1 * g))); }
                u32x4 w; w.x = cvt_pk_bf16(o[0], o[1]); w.y = cvt_pk_bf16(o[2], o[3]); w.z = cvt_pk_bf16(o[4], o[5]); w.w = cvt_pk_bf16(o[6], o[7]);
                *(u32x4*)(ACT + ((size_t)u.pm * (FF / BK) + (col0 >> 6)) * (BM * BK) + img_off((int)(grow & 255), col0 & 63)) = w;
            }
    }
};

template <bool HN = false, bool HM = false> struct EpiY {
    static constexpr bool PERM = true, AFTER_DRAIN = false, INIT_LOADS = true; static constexpr int RELAX = 0, B_AUX = 0, A_BLK = 1;
    const bf16_t* HB; float* Y; PG8_LAS unsigned char* stage;
    struct Aux {};
    __device__ __forceinline__ void init(f32x4 (&acc)[2][2][4][2], const Unit& u, int wr, int wc, int fr, int fq) const { acc_from_bf16<HN, HM, true>(acc, HB, u, wr, wc, fr, fq); }
    __device__ __forceinline__ void aux_load(Aux&, const Unit&, int, int, int, int) const {}
    __device__ __forceinline__ void operator()(const f32x4 (&acc)[2][2][4][2], const Aux&, const Unit& u, int wr, int wc, int fr, int fq) const {
        const int lane = fr + 16 * fq; PG8_LAS unsigned char* st = stage + (wr * 4 + wc) * 2048;
#pragma unroll
        for (int ai = 0; ai < (HM ? 1 : 2); ++ai) {
#pragma unroll
            for (int m = 0; m < 4; ++m) {
                float* tp = Y + ((size_t)u.pm * BM + (HM ? u.hm : ai) * HALF + wr * 64 + m * 16 + (lane >> 3)) * DM + u.pn * BM + (HN ? u.hb * HALF_COLS : 0) + wc * 32 + 4 * (lane & 7);
#pragma unroll
                for (int bj = 0; bj < (HN ? 1 : 2); ++bj) {
                    *(PG8_LAS f32x4*)(st + fr * 128 + (((2 * fq) ^ (fr & 7)) << 4)) = acc[ai][bj][m][0]; *(PG8_LAS f32x4*)(st + fr * 128 + (((2 * fq + 1) ^ (fr & 7)) << 4)) = acc[ai][bj][m][1];
                    asm volatile("s_waitcnt lgkmcnt(0)" ::: "memory");
#pragma unroll
                    for (int ps = 0; ps < 2; ++ps) { const int r = 8 * ps + (lane >> 3); const f32x4 v = *(const PG8_LAS f32x4*)(st + r * 128 + (((lane & 7) ^ (r & 7)) << 4)); *(f32x4*)(tp + (size_t)(8 * ps) * DM + bj * HALF) = v; }
                    asm volatile("s_waitcnt lgkmcnt(0)" ::: "memory");
                }
            }
        }
    }
};

template <class Epi, class Sched, bool ALIGN_EPI = false, bool SP2 = false, bool HALF_N = false>
__device__ __forceinline__ void gemm_phase(PG8_LAS unsigned char* lds, const Gemm g, const Sched& S, const Epi& E) {
    const int tid = threadIdx.x, wid = __builtin_amdgcn_readfirstlane(tid >> 6), lane = tid & 63, wr = wid >> 2, wc = wid & 3, fr = lane & 15, fq = lane >> 4;
    static_assert(SP2 || !HALF_N, "HALF_N needs the SP2 loop");
    const int K = g.K, nt = K / BK;
    unsigned voffA[2], voffB[2];
#pragma unroll
    for (int i = 0; i < 2; ++i) { int R, C; stage_rc(tid * 16 + i * 8192, R, C); const int Rb = Epi::PERM ? ((R & ~31) + perm32(R & 31)) : R;
        voffA[i] = Epi::A_BLK ? (unsigned)(tid * 16 + i * 8192) : (unsigned)(R * K + C) * 2u; voffB[i] = (unsigned)(tid * 16 + i * 8192); (void)Rb; }
    const size_t kstep = (size_t)(BK * 2);
    const size_t hstep = (size_t)HALF * K * 2;
    const size_t tstep = 2 * hstep;
    const size_t kstepA = Epi::A_BLK ? (size_t)BM * BK * 2 : kstep, hstepA = Epi::A_BLK ? (size_t)HALF * BK * 2 : hstep;
    const size_t kstepB = (size_t)BM * BK * 2, hstepB = (size_t)HALF * BK * 2;
    const unsigned ldsw = (unsigned)wid * 1024u;
    const int aoff = lds_byte(wr * 64 + fr, fq * 8), boff = lds_byte(wc * 32 + fr, fq * 8);
#define PG8_SA(b, h) (((b) * 2 + (h)) * HTB)
#define PG8_SB(b, h) ((4 + (b) * 2 + (h)) * HTB)
#define PG8_STAGE(bufoff, gbase, voff) do { _Pragma("unroll") for (int _i = 0; _i < 2; ++_i) \
        __builtin_amdgcn_global_load_lds((const unsigned*)((const char*)(gbase) + (voff)[_i]), (PG8_LAS unsigned*)(lds + (bufoff) + ldsw + _i * 8192), 16, 0, 0); } while (0)
#define PG8_STAGEB(bufoff, gbase) do { _Pragma("unroll") for (int _i = 0; _i < 2; ++_i) \
        __builtin_amdgcn_global_load_lds((const unsigned*)((const char*)(gbase) + voffB[_i]), (PG8_LAS unsigned*)(lds + (bufoff) + ldsw + _i * 8192), 16, 0, Epi::B_AUX); } while (0)
#define PG8_LDA(dst, b, h) do { _Pragma("unroll") for (int m = 0; m < 4; ++m) _Pragma("unroll") for (int k = 0; k < 2; ++k) dst[m][k] = *(const PG8_LAS bf16x8*)(lds + PG8_SA(b, h) + aoff + m * 2048 + k * 1024); } while (0)
#define PG8_LDB(dst, b, h) do { _Pragma("unroll") for (int n = 0; n < 2; ++n) _Pragma("unroll") for (int k = 0; k < 2; ++k) dst[n][k] = *(const PG8_LAS bf16x8*)(lds + PG8_SB(b, h) + boff + n * 2048 + k * 1024); } while (0)
#define PG8_MMA(ai, bj, At, Bt) do { __builtin_amdgcn_s_setprio(1); _Pragma("unroll") for (int m = 0; m < 4; ++m) _Pragma("unroll") for (int n = 0; n < 2; ++n) _Pragma("unroll") for (int k = 0; k < 2; ++k) \
        acc[ai][bj][m][n] = __builtin_amdgcn_mfma_f32_16x16x32_bf16(Bt[n][k], At[m][k], acc[ai][bj][m][n], 0, 0, 0); __builtin_amdgcn_s_setprio(0); } while (0)
#define PG8_WAIT_V(n) asm volatile("s_waitcnt vmcnt(" #n ")" ::: "memory")
#define PG8_WAIT_VK do { if constexpr (HALF_N) asm volatile("s_waitcnt vmcnt(6)" ::: "memory"); else asm volatile("s_waitcnt vmcnt(8)" ::: "memory"); } while (0)
#define PG8_STAGE_B1(bufoff, gbase) do { if constexpr (!HALF_N) PG8_STAGEB(bufoff, gbase); } while (0)
#define PG8_LDB1(dst, b) do { if constexpr (!HALF_N) PG8_LDB(dst, b, 1); } while (0)
#define PG8_MMA1(ai, At, Bt) do { if constexpr (!HALF_N) PG8_MMA(ai, 1, At, Bt); } while (0)
#define PG8_WAIT_V1 do { if (!HALF_N && Epi::RELAX == 9 && rl) asm volatile("s_waitcnt vmcnt(17)" ::: "memory"); else PG8_WAIT_VK; } while (0)
#define PG8_WAIT_L(n) asm volatile("s_waitcnt lgkmcnt(" #n ")" ::: "memory")
#define PG8_BAR __builtin_amdgcn_s_barrier()
#define PG8_SCHED __builtin_amdgcn_sched_barrier(0)
    Unit cur, nxt; int ui = 0;
    if (!S.next(0, cur)) return;
    f32x4 acc[2][2][4][2];
    typename Epi::Aux aux;
    E.init(acc, cur, wr, wc, fr, fq);
    bf16x8 At[4][2], B0[2][2], B1[2][2];
    const char* cA = (const char*)g.A + (size_t)cur.pm * tstep; const char* cB = (const char*)g.Bt + (size_t)cur.pn * tstep + (HALF_N ? (size_t)cur.hb * hstepB : (size_t)0);
    S.a_ready(cur);
    if constexpr (SP2) {
        PG8_STAGEB(PG8_SB(0, 0), cB); PG8_STAGE_B1(PG8_SB(0, 1), cB + hstepB); PG8_STAGE(PG8_SA(0, 0), cA, voffA); PG8_STAGE(PG8_SA(0, 1), cA + hstepA, voffA);
        if (wr == 1) PG8_BAR;
        PG8_WAIT_V(2); PG8_BAR;
        PG8_STAGEB(PG8_SB(1, 0), cB + kstepB); PG8_STAGE(PG8_SA(1, 0), cA + kstepA, voffA); PG8_STAGE_B1(PG8_SB(1, 1), cB + hstepB + kstepB);
        if constexpr (HALF_N) PG8_WAIT_V(4); else PG8_WAIT_V(6);
        PG8_BAR;
    } else {
        PG8_STAGEB(PG8_SB(0, 0), cB); PG8_STAGE(PG8_SA(0, 0), cA, voffA); PG8_STAGEB(PG8_SB(0, 1), cB + hstepB); PG8_STAGE(PG8_SA(0, 1), cA + hstepA, voffA);
        if (wr == 1) PG8_BAR;
        PG8_WAIT_V(4); PG8_BAR;
        PG8_STAGEB(PG8_SB(1, 0), cB + kstepB); PG8_STAGE(PG8_SA(1, 0), cA + kstepA, voffA); PG8_STAGEB(PG8_SB(1, 1), cB + hstepB + kstepB);
        PG8_WAIT_V(6); PG8_BAR;
    }
    for (;;) {
        if constexpr (Epi::INIT_LOADS) {
#pragma unroll
            for (int a = 0; a < 2; ++a)
#pragma unroll
                for (int b = 0; b < (HALF_N ? 1 : 2); ++b)
#pragma unroll
                    for (int m = 0; m < 4; ++m) asm volatile("" : "+v"(acc[a][b][m][0]), "+v"(acc[a][b][m][1]));
        }
        E.aux_load(aux, cur, wr, wc, fr, fq);
        const bool has_next = S.next(ui + 1, nxt);
        const char* nA = has_next ? (const char*)g.A + (size_t)nxt.pm * tstep : cA; const char* nB = has_next ? (const char*)g.Bt + (size_t)nxt.pn * tstep + (HALF_N ? (size_t)nxt.hb * hstepB : (size_t)0) : cB;
        for (int t = 0; t < nt; t += 2) {
            const bool last = (t == nt - 2);
            const char* a1 = cA + (size_t)(t + 1) * kstepA;
            const char* a2 = last ? nA : cA + (size_t)(t + 2) * kstepA; const char* b2 = last ? nB : cB + (size_t)(t + 2) * kstepB;
            const char* a3 = a2 + kstepA; const char* b3 = b2 + kstepB;
            if (last && has_next) S.a_ready(nxt);
            int rl = __builtin_amdgcn_readfirstlane((int)((t == 0) & (ui > 0))); asm volatile("" : "+s"(rl));
            if constexpr (SP2) {
            PG8_LDB(B0, 0, 0); PG8_LDB1(B1, 0); PG8_SCHED; PG8_LDA(At, 0, 0); PG8_STAGE(PG8_SA(1, 1), a1 + hstepA, voffA);
            PG8_WAIT_V1; PG8_WAIT_L(0); PG8_BAR; PG8_MMA(0, 0, At, B0); PG8_MMA1(0, At, B1); PG8_BAR; PG8_SCHED;
            PG8_LDA(At, 0, 1); PG8_STAGEB(PG8_SB(0, 0), b2); PG8_STAGE_B1(PG8_SB(0, 1), b2 + hstepB); PG8_STAGE(PG8_SA(0, 0), a2, voffA);
            PG8_WAIT_V1; PG8_WAIT_L(0); PG8_BAR; PG8_MMA(1, 0, At, B0); PG8_MMA1(1, At, B1); PG8_BAR; PG8_SCHED;
            PG8_LDB(B0, 1, 0); PG8_LDB1(B1, 1); PG8_SCHED; PG8_LDA(At, 1, 0); PG8_STAGE(PG8_SA(0, 1), a2 + hstepA, voffA);
            PG8_WAIT_VK; PG8_WAIT_L(0); PG8_BAR; PG8_MMA(0, 0, At, B0); PG8_MMA1(0, At, B1); PG8_BAR; PG8_SCHED;
            PG8_LDA(At, 1, 1); PG8_STAGEB(PG8_SB(1, 0), b3); PG8_STAGE_B1(PG8_SB(1, 1), b3 + hstepB); PG8_STAGE(PG8_SA(1, 0), a3, voffA);
            PG8_WAIT_VK; PG8_WAIT_L(0); PG8_BAR; PG8_MMA(1, 0, At, B0); PG8_MMA1(1, At, B1); PG8_BAR; PG8_SCHED;
            } else {
            PG8_LDB(B0, 0, 0); PG8_SCHED; PG8_LDA(At, 0, 0); PG8_STAGE(PG8_SA(1, 1), a1 + hstepA, voffA);
            PG8_WAIT_L(8); PG8_BAR; PG8_WAIT_L(0); PG8_MMA(0, 0, At, B0); PG8_BAR; PG8_SCHED;
            PG8_LDB(B1, 0, 1); PG8_STAGEB(PG8_SB(0, 0), b2);
            PG8_BAR; PG8_WAIT_L(0); PG8_MMA(0, 1, At, B1); PG8_BAR;
            PG8_LDA(At, 0, 1); PG8_STAGE(PG8_SA(0, 0), a2, voffA);
            PG8_BAR; PG8_WAIT_L(0); PG8_MMA(1, 0, At, B0); PG8_BAR; PG8_SCHED;
            PG8_STAGEB(PG8_SB(0, 1), b2 + hstepB);
            PG8_WAIT_V(6); PG8_BAR; PG8_MMA(1, 1, At, B1); PG8_BAR;
            PG8_LDB(B0, 1, 0); PG8_SCHED; PG8_LDA(At, 1, 0); PG8_STAGE(PG8_SA(0, 1), a2 + hstepA, voffA);
            PG8_WAIT_L(8); PG8_BAR; PG8_WAIT_L(0); PG8_MMA(0, 0, At, B0); PG8_BAR; PG8_SCHED;
            PG8_LDB(B1, 1, 1); PG8_STAGEB(PG8_SB(1, 0), b3);
            PG8_BAR; PG8_WAIT_L(0); PG8_MMA(0, 1, At, B1); PG8_BAR;
            PG8_LDA(At, 1, 1); PG8_STAGE(PG8_SA(1, 0), a3, voffA);
            PG8_BAR; PG8_WAIT_L(0); PG8_MMA(1, 0, At, B0); PG8_BAR; PG8_SCHED;
            PG8_STAGEB(PG8_SB(1, 1), b3 + hstepB);
            PG8_WAIT_V(6); PG8_BAR; PG8_MMA(1, 1, At, B1); PG8_BAR;
            }
        }
        if constexpr (ALIGN_EPI) { if (wr == 0) PG8_BAR; }
        if constexpr (!Epi::AFTER_DRAIN) { E(acc, aux, cur, wr, wc, fr, fq); S.done(cur); }
        if (!has_next) break;
        E.init(acc, nxt, wr, wc, fr, fq);
        cur = nxt; cA = nA; cB = nB; ++ui;
        if constexpr (ALIGN_EPI) { if (wr == 1) PG8_BAR; }
    }
    PG8_WAIT_V(0);
    if constexpr (!ALIGN_EPI) { if (wr == 0) PG8_BAR; }
    PG8_BAR;
    if constexpr (Epi::AFTER_DRAIN) { E.fused(acc, cur, wr, wc, fr, fq, lds, wid, lane); S.done(cur); }
}
template <class Epi, class Sched>
__device__ __forceinline__ void gemm_phase_q(PG8_LAS unsigned char* lds, const Gemm g, const Sched& S, const Epi& E) {
    const int tid = threadIdx.x, wid = __builtin_amdgcn_readfirstlane(tid >> 6), lane = tid & 63, wr = wid >> 2, wc = wid & 3, fr = lane & 15, fq = lane >> 4;
    const int K = g.K, nt = K / BK;
    static_assert(Epi::A_BLK && Epi::PERM, "quarter units: A and the weights are stored as LDS images");
    unsigned voffA[2], voffB[2];
#pragma unroll
    for (int i = 0; i < 2; ++i) voffA[i] = voffB[i] = (unsigned)(tid * 16 + i * 8192);
    const size_t kstep = (size_t)BM * BK * 2, hstep = (size_t)HALF * BK * 2, tstep = (size_t)BM * K * 2;
    const unsigned ldsw = (unsigned)wid * 1024u;
    const int aoff = lds_byte(wr * 64 + fr, fq * 8), boff = lds_byte(wc * 32 + fr, fq * 8);
    Unit cur;
    if (!S.next(0, cur)) return;
    f32x4 acc[2][2][4][2];
    typename Epi::Aux aux;
    E.init(acc, cur, wr, wc, fr, fq);
    bf16x8 At[4][2], B0[2][2];
    const char* cA = (const char*)g.A + (size_t)cur.pm * tstep + (size_t)cur.hm * hstep; const char* cB = (const char*)g.Bt + (size_t)cur.pn * tstep + (size_t)cur.hb * hstep;
    S.a_ready(cur);
    PG8_STAGEB(PG8_SB(0, 0), cB); PG8_STAGE(PG8_SA(0, 0), cA, voffA);
    PG8_STAGEB(PG8_SB(0, 1), cB + kstep); PG8_STAGE(PG8_SA(0, 1), cA + kstep, voffA);
    PG8_STAGEB(PG8_SB(1, 0), cB + 2 * kstep); PG8_STAGE(PG8_SA(1, 0), cA + 2 * kstep, voffA);
    if (wr == 1) PG8_BAR;
    PG8_WAIT_V(8); PG8_BAR;
    PG8_BAR;
    if constexpr (Epi::INIT_LOADS) {
#pragma unroll
        for (int m = 0; m < 4; ++m) asm volatile("" : "+v"(acc[0][0][m][0]), "+v"(acc[0][0][m][1]));
    }
    E.aux_load(aux, cur, wr, wc, fr, fq);
#define PG8_SPQ(s, kt) do { const int _k = (kt) < nt ? (kt) : (kt) - nt; \
        PG8_LDB(B0, (s) >> 1, (s) & 1); PG8_SCHED; PG8_LDA(At, (s) >> 1, (s) & 1); \
        PG8_STAGEB(PG8_SB((((s) + 3) & 3) >> 1, ((s) + 3) & 1), cB + (size_t)_k * kstep); PG8_STAGE(PG8_SA((((s) + 3) & 3) >> 1, ((s) + 3) & 1), cA + (size_t)_k * kstep, voffA); \
        PG8_WAIT_V(8); PG8_WAIT_L(0); PG8_BAR; PG8_MMA(0, 0, At, B0); PG8_BAR; PG8_SCHED; } while (0)
    for (int t = 0; t < nt; t += 4) { PG8_SPQ(0, t + 3); PG8_SPQ(1, t + 4); PG8_SPQ(2, t + 5); PG8_SPQ(3, t + 6); }
#undef PG8_SPQ
    if (wr == 0) PG8_BAR;
    E(acc, aux, cur, wr, wc, fr, fq); S.done(cur);
    PG8_WAIT_V(0);
    PG8_BAR;
#undef PG8_SA
#undef PG8_SB
#undef PG8_STAGE
#undef PG8_STAGEB
#undef PG8_LDA
#undef PG8_LDB
#undef PG8_MMA
#undef PG8_WAIT_V
#undef PG8_WAIT_V1
#undef PG8_WAIT_VK
#undef PG8_STAGE_B1
#undef PG8_LDB1
#undef PG8_MMA1
#undef PG8_WAIT_L
#undef PG8_BAR
#undef PG8_SCHED
}
}
#ifndef PG8_SP2
#define PG8_SP2 true
#endif
#ifndef PG8_ALIGN
#define PG8_ALIGN true
#endif
namespace mixp {
using pg8::bf16_t; using pg8::bf16x8; using pg8::u32x4; using pg8::u32x2; using pg8::ZP; using pg8::MP; using pg8::MT; using pg8::LOG2E;
typedef float f32x16 __attribute__((ext_vector_type(16)));
typedef short v4i16_t __attribute__((ext_vector_type(4)));
#define MX_LAS __attribute__((address_space(3)))
typedef MX_LAS unsigned char* lptr;
constexpr int KR_OFF = 0, VR_OFF = 49152, OST_OFF = 98304;
constexpr int N_ATT_P = 32 * 3 * 32, N_ATT = N_ATT_P + 32 * 3, N_POOL_P = 32 * 32, N_UNITS = N_ATT + N_POOL_P + 32;
typedef float f32x2_t __attribute__((ext_vector_type(2))); typedef __bf16 bf16x2_t __attribute__((ext_vector_type(2)));
__device__ __forceinline__ unsigned pk_bf16(float lo, float hi) { f32x2_t v = {lo, hi}; bf16x2_t b = __builtin_convertvector(v, bf16x2_t); return __builtin_bit_cast(unsigned, b); }
__device__ __forceinline__ float bf_lo(unsigned w) { return __uint_as_float(w << 16); }
__device__ __forceinline__ float bf_hi(unsigned w) { return __uint_as_float(w & 0xffff0000u); }
__device__ __forceinline__ v4i16_t vtr(lptr p) { return __builtin_amdgcn_ds_read_tr16_b64_v4i16((MX_LAS v4i16_t*)p); }

struct AUnit { bool samp; int b, c, kvh, row0; };
__device__ __forceinline__ AUnit pool_decode(int j) { AUnit u; u.samp = j >= N_POOL_P; u.b = u.samp ? j - N_POOL_P : j >> 5; u.c = u.samp ? 0 : (j & 31); u.kvh = 0; u.row0 = u.samp ? MP + u.b * 64 : u.b * 2048 + 64 * u.c; return u; }
__device__ __forceinline__ void glds16(const void* gsrc, unsigned lds_dst) { unsigned keep;
    asm volatile("s_mov_b32 %0, m0\n\ts_mov_b32 m0, %2\n\ts_nop 0\n\tglobal_load_lds_dwordx4 %1, off\n\ts_mov_b32 m0, %0" : "=&s"(keep) : "v"(gsrc), "s"(lds_dst) : "memory"); }
#define MX_GLDS(src, dst) glds16((src), (unsigned)__builtin_amdgcn_readfirstlane((int)(unsigned)(uintptr_t)(dst)))

__device__ __forceinline__ void attn_issue_chunk(lptr ring, int slot, int j, const bf16_t* Z, const bf16_t* CK, const bf16_t* CV, const AUnit& u, int wid, int lane) {
    const int kkey = 8 * wid + (lane >> 3), kch = (lane & 7) ^ ((lane >> 3) & 7);
    const int vdh = wid >> 2, vkey = 16 * (wid & 3) + (lane >> 2), vch = 4 * vdh + (lane & 3);
    const bf16_t *ks, *vs;
    if (u.samp && j < 2) { const size_t o = (size_t)(u.b * 128 + 64 * j) * 192 + 64 * u.kvh; ks = CK + o + (size_t)kkey * 192 + 8 * kch; vs = CV + o + (size_t)vkey * 192 + 8 * vch; }
    else { const bool valid = u.samp || (u.c - 2 + j >= 0); const int rb = valid ? u.row0 - 128 + 64 * j : u.row0;
        ks = Z + (size_t)(16 + u.kvh) * MT * 64 + pg8::zsub_off(rb + kkey, 8 * kch); vs = Z + (size_t)(19 + u.kvh) * MT * 64 + pg8::zsub_off(rb + vkey, 8 * vch); }
    MX_GLDS(ks, ring + KR_OFF + slot * 8192 + wid * 1024);
    MX_GLDS(vs, ring + VR_OFF + slot * 8192 + wid * 1024);
}
__device__ __forceinline__ void attn_qload(bf16x8 (&q)[4], const bf16_t* Z, const AUnit& u, int wid, int lane) {
    const bf16_t* qp = Z + (size_t)(4 + 4 * u.kvh + (wid >> 1)) * MT * 64 + pg8::zsub_off(u.row0 + 32 * (wid & 1) + (lane & 31), 8 * (lane >> 5));
#pragma unroll
    for (int ks = 0; ks < 4; ++ks) q[ks] = __builtin_nontemporal_load((const bf16x8*)(qp + 512 * (ks >> 1) + 16 * (ks & 1)));
}
__device__ __forceinline__ void attn_compute(lptr ring, int sl0, int sl1, int sl2, const bf16x8 (&qr)[4], bf16_t* MIX, float sink2, const AUnit& u, int wid, int lane) {
    const int slb[3] = {sl0 * 8192, sl1 * 8192, sl2 * 8192};
    const int r32 = lane & 31, hi = lane >> 5, g = wid >> 1, qh = wid & 1, hq = 4 * u.kvh + g;
    const float slope2 = __builtin_amdgcn_exp2f(-8.0f * (float)(hq + 1) * (1.0f / 12.0f)) * LOG2E;
    const float qb = (float)(32 * qh + r32 + 128 - 4 * hi);
    const float nsq = -slope2 * qb;
    f32x16 p[6];
#pragma unroll
    for (int kb = 0; kb < 6; ++kb) {
        const bool valid = u.samp || (u.c - 2 + (kb >> 1) >= 0);
#pragma unroll
        for (int r = 0; r < 16; ++r) { const float cst = (float)(32 * kb + (r & 3) + 8 * (r >> 2));
            const float bias = kb < 4 ? __builtin_fmaf(slope2, cst, nsq) : -slope2 * __builtin_fabsf(qb - cst);
            p[kb][r] = valid ? bias : -1e30f; }
#pragma unroll
        for (int ks = 0; ks < 4; ++ks) {
            const bf16x8 kf = *(const MX_LAS bf16x8*)(ring + KR_OFF + slb[kb >> 1] + (32 * (kb & 1) + r32) * 128 + (((2 * ks + hi) ^ (r32 & 7)) << 4));
            p[kb] = __builtin_amdgcn_mfma_f32_32x32x16_bf16(kf, qr[ks], p[kb], 0, 0, 0);
        }
    }
    float sum = 0.f;
#pragma unroll
    for (int kb = 0; kb < 6; ++kb)
#pragma unroll
        for (int r = 0; r < 16; ++r) { p[kb][r] = __builtin_amdgcn_exp2f(p[kb][r]); sum += p[kb][r]; }
    sum += __shfl_xor(sum, 32);
    sum += __builtin_amdgcn_exp2f(sink2);
    const float inv = 1.0f / sum;
    f32x16 o[2];
#pragma unroll
    for (int r = 0; r < 16; ++r) { o[0][r] = 0.f; o[1][r] = 0.f; }
    const lptr vb = ring + VR_OFF + ((lane >> 4) & 1) * 32 + (lane & 3) * 8 + (4 * hi + ((lane & 15) >> 2)) * 64;
#pragma unroll
    for (int kb = 0; kb < 6; ++kb)
#pragma unroll
        for (int s = 0; s < 2; ++s) {
            u32x4 pw;
            pw.x = pk_bf16(p[kb][8 * s + 0], p[kb][8 * s + 1]); pw.y = pk_bf16(p[kb][8 * s + 2], p[kb][8 * s + 3]);
            pw.z = pk_bf16(p[kb][8 * s + 4], p[kb][8 * s + 5]); pw.w = pk_bf16(p[kb][8 * s + 6], p[kb][8 * s + 7]);
            const bf16x8 pf = __builtin_bit_cast(bf16x8, pw);
#pragma unroll
            for (int db = 0; db < 2; ++db) {
                const v4i16_t lo = vtr(vb + slb[kb >> 1] + db * 4096 + (32 * (kb & 1) + 16 * s) * 64), hh = vtr(vb + slb[kb >> 1] + db * 4096 + (32 * (kb & 1) + 16 * s + 8) * 64);
                const bf16x8 vf = (bf16x8){lo[0], lo[1], lo[2], lo[3], hh[0], hh[1], hh[2], hh[3]};
                o[db] = __builtin_amdgcn_mfma_f32_32x32x16_bf16(vf, pf, o[db], 0, 0, 0);
            }
        }
    const lptr st = ring + OST_OFF + wid * 4096;
#pragma unroll
    for (int db = 0; db < 2; ++db)
#pragma unroll
        for (int rg = 0; rg < 4; ++rg) { u32x2 w; w.x = pk_bf16(o[db][4 * rg] * inv, o[db][4 * rg + 1] * inv); w.y = pk_bf16(o[db][4 * rg + 2] * inv, o[db][4 * rg + 3] * inv);
            *(MX_LAS u32x2*)(st + r32 * 128 + (((4 * db + rg) ^ (r32 & 7)) << 4) + 8 * hi) = w; }
    asm volatile("s_waitcnt lgkmcnt(0)" ::: "memory");
    bf16_t* op = MIX + ((size_t)(u.row0 >> 8) * 16 + 4 + hq) * (256 * 64);
#pragma unroll
    for (int i = 0; i < 4; ++i) { const int row = 8 * i + (lane >> 3); const u32x4 v = *(const MX_LAS u32x4*)(st + row * 128 + (((lane & 7) ^ (row & 7)) << 4)); *(u32x4*)(op + pg8::img_off((u.row0 & 255) + 32 * qh + row, 8 * (lane & 7))) = v; }
}

__device__ __forceinline__ void pool_issue(lptr buf, const bf16_t* Z, const bf16_t* CP, const bf16_t* ZERO, const AUnit& u, int wid, int lane) {
#pragma unroll
    for (int j = 0; j < 5; ++j) {
        const int p = wid + 8 * j, ri = 2 * p + (lane >> 5), rc = ri > 78 ? 78 : ri, ch = (lane & 31) ^ (ri & 15);
        const bf16_t* src = Z + (size_t)(ch >> 3) * MT * 64 + pg8::zsub_off(u.row0 + rc - 15, 8 * (ch & 7));
        if (ri < 15) { if (u.samp) src = CP + (size_t)(u.b * 15 + ri) * 256 + 8 * ch; else if (u.c == 0) src = ZERO + 8 * (lane & 31); }
        MX_GLDS(src, buf + p * 1024);
    }
}
__device__ __forceinline__ void pool_compute(lptr buf, const bf16x8 (&wf)[2][4], bf16_t* MIX, const AUnit& u, int wid, int lane) {
    const int r32 = lane & 31, hi = lane >> 5;
    const int g = wid >> 1, hh = wid & 1, W = 2 << g, t = 32 * hh + r32;
    const int pos = u.samp ? 4096 + t : 64 * u.c + t;
    const float icnt = 1.0f / (float)((pos + 1 < W) ? pos + 1 : W);
    bf16x8 df[4];
#pragma unroll
    for (int ks = 0; ks < 4; ++ks) {
        const int chunk = 8 * g + 2 * ks + hi;
        float a[8]; u32x4 cur = (u32x4){0u, 0u, 0u, 0u};
#pragma unroll
        for (int e = 0; e < 8; ++e) a[e] = 0.f;
        for (int i = 0; i < W; ++i) {
            const int ri = t + 15 - i;
            const u32x4 v = *(const MX_LAS u32x4*)(buf + ri * 512 + ((chunk ^ (ri & 15)) << 4));
            a[0] += bf_lo(v.x); a[1] += bf_hi(v.x); a[2] += bf_lo(v.y); a[3] += bf_hi(v.y); a[4] += bf_lo(v.z); a[5] += bf_hi(v.z); a[6] += bf_lo(v.w); a[7] += bf_hi(v.w);
            if (i == 0) cur = v;
        }
        u32x4 dw;
        dw.x = pk_bf16(a[0] * icnt - bf_lo(cur.x), a[1] * icnt - bf_hi(cur.x)); dw.y = pk_bf16(a[2] * icnt - bf_lo(cur.y), a[3] * icnt - bf_hi(cur.y));
        dw.z = pk_bf16(a[4] * icnt - bf_lo(cur.z), a[5] * icnt - bf_hi(cur.z)); dw.w = pk_bf16(a[6] * icnt - bf_lo(cur.w), a[7] * icnt - bf_hi(cur.w));
        df[ks] = __builtin_bit_cast(bf16x8, dw);
    }
    bf16_t* op = MIX + ((size_t)(u.row0 >> 8) * 16 + g) * (256 * 64);
#pragma unroll
    for (int eb = 0; eb < 2; ++eb) {
        f32x16 o;
#pragma unroll
        for (int r = 0; r < 16; ++r) o[r] = 0.f;
#pragma unroll
        for (int ks = 0; ks < 4; ++ks) o = __builtin_amdgcn_mfma_f32_32x32x16_bf16(wf[eb][ks], df[ks], o, 0, 0, 0);
#pragma unroll
        for (int rg = 0; rg < 4; ++rg) { u32x2 w; w.x = pk_bf16(o[4 * rg], o[4 * rg + 1]); w.y = pk_bf16(o[4 * rg + 2], o[4 * rg + 3]); *(u32x2*)(op + pg8::img_off((u.row0 & 255) + t, 32 * eb + 8 * rg + 4 * hi)) = w; }
    }
}

#define MX_SYNC() do { asm volatile("s_waitcnt vmcnt(0) lgkmcnt(0)" ::: "memory"); __builtin_amdgcn_s_barrier(); asm volatile("" ::: "memory"); } while (0)
__device__ __forceinline__ void mix_phase(lptr lds, const bf16_t* Z, const bf16_t* CK, const bf16_t* CV, const bf16_t* CP, const bf16_t* WPt, const bf16_t* ZERO, bf16_t* MIX, const float* sinks, int first, int stride) {
    const int tid = threadIdx.x, lane = tid & 63, wid = __builtin_amdgcn_readfirstlane(tid >> 6);
    constexpr int PBUF = 40960;
    constexpr int NRUN_P = 32 * 3 * 8, NRUN = NRUN_P + 32 * 3;
    int par = 0;
    if (first < NRUN) {
        const int g = wid >> 1;
        float sk0 = sinks[g] * LOG2E, sk1 = sinks[4 + g] * LOG2E, sk2 = sinks[8 + g] * LOG2E;
        asm volatile("" : "+v"(sk0), "+v"(sk1), "+v"(sk2));
        int run = first, st = 0, head = 0;
        auto unit_of = [](int run, int st) { AUnit u; u.samp = run >= NRUN_P; const int rr = u.samp ? run : NRUN_P - 1 - run;     const int a = u.samp ? run - NRUN_P : rr >> 3; u.b = a / 3; u.kvh = a % 3; u.c = u.samp ? 0 : 4 * (rr & 7) + st;
                                              u.row0 = u.samp ? MP + u.b * 64 : u.b * 2048 + 64 * u.c; return u; };
        bf16x8 qn[4];
        AUnit u = unit_of(run, 0);
        int s0 = 0, s1 = 1, s2 = 2; head = 3;
        attn_issue_chunk(lds, 0, 0, Z, CK, CV, u, wid, lane); attn_issue_chunk(lds, 1, 1, Z, CK, CV, u, wid, lane); attn_issue_chunk(lds, 2, 2, Z, CK, CV, u, wid, lane);
        attn_qload(qn, Z, u, wid, lane);
        for (;;) {
            MX_SYNC();
            bf16x8 qr[4];
#pragma unroll
            for (int ks = 0; ks < 4; ++ks) qr[ks] = qn[ks];
            asm volatile("" : "+v"(qr[0]), "+v"(qr[1]), "+v"(qr[2]), "+v"(qr[3]));
            int nrun = run, nst = st + 1; const int len = (run >= NRUN_P) ? 1 : 4;
            if (nst == len) { nrun = run + stride; nst = 0; }
            const bool more = nrun < NRUN;
            int n0 = s1, n1 = s2, n2 = head;
            AUnit un = u;
            if (more) {
                un = unit_of(nrun, nst);
                if (nst == 0) { n0 = head; n1 = head + 1 >= 6 ? head - 5 : head + 1; n2 = head + 2 >= 6 ? head - 4 : head + 2;
                    attn_issue_chunk(lds, n0, 0, Z, CK, CV, un, wid, lane); attn_issue_chunk(lds, n1, 1, Z, CK, CV, un, wid, lane); attn_issue_chunk(lds, n2, 2, Z, CK, CV, un, wid, lane);
                    head = head + 3 >= 6 ? head - 3 : head + 3; }
                else { attn_issue_chunk(lds, n2, 2, Z, CK, CV, un, wid, lane); head = head + 1 >= 6 ? 0 : head + 1; }
                attn_qload(qn, Z, un, wid, lane);
            }
            attn_compute(lds, s0, s1, s2, qr, MIX, u.kvh == 0 ? sk0 : (u.kvh == 1 ? sk1 : sk2), u, wid, lane);
            if (!more) break;
            run = nrun; st = nst; u = un; s0 = n0; s1 = n1; s2 = n2;
        }
    }
    MX_SYNC();
    int pj = first >= 96 ? first - 96 : first + stride - 96; par = 0;
    if (pj < N_POOL_P + 32) {
        bf16x8 wf[2][4];
#pragma unroll
        for (int eb = 0; eb < 2; ++eb)
#pragma unroll
            for (int ks = 0; ks < 4; ++ks) wf[eb][ks] = *(const bf16x8*)(WPt + (size_t)(((wid >> 1) * 64 + 32 * eb + (lane & 31)) * 64 + 16 * ks + 8 * (lane >> 5)));
        pool_issue(lds, Z, CP, ZERO, pool_decode(pj), wid, lane);
        for (; pj < N_POOL_P + 32; pj += stride, par ^= 1) {
            const AUnit u = pool_decode(pj);
            MX_SYNC();
            if (pj + stride < N_POOL_P + 32) pool_issue(lds + (par ^ 1) * PBUF, Z, CP, ZERO, pool_decode(pj + stride), wid, lane);
            pool_compute(lds + par * PBUF, wf, MIX, u, wid, lane);
        }
    }
    MX_SYNC();
}
#undef MX_SYNC
#undef MX_GLDS
#undef MX_LAS
}
constexpr int NWAVES = 8;
#ifndef MK_N_LAUNCHES
#define MK_N_LAUNCHES 1
#endif
constexpr int N_LAUNCHES = MK_N_LAUNCHES;
constexpr int PER_PHASE = 6;
#ifndef MK_P5_LAG
#define MK_P5_LAG 900
#endif
constexpr int P5_LAG = MK_P5_LAG;

constexpr size_t MiB = 1u << 20;
constexpr size_t WS_CTL = 0, CTL_ZERO_BYTES = 64 * 1024, WS_ZERO = 512 * 1024, WS_SS = 1 * MiB;
constexpr size_t WS_WIN = 2 * MiB, WS_WOUT = 5 * MiB, WS_WGU = 7 * MiB, WS_WD = 18 * MiB;
constexpr size_t WS_WP = 24 * MiB, WS_CK = 25 * MiB, WS_CV = 27 * MiB, WS_CP = 29 * MiB;
constexpr size_t WS_RX = 30 * MiB;
constexpr size_t WS_XB_FROM_END = 132 * MiB;
constexpr size_t WS_Z_FROM_END = (132 + 182) * MiB;
constexpr size_t WS_ACT = 32 * MiB;
constexpr size_t WS_MIX = 396 * MiB;
constexpr size_t WS_HB = 528 * MiB;
constexpr size_t WS_LOW_END = 660 * MiB, WS_END = WS_LOW_END + WS_Z_FROM_END;
static_assert(WS_SS + (size_t)67584 * 4 <= WS_WIN && WS_WD + (size_t)1024 * 2816 * 2 <= WS_WP && WS_RX + (size_t)67584 * 4 <= WS_ACT && WS_ACT + (size_t)67584 * 2816 * 2 <= WS_MIX &&
              WS_MIX + (size_t)67584 * 1024 * 2 <= WS_HB && WS_HB + (size_t)67584 * 1024 * 2 <= WS_LOW_END && (size_t)67584 * 1024 * 2 <= 132 * MiB && (size_t)67584 * 1408 * 2 <= 182 * MiB, "d_ws map");
constexpr int CW_TMO = 0, CW_CODE = 1;
constexpr int CW_BAR = 4096;
constexpr int RING_OFF = 0, RING_BYTES = 131072;
constexpr int LDSCTL_OFF = RING_BYTES, MISC_OFF = LDSCTL_OFF + 320;
constexpr int STAGE_OFF = LDSCTL_OFF + 1024;
constexpr int JUNK_OFF = STAGE_OFF + 16384;
constexpr int LDS_BYTES = STAGE_OFF + 16384;
static_assert(MISC_OFF + 128 <= LDS_BYTES, "LDS map");

#define GAS __attribute__((address_space(1)))
#define LAS __attribute__((address_space(3)))
typedef unsigned short bf16;
typedef unsigned v4u __attribute__((ext_vector_type(4)));
typedef float f32x4 __attribute__((ext_vector_type(4)));
typedef short bf16x8 __attribute__((ext_vector_type(8)));
typedef GAS unsigned gu32;
typedef GAS unsigned long long gu64;
#define RLX_AGENT __ATOMIC_RELAXED, __HIP_MEMORY_SCOPE_AGENT
#define LDS_WAIT() asm volatile("s_waitcnt lgkmcnt(0)" ::: "memory")
#define VM_WAIT() asm volatile("s_waitcnt vmcnt(0)" ::: "memory")
__device__ __forceinline__ unsigned long long rt() { return __builtin_amdgcn_s_memrealtime(); }
__device__ __forceinline__ unsigned f2bf(float f) { unsigned u = __builtin_bit_cast(unsigned, f); return (u + 0x7fffu + ((u >> 16) & 1u)) >> 16; }
__device__ __forceinline__ unsigned pk2(float lo, float hi) { return f2bf(lo) | (f2bf(hi) << 16); }

#define XB_TMO      128
#define XB_XCNT(j)  (256  + 64 * (j))
#define XB_XSUB(j)  (1280 + 64 * (j))
#define XB_XGEN(j)  (2304 + 64 * (j))
#define XB_TOP      3328
#define XB_TOPGEN   3392
#define XCD_BAR_WORDS 3456
#define XB_SPIN_CAP (1u << 18)

__device__ __forceinline__ unsigned xb_ld(unsigned* p)              { return __hip_atomic_load(p, __ATOMIC_RELAXED, __HIP_MEMORY_SCOPE_AGENT); }
__device__ __forceinline__ unsigned xb_add(unsigned* p, unsigned v) { return __hip_atomic_fetch_add(p, v, __ATOMIC_RELAXED, __HIP_MEMORY_SCOPE_AGENT); }
__device__ __forceinline__ unsigned xb_xcc_id() { return (unsigned)__builtin_amdgcn_s_getreg((3 << 11) | 20) & 0xFu; }
#define XB_SPIN(cond, bar) do { unsigned _sp = 0; while (cond) { __builtin_amdgcn_s_sleep(1); \
    if ((++_sp & 255u) == 0u) { if (xb_ld(&(bar)[XB_TMO])) break; if (_sp > XB_SPIN_CAP) { atomicAdd(&(bar)[XB_TMO], 1u); break; } } } } while (0)

struct XcdBarrier {
    unsigned* bar; unsigned x;
    volatile LAS unsigned* st;
};

__device__ __forceinline__ XcdBarrier xcd_barrier_post(unsigned* bar, volatile LAS unsigned* st) {
    XcdBarrier b; b.bar = bar; b.x = xb_xcc_id(); b.st = st;
    if (threadIdx.x == 0) (void)xb_add(&bar[XB_XCNT(b.x)], 1u);
    return b;
}
__device__ __forceinline__ void xcd_barrier_complete(unsigned* bar, unsigned x, unsigned& nloc, unsigned& nx) {
    const unsigned G = gridDim.x * gridDim.y * gridDim.z;
    unsigned sum, cnt, mine, sp = 0u;
    for (;;) {
        sum = 0u; cnt = 0u; mine = 0u;
#pragma unroll
        for (unsigned j = 0; j < 16; ++j) { const unsigned c = xb_ld(&bar[XB_XCNT(j)]); sum += c; cnt += (c > 0u) ? 1u : 0u; mine = (j == x) ? c : mine; }
        if (sum == G) break;
        __builtin_amdgcn_s_sleep(1);
        if ((++sp & 255u) == 0u) { if (xb_ld(&bar[XB_TMO])) break; if (sp > XB_SPIN_CAP) { atomicAdd(&bar[XB_TMO], 1u); break; } }
    }
    nloc = mine > 0u ? mine : 1u; nx = cnt > 0u ? cnt : 1u;
}

__device__ __forceinline__ void xcd_barrier(const XcdBarrier& b) {
    asm volatile("s_waitcnt vmcnt(0)" ::: "memory");
    __syncthreads();
    if (threadIdx.x == 0) {
        unsigned* bar = b.bar;
        __builtin_amdgcn_s_waitcnt(0);
        unsigned nloc = b.st[0], nx = b.st[1];
        if (nloc == 0u) { xcd_barrier_complete(bar, b.x, nloc, nx); b.st[0] = nloc; b.st[1] = nx; }
        const unsigned old = xb_add(&bar[XB_XSUB(b.x)], 1u);
        const unsigned gen = old / nloc;
        if (old + 1u == (gen + 1u) * nloc) {
            __builtin_amdgcn_fence(__ATOMIC_RELEASE, "agent");
            asm volatile("s_waitcnt vmcnt(0)" ::: "memory");
            const unsigned og = xb_add(&bar[XB_TOP], 1u);
            const unsigned tg = og / nx;
            if (og + 1u == (tg + 1u) * nx) xb_add(&bar[XB_TOPGEN], 1u);
            else XB_SPIN(xb_ld(&bar[XB_TOPGEN]) == tg, bar);
            __builtin_amdgcn_fence(__ATOMIC_ACQUIRE, "agent");
            xb_add(&bar[XB_XGEN(b.x)], 1u);
            asm volatile("s_waitcnt vmcnt(0)" ::: "memory");
        } else {
            XB_SPIN(xb_ld(&bar[XB_XGEN(b.x)]) == gen, bar);
            __builtin_amdgcn_fence(__ATOMIC_ACQUIRE, "agent");
            asm volatile("s_waitcnt vmcnt(0)" ::: "memory");
        }
    }
    __syncthreads();
}
struct Frame {
    LAS unsigned char* lds;
    volatile LAS unsigned* MISC;
    gu32* ctl;
    int tid, lane, wave;
    int vcu, G;
};

__device__ __forceinline__ float wave_sum(float v) {
#pragma unroll
    for (int o = 1; o < 64; o <<= 1) v += __shfl_xor(v, o);
    return v;
}
__device__ __forceinline__ int p0_drow(int mode, int n0) {
    if (mode == 1) { const int lc = n0 & 255, dd = lc & 63; return n0 >= 1280 ? n0 : (n0 & ~255) + 128 * (dd >> 5) + 32 * (lc >> 6); }
    if (mode == 2) return 256 * (n0 >> 7) + (n0 & 127);
    if (mode == 3) return 256 * (n0 >> 7) + 128 + (n0 & 127);
    return n0;
}
__device__ __forceinline__ void p0_transpose_item(const float* W, const float* gain, int K, int N, bf16* WT, int kt, int b, int n0, int mode, LAS float* scr, int lane) {
    const int k0 = 64 * kt + 32 * b;
    const GAS f32x4* src = (const GAS f32x4*)(W + (size_t)(k0 + (lane >> 5)) * N + n0) + (lane & 31);
    f32x4 v[16];
#pragma unroll
    for (int i = 0; i < 16; ++i) v[i] = __builtin_nontemporal_load(src + (size_t)(2 * i) * (N >> 2));
    const int pb = lane * 16, ob = pb ^ (((pb >> 9) & 1) << 5), rr = ob >> 6, cc = (ob & 63) >> 1;
    f32x4 g0 = (f32x4){1.f, 1.f, 1.f, 1.f}, g1 = g0;
    if (gain) { g0 = *(const GAS f32x4*)(gain + k0 + cc); g1 = *(const GAS f32x4*)(gain + k0 + cc + 4); }
#pragma unroll
    for (int i = 0; i < 16; ++i) *(LAS f32x4*)(scr + (2 * i + (lane >> 5)) * 128 + 4 * (lane & 31)) = v[i];
    LDS_WAIT(); asm volatile("" ::: "memory");
#pragma unroll
    for (int g = 0; g < 4; ++g) {
        const int drow0 = p0_drow(mode, n0 + 32 * g);
        GAS unsigned char* base = (GAS unsigned char*)WT + ((size_t)((drow0 >> 8) * (K >> 6) + kt) * 2 + ((drow0 >> 7) & 1)) * pg8::HTB + (size_t)(((drow0 & 127) >> 4) * 2 + b) * 1024 + pb;
#pragma unroll
        for (int a = 0; a < 2; ++a) { const LAS float* t = scr + cc * 128 + 32 * g + pg8::perm32(16 * a + rr);
            v4u o; o.x = pk2(t[0 * 128] * g0.x, t[1 * 128] * g0.y); o.y = pk2(t[2 * 128] * g0.z, t[3 * 128] * g0.w); o.z = pk2(t[4 * 128] * g1.x, t[5 * 128] * g1.y); o.w = pk2(t[6 * 128] * g1.z, t[7 * 128] * g1.w);
            *(GAS v4u*)(base + a * 2048) = o; }
    }
    LDS_WAIT(); asm volatile("" ::: "memory");
}
__device__ __forceinline__ void x_rows2_to_bf16(const float* xa, const float* xb, bf16* oa, bf16* ob, float* ra, float* rb, int lane) {
    const GAS f32x4* pa = (const GAS f32x4*)xa + lane; const GAS f32x4* pb = (const GAS f32x4*)xb + lane;
    f32x4 va[4], vb[4]; float sa = 0.f, sb = 0.f;
#pragma unroll
    for (int j = 0; j < 4; ++j) { va[j] = __builtin_nontemporal_load(pa + 64 * j); vb[j] = __builtin_nontemporal_load(pb + 64 * j); }
#pragma unroll
    for (int j = 0; j < 4; ++j) { sa += (va[j].x * va[j].x + va[j].y * va[j].y) + (va[j].z * va[j].z + va[j].w * va[j].w); sb += (vb[j].x * vb[j].x + vb[j].y * vb[j].y) + (vb[j].z * vb[j].z + vb[j].w * vb[j].w); }
    GAS unsigned long long* qa = (GAS unsigned long long*)oa + lane; GAS unsigned long long* qb = (GAS unsigned long long*)ob + lane;
#pragma unroll
    for (int j = 0; j < 4; ++j) { qa[64 * j] = (unsigned long long)pk2(va[j].x, va[j].y) | ((unsigned long long)pk2(va[j].z, va[j].w) << 32);
                                  qb[64 * j] = (unsigned long long)pk2(vb[j].x, vb[j].y) | ((unsigned long long)pk2(vb[j].z, vb[j].w) << 32); }
    const float r1 = 1.f / sqrtf(wave_sum(sa) * (1.f / 1024.f) + 1e-6f), r2 = 1.f / sqrtf(wave_sum(sb) * (1.f / 1024.f) + 1e-6f);
    if (lane == 0) { *ra = r1; *rb = r2; }
}
struct P0Args { const float *xp, *xs, *cpool, *ck, *cv, *norm_mix, *w_in, *w_pool, *pool_scale, *w_out, *norm_ffn, *w_gate, *w_up, *w_down; float* out;
                bf16 *Win_t, *Wout_t, *Wgu_t, *Wd_t, *WPt, *CK, *CV, *CP, *XB; float* RX; float* SS; float* ZERO; };
__device__ __forceinline__ void p0_prologue(Frame& F, const P0Args& A) {
    LAS float* scr = (LAS float*)(F.lds + RING_OFF + F.wave * 16384);
    const int gw = F.vcu * NWAVES + F.wave, NGW = F.G * NWAVES;
    constexpr int I_IN = 32 * 11, I_OUT = 32 * 8, I_G = 32 * 22, I_D = 88 * 8, NITEMS = I_IN + I_OUT + 2 * I_G + I_D;
    for (int it = gw; it < NITEMS; it += NGW) {
        int r = it;
        if (r < I_IN) { const int kh = r / 11, nb = r % 11; p0_transpose_item(A.w_in, A.norm_mix, 1024, 1408, A.Win_t, kh >> 1, kh & 1, 128 * nb, 1, scr, F.lane); continue; } r -= I_IN;
        if (r < I_OUT) { const int kh = r / 8, nb = r % 8; p0_transpose_item(A.w_out, nullptr, 1024, 1024, A.Wout_t, kh >> 1, kh & 1, 128 * nb, 0, scr, F.lane); continue; } r -= I_OUT;
        if (r < I_G) { const int kh = r / 22, nb = r % 22; p0_transpose_item(A.w_gate, A.norm_ffn, 1024, 2816, A.Wgu_t, kh >> 1, kh & 1, 128 * nb, 2, scr, F.lane); continue; } r -= I_G;
        if (r < I_G) { const int kh = r / 22, nb = r % 22; p0_transpose_item(A.w_up, A.norm_ffn, 1024, 2816, A.Wgu_t, kh >> 1, kh & 1, 128 * nb, 3, scr, F.lane); continue; } r -= I_G;
        { const int kh = r / 8, nb = r % 8; p0_transpose_item(A.w_down, nullptr, 2816, 1024, A.Wd_t, kh >> 1, kh & 1, 128 * nb, 0, scr, F.lane); }
    }
    __syncthreads();
    {
        constexpr int RS = 2112, NG = pg8::MT / 16;
        LAS unsigned char* stg = F.lds + RING_OFF;
        f32x4 va[4], vb[4];
        int grp = F.vcu;
        auto issue = [&](int g) { const int r = 16 * g + 2 * F.wave; const float* xa = r < pg8::MP ? A.xp + (size_t)r * 1024 : A.xs + (size_t)(r - pg8::MP) * 1024;
            const GAS f32x4* pa = (const GAS f32x4*)xa + F.lane;
#pragma unroll
            for (int j = 0; j < 4; ++j) { va[j] = __builtin_nontemporal_load(pa + 64 * j); vb[j] = __builtin_nontemporal_load(pa + 256 + 64 * j); } };
        if (grp < NG) issue(grp);
        for (; grp < NG; grp += F.G) {
            const int r = 16 * grp + 2 * F.wave;
            float sa = 0.f, sb = 0.f;
#pragma unroll
            for (int j = 0; j < 4; ++j) { sa += (va[j].x * va[j].x + va[j].y * va[j].y) + (va[j].z * va[j].z + va[j].w * va[j].w); sb += (vb[j].x * vb[j].x + vb[j].y * vb[j].y) + (vb[j].z * vb[j].z + vb[j].w * vb[j].w); }
            LAS unsigned long long* la = (LAS unsigned long long*)(stg + (2 * F.wave) * RS) + F.lane; LAS unsigned long long* lb = (LAS unsigned long long*)(stg + (2 * F.wave + 1) * RS) + F.lane;
#pragma unroll
            for (int j = 0; j < 4; ++j) { la[64 * j] = (unsigned long long)pk2(va[j].x, va[j].y) | ((unsigned long long)pk2(va[j].z, va[j].w) << 32);
                                          lb[64 * j] = (unsigned long long)pk2(vb[j].x, vb[j].y) | ((unsigned long long)pk2(vb[j].z, vb[j].w) << 32); }
            if (grp + F.G < NG) issue(grp + F.G);
            const float r1 = 1.f / sqrtf(wave_sum(sa) * (1.f / 1024.f) + 1e-6f), r2 = 1.f / sqrtf(wave_sum(sb) * (1.f / 1024.f) + 1e-6f);
            if (F.lane == 0) { A.RX[r] = r1; A.RX[r + 1] = r2; }
            __syncthreads();
            GAS unsigned char* blk = (GAS unsigned char*)A.XB + ((size_t)(grp >> 4) * 16 * 2 + ((grp >> 3) & 1)) * pg8::HTB + (size_t)(grp & 7) * 2048;
            const int pb = F.lane * 16, ob = pb ^ (((pb >> 9) & 1) << 5), rr = ob >> 6, cc = (ob & 63) >> 1;
#pragma unroll
            for (int q = 0; q < 4; ++q) { const int st = F.wave + 8 * q, kt = st >> 1, ch = st & 1;
                const v4u val = *(const LAS v4u*)(stg + rr * RS + (kt * 64 + ch * 32 + cc) * 2);
                *(GAS v4u*)(blk + (size_t)kt * (2 * pg8::HTB) + ch * 1024 + pb) = val; }
            __syncthreads();
        }
    }
    const int gt = gw * 64 + F.lane, NGT = NGW * 64;
    for (int i = gt; i < 4 * 64 * 64; i += NGT) { const int g = i >> 12, e = (i >> 6) & 63, c = i & 63;
        A.WPt[i] = (bf16)f2bf(A.w_pool[(g * 64 + c) * 64 + e] * A.pool_scale[64 * g + e]); }
    for (int i = gt; i < 32 * 128 * 192 / 4; i += NGT) {
        const f32x4 k4 = ((const GAS f32x4*)A.ck)[i], v4 = ((const GAS f32x4*)A.cv)[i];
        ((GAS unsigned long long*)A.CK)[i] = (unsigned long long)pk2(k4.x, k4.y) | ((unsigned long long)pk2(k4.z, k4.w) << 32);
        ((GAS unsigned long long*)A.CV)[i] = (unsigned long long)pk2(v4.x, v4.y) | ((unsigned long long)pk2(v4.z, v4.w) << 32);
        const int b = i / (128 * 48), rr = (i / 48) & 127, q = i % 48;
        if (rr >= 64) { const size_t o = ((size_t)(b * 128 + rr - 64) * 192) / 4 + q; ((GAS f32x4*)(A.out + pg8::O_K_S))[o] = k4; ((GAS f32x4*)(A.out + pg8::O_V_S))[o] = v4; }
    }
    for (int i = gt; i < 67584 / 4; i += NGT) ((GAS f32x4*)A.SS)[i] = (f32x4){0.f, 0.f, 0.f, 0.f};
    if (gt < 64) ((GAS f32x4*)A.ZERO)[gt] = (f32x4){0.f, 0.f, 0.f, 0.f};
    for (int i = gt; i < 32 * 15 * 256 / 4; i += NGT) { const f32x4 p4 = ((const GAS f32x4*)A.cpool)[i]; ((GAS unsigned long long*)A.CP)[i] = (unsigned long long)pk2(p4.x, p4.y) | ((unsigned long long)pk2(p4.z, p4.w) << 32); }
}

struct Args { const float* in[17]; float* out; unsigned char* ws; size_t ws_size; int ph_lo, ph_hi, li, pad; };
__global__ void __launch_bounds__(NWAVES * 64, 2) mk_fwd(Args args) {
    extern __shared__ __attribute__((aligned(16))) unsigned char lds[];
    Frame F;
    F.lds = (LAS unsigned char*)lds;
    F.MISC = (volatile LAS unsigned*)(F.lds + MISC_OFF);
    F.tid = threadIdx.x; F.lane = F.tid & 63; F.wave = __builtin_amdgcn_readfirstlane(F.tid >> 6);
    F.G = gridDim.x; { const int bx = blockIdx.x; F.vcu = (F.G % 8 == 0) ? (bx % 8) * (F.G / 8) + bx / 8 : bx; }
#define GRID_BAR(seam) do { if (N_LAUNCHES == PER_PHASE) { if (F.tid == 0) __hip_atomic_store(F.ctl + CW_TMO, 0xBADBA0u | (unsigned)(seam), RLX_AGENT); } \
    else { xcd_barrier(bar); } } while (0)
    unsigned char* ws = args.ws;
    F.ctl = (gu32*)(ws + WS_CTL);
    float* const out = args.out;
    bf16* const Win_t = (bf16*)(ws + WS_WIN); bf16* const Wout_t = (bf16*)(ws + WS_WOUT); bf16* const Wgu_t = (bf16*)(ws + WS_WGU); bf16* const Wd_t = (bf16*)(ws + WS_WD);
    bf16* const WPt = (bf16*)(ws + WS_WP); bf16* const CKb = (bf16*)(ws + WS_CK); bf16* const CVb = (bf16*)(ws + WS_CV); bf16* const CPb = (bf16*)(ws + WS_CP);
    bf16* const XB = (bf16*)(ws + (args.ws_size - WS_XB_FROM_END)); bf16* const HB = (bf16*)(ws + WS_HB); bf16* const Z = (bf16*)(ws + (args.ws_size - WS_Z_FROM_END)); bf16* const MIX = (bf16*)(ws + WS_MIX); bf16* const ACT = (bf16*)(ws + WS_ACT);
    float* const SS = (float*)(ws + WS_SS); float* const RX = (float*)(ws + WS_RX);
    for (int u = F.tid; u < (LDS_BYTES - LDSCTL_OFF) / 4; u += NWAVES * 64) ((LAS unsigned*)(F.lds + LDSCTL_OFF))[u] = 0u;
    __syncthreads();
    const int bli = (N_LAUNCHES == PER_PHASE) ? 0 : args.li;
    XcdBarrier bar; bar.bar = (unsigned*)(F.ctl + CW_BAR) + bli * XCD_BAR_WORDS; bar.x = 0; bar.st = nullptr;
    if (N_LAUNCHES != PER_PHASE)
        bar = xcd_barrier_post((unsigned*)(F.ctl + CW_BAR) + bli * XCD_BAR_WORDS, F.MISC + 8);

    const int lo = args.ph_lo, hi = args.ph_hi;
#define IN(k) (lo <= (k) && (k) < hi)
#define BOTH(k) (IN(k) && IN((k) + 1))

    if (IN(0)) {
        P0Args A{args.in[0], args.in[1], args.in[2], args.in[3], args.in[4], args.in[5], args.in[6], args.in[7], args.in[8], args.in[12], args.in[13], args.in[14], args.in[15], args.in[16], out,
                 Win_t, Wout_t, Wgu_t, Wd_t, WPt, CKb, CVb, CPb, XB, RX, SS, (float*)(ws + WS_ZERO)};
        p0_prologue(F, A);
        if (BOTH(0)) GRID_BAR(0);
    }
    if (IN(1)) {
        pg8::Gemm g{XB, Win_t, pg8::MT, 1536, 1024};
        pg8::StaticOrder S; S.init(pg8::MT, 1280, F.G, (int)blockIdx.x);
        { pg8::BalancedFullOrder Sb; Sb.init(pg8::MT, 1280, F.G, (int)blockIdx.x); pg8::EpiZ E{Z, args.in[9], args.in[10], out, RX, F.lds + STAGE_OFF};
          pg8::gemm_phase<pg8::EpiZ, pg8::BalancedFullOrder, PG8_ALIGN, PG8_SP2>(F.lds + RING_OFF, g, Sb, E); }
        { pg8::BalancedHalfOrder T{5, 0, (int)blockIdx.x, F.G, S.nM, S.nwg % F.G}; pg8::EpiZv E{Z, out, RX, F.lds + STAGE_OFF};
          pg8::gemm_phase<pg8::EpiZv, pg8::BalancedHalfOrder, PG8_ALIGN, PG8_SP2, true>(F.lds + RING_OFF, g, T, E); }
        if (BOTH(1)) GRID_BAR(1);
    }
    if (IN(2)) {
        mixp::mix_phase(F.lds + RING_OFF, Z, CKb, CVb, CPb, WPt, (const bf16*)(ws + WS_ZERO), MIX, args.in[11], (int)blockIdx.x, F.G);
        if (BOTH(2)) GRID_BAR(2);
    }
    if (IN(3)) {
        pg8::Gemm g{MIX, Wout_t, pg8::MT, 1024, 1024}; pg8::StaticOrder S; S.init(pg8::MT, 1024, F.G, (int)blockIdx.x);
        const int full = (S.nwg / F.G) * F.G;
        { pg8::StaticOrder Sa = S; Sa.hi = full; pg8::EpiH<false> E{XB, HB, SS};
          pg8::gemm_phase<pg8::EpiH<false>, pg8::StaticOrder, PG8_ALIGN, PG8_SP2>(F.lds + RING_OFF, g, Sa, E); }
        { pg8::TailHalfOrder T{S, full, (int)blockIdx.x}; pg8::EpiH<true> E{XB, HB, SS};
          pg8::gemm_phase<pg8::EpiH<true>, pg8::TailHalfOrder, PG8_ALIGN, PG8_SP2, true>(F.lds + RING_OFF, g, T, E); }
        if (BOTH(3)) GRID_BAR(3);
    }
    if (IN(4)) {
        pg8::Gemm g{HB, Wgu_t, pg8::MT, 5632, 1024}; pg8::StaticOrder S; S.init(pg8::MT, 5632, F.G, (int)blockIdx.x);
        S.rev = 1;
        pg8::EpiAct E{SS, ACT, F.lds + STAGE_OFF};
        pg8::gemm_phase<pg8::EpiAct, pg8::StaticOrder, PG8_ALIGN, PG8_SP2>(F.lds + RING_OFF, g, S, E);
        if (BOTH(4)) GRID_BAR(4);
    }
    if (IN(5)) {
        pg8::Gemm g{ACT, Wd_t, pg8::MT, 1024, 2816}; pg8::StaticOrder S; S.init(pg8::MT, 1024, F.G, (int)blockIdx.x);
        const int full = (S.nwg / F.G) * F.G;
        { pg8::StaticOrder Sa = S; Sa.hi = full; pg8::EpiY<false> E{HB, out, F.lds + STAGE_OFF};
          pg8::gemm_phase<pg8::EpiY<false>, pg8::StaticOrder, PG8_ALIGN, PG8_SP2>(F.lds + RING_OFF, g, Sa, E); }
        { pg8::TailHalfOrder T{S, full, (int)blockIdx.x}; pg8::EpiY<true> E{HB, out, F.lds + STAGE_OFF};
          pg8::gemm_phase<pg8::EpiY<true>, pg8::TailHalfOrder, PG8_ALIGN, PG8_SP2, true>(F.lds + RING_OFF, g, T, E); }
    }
#undef IN
#undef BOTH
}

extern "C" void kernel_launch(void* const* d_in, const int* in_sizes, int n_in, void* d_out, int out_size, void* d_ws, size_t ws_size, hipStream_t stream) {
    static int grid = 0;
    if (grid == 0) {
        if (n_in != 17 || in_sizes[0] != 65536 * 1024 || out_size != (int)pg8::O_END || ws_size < WS_END) { fprintf(stderr, "kernel_launch: shape mismatch: n_in %d, in0 %d, out %d, ws %zu (need >= %zu); nothing launched\n", n_in, n_in > 0 ? in_sizes[0] : -1, out_size, ws_size, (size_t)WS_END); grid = -1; return; }
        int dev = 0, cus = 0, per_cu = 0;
        if (hipGetDevice(&dev) != hipSuccess || hipDeviceGetAttribute(&cus, hipDeviceAttributeMultiprocessorCount, dev) != hipSuccess) { fprintf(stderr, "kernel_launch: hipGetDevice / hipDeviceGetAttribute failed; nothing launched\n"); grid = -1; return; }
        if (hipFuncSetAttribute((const void*)mk_fwd, hipFuncAttributeMaxDynamicSharedMemorySize, LDS_BYTES) != hipSuccess) { fprintf(stderr, "kernel_launch: hipFuncSetAttribute failed; nothing launched\n"); grid = -1; return; }
        if (hipOccupancyMaxActiveBlocksPerMultiprocessor(&per_cu, (const void*)mk_fwd, NWAVES * 64, LDS_BYTES) != hipSuccess || per_cu < 1)
            fprintf(stderr, "kernel_launch: note: the occupancy query reports %d workgroups per CU\n", per_cu);
        (void)hipGetLastError();
        grid = cus;
    }
    if (grid < 0) return;
    if (hipMemsetAsync((char*)d_ws + WS_CTL, 0, CTL_ZERO_BYTES, stream) != hipSuccess) { fprintf(stderr, "kernel_launch: hipMemsetAsync of the control words failed; nothing launched\n"); return; }
    Args a{};
    for (int i = 0; i < 17; ++i) a.in[i] = (const float*)d_in[i];
    a.out = (float*)d_out; a.ws = (unsigned char*)d_ws; a.ws_size = ws_size & ~(size_t)(MiB - 1);
    static_assert(((N_LAUNCHES >= 1 && N_LAUNCHES <= 3) || N_LAUNCHES == PER_PHASE) && (CW_BAR + 3 * XCD_BAR_WORDS) * 4 <= (int)CTL_ZERO_BYTES, "-DMK_N_LAUNCHES must be 1, 2, 3 or 6");
    const int cuts3[4] = {0, N_LAUNCHES == 3 ? 1 : (N_LAUNCHES == 2 ? 4 : PER_PHASE), N_LAUNCHES == 3 ? 4 : PER_PHASE, PER_PHASE};
    for (int li = 0; li < N_LAUNCHES; ++li) {
        a.ph_lo = (N_LAUNCHES == PER_PHASE) ? li : cuts3[li]; a.ph_hi = (N_LAUNCHES == PER_PHASE) ? li + 1 : cuts3[li + 1]; a.li = li;
        hipLaunchKernelGGL(mk_fwd, dim3(grid), dim3(NWAVES * 64), LDS_BYTES, stream, a);
        const hipError_t le = hipPeekAtLastError();
        if (le != hipSuccess) { fprintf(stderr, "kernel_launch: launch %d failed: %s (grid %d x %d threads, %d B LDS)\n", li, hipGetErrorName(le), grid, NWAVES * 64, LDS_BYTES); break; }
    }
}
```

```cpp
#include <hip/hip_runtime.h>
#include <cstdio>
#include <cstdint>
namespace pg8 {
#define PG8_LAS __attribute__((address_space(3)))
typedef unsigned short bf16_t;
typedef short bf16x8 __attribute__((ext_vector_type(8)));
typedef float f32x4 __attribute__((ext_vector_type(4)));
typedef unsigned u32x4 __attribute__((ext_vector_type(4)));
constexpr int BM = 256, BK = 64, HALF = 128, HTB = HALF * BK * 2  , STAGE_BYTES = 8 * HTB, NXCD = 8, WGM = 8;

__host__ __device__ __forceinline__ int lds_byte(int r, int c) { const int st = (r >> 4) * 2 + (c >> 5), rr = r & 15, cc = c & 31, ob = rr * 64 + cc * 2; return st * 1024 + (ob ^ (((ob >> 9) & 1) << 5)); }
__host__ __device__ __forceinline__ int img_off(int r, int c) { return ((r >> 7) * HTB + lds_byte(r & 127, c)) >> 1; }
__host__ __device__ __forceinline__ void stage_rc(int b, int& R, int& C) { const int st = b / 1024, sb = b % 1024, swz = sb ^ (((sb >> 9) & 1) << 5); R = (st >> 1) * 16 + swz / 64; C = (st & 1) * 32 + (swz % 64) / 2; }
__host__ __device__ __forceinline__ int inv_perm32(int x) { return 16 * ((x >> 2) & 1) + 4 * (x >> 3) + (x & 3); }
__host__ __device__ __forceinline__ int perm32(int rho) { const int n = rho >> 4, i = rho & 15; return 8 * (i >> 2) + 4 * n + (i & 3); }

struct Unit { int pm, pn, hb, hm; };
struct Gemm { const bf16_t* A; const bf16_t* Bt; int M, N, K; };

struct StaticOrder {
    int nM, nN, nwg, G, c, lo, hi, rev, wgm, pm0;
    __host__ __device__ void init(int M, int N, int G_, int c_) { nM = M / BM; nN = N / BM; nwg = nM * nN; G = G_; c = c_; lo = 0; hi = nwg; rev = 0; wgm = WGM; pm0 = 0; }
    __host__ __device__ bool next(int i, Unit& u) const {
        const long L = (long)lo + (long)i * G + c; if (L >= hi) return false;
        int wgid = (int)L; { const int q = nwg / NXCD, r = nwg % NXCD, xcd = wgid % NXCD, off = wgid / NXCD; wgid = (xcd < r ? xcd * (q + 1) : r * (q + 1) + (xcd - r) * q) + off; }
        const int nig = wgm * nN, gid = wgid / nig, fm = gid * wgm, gsz = (nM - fm) < wgm ? (nM - fm) : wgm;
        u.pm = fm + ((wgid % nig) % gsz); u.pn = (wgid % nig) / gsz; u.hb = 0; u.hm = 0; if (rev) u.pm = nM - 1 - u.pm; u.pm += pm0; return true;
    }
    __host__ __device__ void tile_of(int L, Unit& u) const { StaticOrder t = *this; t.lo = L; t.hi = L + 1; t.c = 0; (void)t.next(0, u); }
    __device__ __forceinline__ void a_ready(const Unit&) const {}
    __device__ __forceinline__ void done(const Unit&) const {}
};
struct EarlyOrder : StaticOrder {
    int elo, ehi, lpm, lpn, nearly; unsigned* cnt;
    __device__ __forceinline__ void scan() { Unit u; lpm = -1; lpn = -1; nearly = 0; for (int i = 0; StaticOrder::next(i, u); ++i) if (u.pm >= elo && u.pm < ehi) { lpm = u.pm; lpn = u.pn; ++nearly; } }
    __device__ __forceinline__ void done(const Unit& u) const {
        if (u.pm == lpm && u.pn == lpn) {
            asm volatile("s_waitcnt vmcnt(0)" ::: "memory");
            if ((threadIdx.x & 63) == 0) (void)__hip_atomic_fetch_add(cnt, (unsigned)nearly, __ATOMIC_RELAXED, __HIP_MEMORY_SCOPE_AGENT);
        }
    }
};
struct OneUnitOrder {
    int pm, pn, valid;
    __host__ __device__ bool next(int i, Unit& u) const { if (i > 0 || !valid) return false; u.pm = pm; u.pn = pn; u.hb = 0; u.hm = 0; return true; }
    __device__ __forceinline__ void a_ready(const Unit&) const {}
    __device__ __forceinline__ void done(const Unit&) const {}
};
struct BalancedFullOrder : StaticOrder {
    __host__ __device__ bool next(int i, Unit& u) const {
        if (G != 256 || nwg != 1320) return StaticOrder::next(i, u);
        int L; if (i < 4) L = i * G + c; else if (i == 4 && c < 208) L = 4 * G + c; else if (i == 5 && c < 88) L = 4 * G + 208 + c; else return false;
        StaticOrder t = *this; t.lo = L; t.hi = L + 1; t.c = 0; return t.StaticOrder::next(0, u);
    }
};
struct BalancedHalfOrder {
    int pn, hb, c, G, nM, busy;
    __host__ __device__ bool next(int i, Unit& u) const { int j;
        if (G != 256 || nM != 264) { if (c < busy) return false; j = (c - busy) + (G - busy) * i; if (j >= nM) return false; u.pm = j; u.pn = pn; u.hb = hb; u.hm = 0; return true; }
        if (c < 88) return false; if (c < 208) { if (i > 0) return false; j = c - 88; } else { if (i > 2) return false; j = 120 + 3 * (c - 208) + i; }
        u.pm = j; u.pn = pn; u.hb = hb; u.hm = 0; return true; }
    __device__ __forceinline__ void a_ready(const Unit&) const {}
    __device__ __forceinline__ void done(const Unit&) const {}
};
struct TailHalfOrder {
    StaticOrder S; int lo, c;
    __host__ __device__ bool next(int i, Unit& u) const { if (i > 0) return false; const int L = lo + (c >> 1); if (L >= S.nwg) return false; S.tile_of(L, u); u.hb = c & 1; return true; }
    __device__ __forceinline__ void a_ready(const Unit&) const {}
    __device__ __forceinline__ void done(const Unit&) const {}
};
struct TailQuarterOrder {
    StaticOrder S; int lo, c;
    __host__ __device__ bool next(int i, Unit& u) const { if (i > 0) return false; const int L = lo + (c >> 2); if (L >= S.nwg) return false; S.tile_of(L, u); u.hb = c & 1; u.hm = (c >> 1) & 1; return true; }
    __device__ __forceinline__ void a_ready(const Unit&) const {}
    __device__ __forceinline__ void done(const Unit&) const {}
};
typedef float f32x2 __attribute__((ext_vector_type(2))); typedef __bf16 bf16x2_t __attribute__((ext_vector_type(2)));
__device__ __forceinline__ unsigned cvt_pk_bf16(float lo, float hi) { f32x2 v = {lo, hi}; bf16x2_t b = __builtin_convertvector(v, bf16x2_t); return __builtin_bit_cast(unsigned, b); }
typedef unsigned u32x2 __attribute__((ext_vector_type(2)));
constexpr float LOG2E = 1.4426950408889634f;
constexpr float C2 = 0.125f * LOG2E;
constexpr float EPS = 1e-6f;
constexpr int HALF_COLS = 128;
constexpr int DM = 1024, ZP = 1408, FF = 2816;
constexpr int MP = 65536, MS = 2048, MT = MP + MS;
constexpr size_t O_POOL_P = 69206016, O_K_P = 69328896, O_V_P = 70115328, O_POOL_S = 70901760, O_K_S = 71024640, O_V_S = 71811072, O_END = 72597504;

__host__ __device__ __forceinline__ size_t zsub_off(int row, int c) { return ((size_t)(row >> 4) * 2 + (c >> 5)) * 512 + (row & 15) * 32 + (c & 31); }
__device__ __forceinline__ void acc_zero(f32x4 (&acc)[2][2][4][2]) {
#pragma unroll
    for (int a = 0; a < 2; ++a)
#pragma unroll
        for (int b = 0; b < 2; ++b)
#pragma unroll
            for (int m = 0; m < 4; ++m)
#pragma unroll
                for (int n = 0; n < 2; ++n) acc[a][b][m][n] = (f32x4){0.f, 0.f, 0.f, 0.f};
}
__device__ __forceinline__ float bf_lo(unsigned w) { return __uint_as_float(w << 16); }
__device__ __forceinline__ float bf_hi(unsigned w) { return __uint_as_float(w & 0xffff0000u); }
template <bool HN = false, bool HM = false, bool BLK = false>
__device__ __forceinline__ void acc_from_bf16(f32x4 (&acc)[2][2][4][2], const bf16_t* R, const Unit& u, int wr, int wc, int fr, int fq) {
    const int r0 = (HM ? u.hm * HALF : 0) + wr * 64 + fr, c0 = u.pn * BM + (HN ? u.hb * HALF_COLS : 0) + wc * 32 + 8 * fq;
    const bf16_t* rp = BLK ? R + (size_t)u.pm * (1024 / BK) * (BM * BK) : R + ((size_t)u.pm * BM + r0) * 1024 + c0;
#pragma unroll
    for (int ai = 0; ai < (HM ? 1 : 2); ++ai)
#pragma unroll
        for (int m = 0; m < 4; ++m)
#pragma unroll
            for (int bj = 0; bj < (HN ? 1 : 2); ++bj) { const int c = c0 + bj * HALF;
                const u32x4 w = BLK ? *(const u32x4*)(rp + (size_t)(c >> 6) * (BM * BK) + img_off(r0 + ai * HALF + m * 16, c & 63)) : *(const u32x4*)(rp + (size_t)(ai * HALF + m * 16) * 1024 + bj * HALF);
                acc[ai][bj][m][0] = (f32x4){bf_lo(w.x), bf_hi(w.x), bf_lo(w.y), bf_hi(w.y)}; acc[ai][bj][m][1] = (f32x4){bf_lo(w.z), bf_hi(w.z), bf_lo(w.w), bf_hi(w.w)}; }
}

struct EpiZ {
    static constexpr bool PERM = true, AFTER_DRAIN = false, INIT_LOADS = false; static constexpr int RELAX = 0, B_AUX = 0, A_BLK = 1;
    bf16_t* Z; const float* qn; const float* kn; float* out; const float* RX; PG8_LAS unsigned char* stage;
    struct Aux {};
    __device__ __forceinline__ void init(f32x4 (&acc)[2][2][4][2], const Unit&, int, int, int, int) const { acc_zero(acc); }
    __device__ __forceinline__ void aux_load(Aux&, const Unit& u, int wr, int wc, int fr, int fq) const {
        __builtin_amdgcn_global_load_lds((const unsigned*)(RX + (size_t)u.pm * BM + 4 * (fr + 16 * fq)), (PG8_LAS unsigned*)(stage + (wr * 4 + wc) * 1024), 16, 0, 0);
    }
    __device__ __forceinline__ void operator()(const f32x4 (&acc)[2][2][4][2], const Aux&, const Unit& u, int wr, int wc, int fr, int fq) const {
        const int zcol = u.pn * 256 + wc * 64;
        if (zcol >= ZP) return;
        const int kind = (zcol >= 256 && zcol < 1024) ? 1 : ((zcol >= 1024 && zcol < 1216) ? 2 : 0);
        f32x4 sc[2][2];
#pragma unroll
        for (int bj = 0; bj < 2; ++bj)
#pragma unroll
            for (int n = 0; n < 2; ++n) {
                if (kind == 1) sc[bj][n] = *(const f32x4*)(qn + 32 * bj + 8 * fq + 4 * n) * C2;
                else if (kind == 2) sc[bj][n] = *(const f32x4*)(kn + 32 * bj + 8 * fq + 4 * n);
                else sc[bj][n] = (f32x4){1.f, 1.f, 1.f, 1.f};
            }
        const bool samp = u.pm >= 256;
        const int cm = (!samp && (u.pm & 7) != 7) ? 0 : (zcol < 256 ? 1 : (zcol >= 1216 ? 3 : (zcol >= 1024 ? 2 : 0)));
        const int rowbase = u.pm * BM + wr * 64 + fr;
        const PG8_LAS float* sl = (const PG8_LAS float*)(stage + (wr * 4 + wc) * 1024) + wr * 64 + fr;
#pragma unroll
        for (int ai = 0; ai < 2; ++ai)
#pragma unroll
            for (int m = 0; m < 4; ++m) {
                const int row = rowbase + ai * HALF + m * 16;
                const float rx = sl[ai * HALF + m * 16];
                float rs = rx;
                if (kind) {
                    float ss = 0.f;
#pragma unroll
                    for (int bj = 0; bj < 2; ++bj)
#pragma unroll
                        for (int n = 0; n < 2; ++n) { const f32x4 x = acc[ai][bj][m][n]; ss += (x[0] * x[0] + x[1] * x[1]) + (x[2] * x[2] + x[3] * x[3]); }
                    ss += __shfl_xor(ss, 16); ss += __shfl_xor(ss, 32);
                    rs = rx / sqrtf(ss * (rx * rx) * (1.0f / 64.0f) + EPS);
                }
                f32x4 v[2][2];
#pragma unroll
                for (int bj = 0; bj < 2; ++bj)
#pragma unroll
                    for (int n = 0; n < 2; ++n) v[bj][n] = acc[ai][bj][m][n] * rs * sc[bj][n];
                bf16_t* zp = Z + (size_t)(zcol >> 6) * MT * 64 + zsub_off(row, 8 * fq);
#pragma unroll
                for (int bj = 0; bj < 2; ++bj) { u32x4 w; w.x = cvt_pk_bf16(v[bj][0][0], v[bj][0][1]); w.y = cvt_pk_bf16(v[bj][0][2], v[bj][0][3]); w.z = cvt_pk_bf16(v[bj][1][0], v[bj][1][1]); w.w = cvt_pk_bf16(v[bj][1][2], v[bj][1][3]);
                    *(u32x4*)(zp + 512 * bj) = w; }
                if (cm) {
                    int b, t, T; if (samp) { const int r2 = row - MP; b = r2 >> 6; t = r2 & 63; T = 64; } else { b = row >> 11; t = row & 2047; T = 2048; }
                    float* dst = nullptr;
                    if (cm == 1) { const int i = t - (T - 15); if (i >= 0) dst = out + (samp ? O_POOL_S : O_POOL_P) + ((size_t)(b * 15 + i) * 256 + zcol); }
                    else { const int i = samp ? 64 + t : t - (T - 128); if (i >= 0) dst = out + (cm == 2 ? (samp ? O_K_S : O_K_P) : (samp ? O_V_S : O_V_P)) + ((size_t)(b * 128 + i) * 192 + (zcol - (cm == 2 ? 1024 : 1216))); }
                    if (dst) {
#pragma unroll
                        for (int bj = 0; bj < 2; ++bj)
#pragma unroll
                            for (int n = 0; n < 2; ++n) *(f32x4*)(dst + 32 * bj + 8 * fq + 4 * n) = v[bj][n];
                    }
                }
            }
    }
};

struct EpiZv {
    static constexpr bool PERM = true, AFTER_DRAIN = false, INIT_LOADS = false; static constexpr int RELAX = 0, B_AUX = 0, A_BLK = 1;
    bf16_t* Z; float* out; const float* RX; PG8_LAS unsigned char* stage;
    struct Aux {};
    __device__ __forceinline__ void init(f32x4 (&acc)[2][2][4][2], const Unit&, int, int, int, int) const { acc_zero(acc); }
    __device__ __forceinline__ void aux_load(Aux&, const Unit& u, int wr, int wc, int fr, int fq) const {
        __builtin_amdgcn_global_load_lds((const unsigned*)(RX + (size_t)u.pm * BM + 4 * (fr + 16 * fq)), (PG8_LAS unsigned*)(stage + (wr * 4 + wc) * 1024), 16, 0, 0);
    }
    __device__ __forceinline__ void operator()(const f32x4 (&acc)[2][2][4][2], const Aux&, const Unit& u, int wr, int wc, int fr, int fq) const {
        const int zcol = 1280 + 32 * wc + 8 * fq;
        const bool samp = u.pm >= 256, cache = samp || (u.pm & 7) == 7;
        const int rowbase = u.pm * BM + wr * 64 + fr;
        const PG8_LAS float* sl = (const PG8_LAS float*)(stage + (wr * 4 + wc) * 1024) + wr * 64 + fr;
#pragma unroll
        for (int ai = 0; ai < 2; ++ai)
#pragma unroll
            for (int m = 0; m < 4; ++m) {
                const int row = rowbase + ai * HALF + m * 16;
                const float rx = sl[ai * HALF + m * 16];
                const f32x4 v0 = acc[ai][0][m][0] * rx, v1 = acc[ai][0][m][1] * rx;
                u32x4 w; w.x = cvt_pk_bf16(v0[0], v0[1]); w.y = cvt_pk_bf16(v0[2], v0[3]); w.z = cvt_pk_bf16(v1[0], v1[1]); w.w = cvt_pk_bf16(v1[2], v1[3]);
                *(u32x4*)(Z + (size_t)(zcol >> 6) * MT * 64 + zsub_off(row, zcol & 63)) = w;
                if (cache) {
                    int b, i; if (samp) { const int r2 = row - MP; b = r2 >> 6; i = 64 + (r2 & 63); } else { b = row >> 11; i = (row & 2047) - 1920; }
                    if (i >= 0) { float* dst = out + (samp ? O_V_S : O_V_P) + ((size_t)(b * 128 + i) * 192 + (zcol - 1216)); *(f32x4*)dst = v0; *(f32x4*)(dst + 4) = v1; }
                }
            }
    }
};

template <bool HN = false, bool HM = false> struct EpiH {
    static constexpr bool PERM = true, AFTER_DRAIN = false, INIT_LOADS = true; static constexpr int RELAX = 0, B_AUX = 0, A_BLK = 1;
    const bf16_t* XB; bf16_t* HB; float* SS; int wt_hi;
    struct Aux {};
    __device__ __forceinline__ void init(f32x4 (&acc)[2][2][4][2], const Unit& u, int wr, int wc, int fr, int fq) const { acc_from_bf16<HN, HM, true>(acc, XB, u, wr, wc, fr, fq); }
    __device__ __forceinline__ void aux_load(Aux&, const Unit&, int, int, int, int) const {}
    __device__ __forceinline__ void operator()(const f32x4 (&acc)[2][2][4][2], const Aux& a, const Unit& u, int wr, int wc, int fr, int fq) const { if (u.pm < wt_hi) run<true>(acc, a, u, wr, wc, fr, fq); else run<false>(acc, a, u, wr, wc, fr, fq); }
    template <bool WT> __device__ __forceinline__ void run(const f32x4 (&acc)[2][2][4][2], const Aux&, const Unit& u, int wr, int wc, int fr, int fq) const {
        const int col0 = u.pn * BM + (HN ? u.hb * HALF_COLS : 0) + wc * 32 + 8 * fq;
#pragma unroll
        for (int ai = 0; ai < (HM ? 1 : 2); ++ai) {
#pragma unroll
            for (int m = 0; m < 4; ++m) {
                const size_t grow = (size_t)u.pm * BM + (HM ? u.hm : ai) * HALF + wr * 64 + m * 16 + fr;
                float ss = 0.f;
#pragma unroll
                for (int bj = 0; bj < (HN ? 1 : 2); ++bj) { const f32x4 h0 = acc[ai][bj][m][0], h1 = acc[ai][bj][m][1];
                    ss += ((h0[0] * h0[0] + h0[1] * h0[1]) + (h0[2] * h0[2] + h0[3] * h0[3])) + ((h1[0] * h1[0] + h1[1] * h1[1]) + (h1[2] * h1[2] + h1[3] * h1[3]));
                    u32x4 w; w.x = cvt_pk_bf16(h0[0], h0[1]); w.y = cvt_pk_bf16(h0[2], h0[3]); w.z = cvt_pk_bf16(h1[0], h1[1]); w.w = cvt_pk_bf16(h1[2], h1[3]);
                    { const int c = col0 + bj * HALF; bf16_t* const dst = HB + ((size_t)u.pm * (DM / BK) + (c >> 6)) * (BM * BK) + img_off((int)(grow & 255), c & 63);
                      if constexpr (WT) asm volatile("global_store_dwordx4 %0, %1, off sc1\n\ts_nop 1" :: "v"(dst), "v"(w) : "memory");     else *(u32x4*)dst = w; } }
                ss += __shfl_xor(ss, 16); ss += __shfl_xor(ss, 32);
                if constexpr (WT) { if (fq == 0) (void)__hip_atomic_fetch_add(SS + grow, ss, __ATOMIC_RELAXED, __HIP_MEMORY_SCOPE_SYSTEM); }
                else if (fq == 0) atomicAdd(SS + grow, ss);
            }
        }
    }
};

struct EpiAct {
    static constexpr bool PERM = true, AFTER_DRAIN = false, INIT_LOADS = false; static constexpr int RELAX = 0, B_AUX = 0, A_BLK = 1;
    const float* SS; bf16_t* ACT; PG8_LAS unsigned char* stage;
    struct Aux {};
    __device__ __forceinline__ void init(f32x4 (&acc)[2][2][4][2], const Unit&, int, int, int, int) const { acc_zero(acc); }
    __device__ __forceinline__ void aux_load(Aux&, const Unit& u, int wr, int wc, int fr, int fq) const {
        __builtin_amdgcn_global_load_lds((const unsigned*)(SS + (size_t)u.pm * BM + 4 * (fr + 16 * fq)), (PG8_LAS unsigned*)(stage + (wr * 4 + wc) * 1024), 16, 0, 0);
    }
    __device__ __forceinline__ void operator()(const f32x4 (&acc)[2][2][4][2], const Aux&, const Unit& u, int wr, int wc, int fr, int fq) const {
        const int col0 = u.pn * HALF + wc * 32 + 8 * fq;
        const PG8_LAS float* sl = (const PG8_LAS float*)(stage + (wr * 4 + wc) * 1024) + wr * 64 + fr;
#pragma unroll
        for (int ai = 0; ai < 2; ++ai)
#pragma unroll
            for (int m = 0; m < 4; ++m) {
                const size_t grow = (size_t)u.pm * BM + ai * HALF + wr * 64 + m * 16 + fr;
                const float r2 = __builtin_amdgcn_rcpf(sl[ai * HALF + m * 16] * (1.0f / DM) + EPS), rs = __builtin_amdgcn_sqrtf(r2), c1 = -LOG2E * rs;
                float o[8];
#pragma unroll
                for (int n = 0; n < 2; ++n)
#pragma unroll
                    for (int e = 0; e < 4; ++e) { const float g = acc[ai][0][m][n][e], uu = acc[ai][1][m][n][e];
                        o[4 * n + e] = (g * uu) * (r2 * __builtin_amdgcn_rcpf(1.0f + __builtin_amdgcn_exp2f(c1 * g))); }
                u32x4 w; w.x = cvt_pk_bf16(o[0], o[1]); w.y = cvt_pk_bf16(o[2], o[3]); w.z = cvt_pk_bf16(o[4], o[5]); w.w = cvt_pk_bf16(o[6], o[7]);
                *(u32x4*)(ACT + ((size_t)u.pm * (FF / BK) + (col0 >> 6)) * (BM * BK) + img_off((int)(grow & 255), col0 & 63)) = w;
            }
    }
};

template <bool HN = false, bool HM = false> struct EpiY {
    static constexpr bool PERM = true, AFTER_DRAIN = false, INIT_LOADS = true; static constexpr int RELAX = 0, B_AUX = 0, A_BLK = 1;
    const bf16_t* HB; float* Y; PG8_LAS unsigned char* stage;
    struct Aux {};
    __device__ __forceinline__ void init(f32x4 (&acc)[2][2][4][2], const Unit& u, int wr, int wc, int fr, int fq) const { acc_from_bf16<HN, HM, true>(acc, HB, u, wr, wc, fr, fq); }
    __device__ __forceinline__ void aux_load(Aux&, const Unit&, int, int, int, int) const {}
    __device__ __forceinline__ void operator()(const f32x4 (&acc)[2][2][4][2], const Aux&, const Unit& u, int wr, int wc, int fr, int fq) const {
        const int lane = fr + 16 * fq; PG8_LAS unsigned char* st = stage + (wr * 4 + wc) * 2048;
#pragma unroll
        for (int ai = 0; ai < (HM ? 1 : 2); ++ai) {
#pragma unroll
            for (int m = 0; m < 4; ++m) {
                float* tp = Y + ((size_t)u.pm * BM + (HM ? u.hm : ai) * HALF + wr * 64 + m * 16 + (lane >> 3)) * DM + u.pn * BM + (HN ? u.hb * HALF_COLS : 0) + wc * 32 + 4 * (lane & 7);
#pragma unroll
                for (int bj = 0; bj < (HN ? 1 : 2); ++bj) {
                    *(PG8_LAS f32x4*)(st + fr * 128 + (((2 * fq) ^ (fr & 7)) << 4)) = acc[ai][bj][m][0]; *(PG8_LAS f32x4*)(st + fr * 128 + (((2 * fq + 1) ^ (fr & 7)) << 4)) = acc[ai][bj][m][1];
                    asm volatile("s_waitcnt lgkmcnt(0)" ::: "memory");
#pragma unroll
                    for (int ps = 0; ps < 2; ++ps) { const int r = 8 * ps + (lane >> 3); const f32x4 v = *(const PG8_LAS f32x4*)(st + r * 128 + (((lane & 7) ^ (r & 7)) << 4)); *(f32x4*)(tp + (size_t)(8 * ps) * DM + bj * HALF) = v; }
                    asm volatile("s_waitcnt lgkmcnt(0)" ::: "memory");
                }
            }
        }
    }
};

template <class Epi, class Sched, bool ALIGN_EPI = false, bool SP2 = false, bool HALF_N = false>
__device__ __forceinline__ void gemm_phase(PG8_LAS unsigned char* lds, const Gemm g, const Sched& S, const Epi& E) {
    const int tid = threadIdx.x, wid = __builtin_amdgcn_readfirstlane(tid >> 6), lane = tid & 63, wr = wid >> 2, wc = wid & 3, fr = lane & 15, fq = lane >> 4;
    static_assert(SP2 || !HALF_N, "HALF_N needs the SP2 loop");
    const int K = g.K, nt = K / BK;
    unsigned voffA[2], voffB[2];
#pragma unroll
    for (int i = 0; i < 2; ++i) { int R, C; stage_rc(tid * 16 + i * 8192, R, C); const int Rb = Epi::PERM ? ((R & ~31) + perm32(R & 31)) : R;
        voffA[i] = Epi::A_BLK ? (unsigned)(tid * 16 + i * 8192) : (unsigned)(R * K + C) * 2u; voffB[i] = (unsigned)(tid * 16 + i * 8192); (void)Rb; }
    const size_t kstep = (size_t)(BK * 2);
    const size_t hstep = (size_t)HALF * K * 2;
    const size_t tstep = 2 * hstep;
    const size_t kstepA = Epi::A_BLK ? (size_t)BM * BK * 2 : kstep, hstepA = Epi::A_BLK ? (size_t)HALF * BK * 2 : hstep;
    const size_t kstepB = (size_t)BM * BK * 2, hstepB = (size_t)HALF * BK * 2;
    const unsigned ldsw = (unsigned)wid * 1024u;
    const int aoff = lds_byte(wr * 64 + fr, fq * 8), boff = lds_byte(wc * 32 + fr, fq * 8);
#define PG8_SA(b, h) (((b) * 2 + (h)) * HTB)
#define PG8_SB(b, h) ((4 + (b) * 2 + (h)) * HTB)
#define PG8_STAGE(bufoff, gbase, voff) do { _Pragma("unroll") for (int _i = 0; _i < 2; ++_i) \
        __builtin_amdgcn_global_load_lds((const unsigned*)((const char*)(gbase) + (voff)[_i]), (PG8_LAS unsigned*)(lds + (bufoff) + ldsw + _i * 8192), 16, 0, 0); } while (0)
#define PG8_STAGEB(bufoff, gbase) do { _Pragma("unroll") for (int _i = 0; _i < 2; ++_i) \
        __builtin_amdgcn_global_load_lds((const unsigned*)((const char*)(gbase) + voffB[_i]), (PG8_LAS unsigned*)(lds + (bufoff) + ldsw + _i * 8192), 16, 0, Epi::B_AUX); } while (0)
#define PG8_LDA(dst, b, h) do { _Pragma("unroll") for (int m = 0; m < 4; ++m) _Pragma("unroll") for (int k = 0; k < 2; ++k) dst[m][k] = *(const PG8_LAS bf16x8*)(lds + PG8_SA(b, h) + aoff + m * 2048 + k * 1024); } while (0)
#define PG8_LDB(dst, b, h) do { _Pragma("unroll") for (int n = 0; n < 2; ++n) _Pragma("unroll") for (int k = 0; k < 2; ++k) dst[n][k] = *(const PG8_LAS bf16x8*)(lds + PG8_SB(b, h) + boff + n * 2048 + k * 1024); } while (0)
#define PG8_MMA(ai, bj, At, Bt) do { __builtin_amdgcn_s_setprio(1); _Pragma("unroll") for (int m = 0; m < 4; ++m) _Pragma("unroll") for (int n = 0; n < 2; ++n) _Pragma("unroll") for (int k = 0; k < 2; ++k) \
        acc[ai][bj][m][n] = __builtin_amdgcn_mfma_f32_16x16x32_bf16(Bt[n][k], At[m][k], acc[ai][bj][m][n], 0, 0, 0); __builtin_amdgcn_s_setprio(0); } while (0)
#define PG8_WAIT_V(n) asm volatile("s_waitcnt vmcnt(" #n ")" ::: "memory")
#define PG8_WAIT_VK do { if constexpr (HALF_N) asm volatile("s_waitcnt vmcnt(6)" ::: "memory"); else asm volatile("s_waitcnt vmcnt(8)" ::: "memory"); } while (0)
#define PG8_STAGE_B1(bufoff, gbase) do { if constexpr (!HALF_N) PG8_STAGEB(bufoff, gbase); } while (0)
#define PG8_LDB1(dst, b) do { if constexpr (!HALF_N) PG8_LDB(dst, b, 1); } while (0)
#define PG8_MMA1(ai, At, Bt) do { if constexpr (!HALF_N) PG8_MMA(ai, 1, At, Bt); } while (0)
#define PG8_WAIT_V1 do { if (!HALF_N && Epi::RELAX == 9 && rl) asm volatile("s_waitcnt vmcnt(17)" ::: "memory"); else PG8_WAIT_VK; } while (0)
#define PG8_WAIT_L(n) asm volatile("s_waitcnt lgkmcnt(" #n ")" ::: "memory")
#define PG8_BAR __builtin_amdgcn_s_barrier()
#define PG8_SCHED __builtin_amdgcn_sched_barrier(0)
    Unit cur, nxt; int ui = 0;
    if (!S.next(0, cur)) return;
    f32x4 acc[2][2][4][2];
    typename Epi::Aux aux;
    E.init(acc, cur, wr, wc, fr, fq);
    bf16x8 At[4][2], B0[2][2], B1[2][2];
    const char* cA = (const char*)g.A + (size_t)cur.pm * tstep; const char* cB = (const char*)g.Bt + (size_t)cur.pn * tstep + (HALF_N ? (size_t)cur.hb * hstepB : (size_t)0);
    S.a_ready(cur);
    if constexpr (SP2) {
        PG8_STAGEB(PG8_SB(0, 0), cB); PG8_STAGE_B1(PG8_SB(0, 1), cB + hstepB); PG8_STAGE(PG8_SA(0, 0), cA, voffA); PG8_STAGE(PG8_SA(0, 1), cA + hstepA, voffA);
        if (wr == 1) PG8_BAR;
        PG8_WAIT_V(2); PG8_BAR;
        PG8_STAGEB(PG8_SB(1, 0), cB + kstepB); PG8_STAGE(PG8_SA(1, 0), cA + kstepA, voffA); PG8_STAGE_B1(PG8_SB(1, 1), cB + hstepB + kstepB);
        if constexpr (HALF_N) PG8_WAIT_V(4); else PG8_WAIT_V(6);
        PG8_BAR;
    } else {
        PG8_STAGEB(PG8_SB(0, 0), cB); PG8_STAGE(PG8_SA(0, 0), cA, voffA); PG8_STAGEB(PG8_SB(0, 1), cB + hstepB); PG8_STAGE(PG8_SA(0, 1), cA + hstepA, voffA);
        if (wr == 1) PG8_BAR;
        PG8_WAIT_V(4); PG8_BAR;
        PG8_STAGEB(PG8_SB(1, 0), cB + kstepB); PG8_STAGE(PG8_SA(1, 0), cA + kstepA, voffA); PG8_STAGEB(PG8_SB(1, 1), cB + hstepB + kstepB);
        PG8_WAIT_V(6); PG8_BAR;
    }
    for (;;) {
        if constexpr (Epi::INIT_LOADS) {
#pragma unroll
            for (int a = 0; a < 2; ++a)
#pragma unroll
                for (int b = 0; b < (HALF_N ? 1 : 2); ++b)
#pragma unroll
                    for (int m = 0; m < 4; ++m) asm volatile("" : "+v"(acc[a][b][m][0]), "+v"(acc[a][b][m][1]));
        }
        E.aux_load(aux, cur, wr, wc, fr, fq);
        const bool has_next = S.next(ui + 1, nxt);
        const char* nA = has_next ? (const char*)g.A + (size_t)nxt.pm * tstep : cA; const char* nB = has_next ? (const char*)g.Bt + (size_t)nxt.pn * tstep + (HALF_N ? (size_t)nxt.hb * hstepB : (size_t)0) : cB;
        for (int t = 0; t < nt; t += 2) {
            const bool last = (t == nt - 2);
            const char* a1 = cA + (size_t)(t + 1) * kstepA;
            const char* a2 = last ? nA : cA + (size_t)(t + 2) * kstepA; const char* b2 = last ? nB : cB + (size_t)(t + 2) * kstepB;
            const char* a3 = a2 + kstepA; const char* b3 = b2 + kstepB;
            if (last && has_next) S.a_ready(nxt);
            int rl = __builtin_amdgcn_readfirstlane((int)((t == 0) & (ui > 0))); asm volatile("" : "+s"(rl));
            if constexpr (SP2) {
            PG8_LDB(B0, 0, 0); PG8_LDB1(B1, 0); PG8_SCHED; PG8_LDA(At, 0, 0); PG8_STAGE(PG8_SA(1, 1), a1 + hstepA, voffA);
            PG8_WAIT_V1; PG8_WAIT_L(0); PG8_BAR; PG8_MMA(0, 0, At, B0); PG8_MMA1(0, At, B1); PG8_BAR; PG8_SCHED;
            PG8_LDA(At, 0, 1); PG8_STAGEB(PG8_SB(0, 0), b2); PG8_STAGE_B1(PG8_SB(0, 1), b2 + hstepB); PG8_STAGE(PG8_SA(0, 0), a2, voffA);
            PG8_WAIT_V1; PG8_WAIT_L(0); PG8_BAR; PG8_MMA(1, 0, At, B0); PG8_MMA1(1, At, B1); PG8_BAR; PG8_SCHED;
            PG8_LDB(B0, 1, 0); PG8_LDB1(B1, 1); PG8_SCHED; PG8_LDA(At, 1, 0); PG8_STAGE(PG8_SA(0, 1), a2 + hstepA, voffA);
            PG8_WAIT_VK; PG8_WAIT_L(0); PG8_BAR; PG8_MMA(0, 0, At, B0); PG8_MMA1(0, At, B1); PG8_BAR; PG8_SCHED;
            PG8_LDA(At, 1, 1); PG8_STAGEB(PG8_SB(1, 0), b3); PG8_STAGE_B1(PG8_SB(1, 1), b3 + hstepB); PG8_STAGE(PG8_SA(1, 0), a3, voffA);
            PG8_WAIT_VK; PG8_WAIT_L(0); PG8_BAR; PG8_MMA(1, 0, At, B0); PG8_MMA1(1, At, B1); PG8_BAR; PG8_SCHED;
            } else {
            PG8_LDB(B0, 0, 0); PG8_SCHED; PG8_LDA(At, 0, 0); PG8_STAGE(PG8_SA(1, 1), a1 + hstepA, voffA);
            PG8_WAIT_L(8); PG8_BAR; PG8_WAIT_L(0); PG8_MMA(0, 0, At, B0); PG8_BAR; PG8_SCHED;
            PG8_LDB(B1, 0, 1); PG8_STAGEB(PG8_SB(0, 0), b2);
            PG8_BAR; PG8_WAIT_L(0); PG8_MMA(0, 1, At, B1); PG8_BAR;
            PG8_LDA(At, 0, 1); PG8_STAGE(PG8_SA(0, 0), a2, voffA);
            PG8_BAR; PG8_WAIT_L(0); PG8_MMA(1, 0, At, B0); PG8_BAR; PG8_SCHED;
            PG8_STAGEB(PG8_SB(0, 1), b2 + hstepB);
            PG8_WAIT_V(6); PG8_BAR; PG8_MMA(1, 1, At, B1); PG8_BAR;
            PG8_LDB(B0, 1, 0); PG8_SCHED; PG8_LDA(At, 1, 0); PG8_STAGE(PG8_SA(0, 1), a2 + hstepA, voffA);
            PG8_WAIT_L(8); PG8_BAR; PG8_WAIT_L(0); PG8_MMA(0, 0, At, B0); PG8_BAR; PG8_SCHED;
            PG8_LDB(B1, 1, 1); PG8_STAGEB(PG8_SB(1, 0), b3);
            PG8_BAR; PG8_WAIT_L(0); PG8_MMA(0, 1, At, B1); PG8_BAR;
            PG8_LDA(At, 1, 1); PG8_STAGE(PG8_SA(1, 0), a3, voffA);
            PG8_BAR; PG8_WAIT_L(0); PG8_MMA(1, 0, At, B0); PG8_BAR; PG8_SCHED;
            PG8_STAGEB(PG8_SB(1, 1), b3 + hstepB);
            PG8_WAIT_V(6); PG8_BAR; PG8_MMA(1, 1, At, B1); PG8_BAR;
            }
        }
        if constexpr (ALIGN_EPI) { if (wr == 0) PG8_BAR; }
        if constexpr (!Epi::AFTER_DRAIN) { E(acc, aux, cur, wr, wc, fr, fq); S.done(cur); }
        if (!has_next) break;
        E.init(acc, nxt, wr, wc, fr, fq);
        cur = nxt; cA = nA; cB = nB; ++ui;
        if constexpr (ALIGN_EPI) { if (wr == 1) PG8_BAR; }
    }
    PG8_WAIT_V(0);
    if constexpr (!ALIGN_EPI) { if (wr == 0) PG8_BAR; }
    PG8_BAR;
    if constexpr (Epi::AFTER_DRAIN) { E.fused(acc, cur, wr, wc, fr, fq, lds, wid, lane); S.done(cur); }
}
template <class Epi, class Sched>
__device__ __forceinline__ void gemm_phase_q(PG8_LAS unsigned char* lds, const Gemm g, const Sched& S, const Epi& E) {
    const int tid = threadIdx.x, wid = __builtin_amdgcn_readfirstlane(tid >> 6), lane = tid & 63, wr = wid >> 2, wc = wid & 3, fr = lane & 15, fq = lane >> 4;
    const int K = g.K, nt = K / BK;
    unsigned voffA[2], voffB[2];
#pragma unroll
    for (int i = 0; i < 2; ++i) { int R, C; stage_rc(tid * 16 + i * 8192, R, C); const int Rb = Epi::PERM ? ((R & ~31) + perm32(R & 31)) : R;
        voffA[i] = (unsigned)(R * K + C) * 2u; voffB[i] = (unsigned)(Rb * K + C) * 2u; }
    const size_t kstep = (size_t)(BK * 2), hstep = (size_t)HALF * K * 2, tstep = 2 * hstep;
    const unsigned ldsw = (unsigned)wid * 1024u;
    const int aoff = lds_byte(wr * 64 + fr, fq * 8), boff = lds_byte(wc * 32 + fr, fq * 8);
    Unit cur;
    if (!S.next(0, cur)) return;
    f32x4 acc[2][2][4][2];
    typename Epi::Aux aux;
    E.init(acc, cur, wr, wc, fr, fq);
    bf16x8 At[4][2], B0[2][2];
    const char* cA = (const char*)g.A + (size_t)cur.pm * tstep + (size_t)cur.hm * hstep; const char* cB = (const char*)g.Bt + (size_t)cur.pn * tstep + (size_t)cur.hb * hstep;
    S.a_ready(cur);
    PG8_STAGEB(PG8_SB(0, 0), cB); PG8_STAGE(PG8_SA(0, 0), cA, voffA);
    PG8_STAGEB(PG8_SB(0, 1), cB + kstep); PG8_STAGE(PG8_SA(0, 1), cA + kstep, voffA);
    PG8_STAGEB(PG8_SB(1, 0), cB + 2 * kstep); PG8_STAGE(PG8_SA(1, 0), cA + 2 * kstep, voffA);
    if (wr == 1) PG8_BAR;
    PG8_WAIT_V(8); PG8_BAR;
    PG8_BAR;
    if constexpr (Epi::INIT_LOADS) {
#pragma unroll
        for (int m = 0; m < 4; ++m) asm volatile("" : "+v"(acc[0][0][m][0]), "+v"(acc[0][0][m][1]));
    }
    E.aux_load(aux, cur, wr, wc, fr, fq);
#define PG8_SPQ(s, kt) do { const int _k = (kt) < nt ? (kt) : (kt) - nt; \
        PG8_LDB(B0, (s) >> 1, (s) & 1); PG8_SCHED; PG8_LDA(At, (s) >> 1, (s) & 1); \
        PG8_STAGE(PG8_SB((((s) + 3) & 3) >> 1, ((s) + 3) & 1), cB + (size_t)_k * kstep, voffB); PG8_STAGE(PG8_SA((((s) + 3) & 3) >> 1, ((s) + 3) & 1), cA + (size_t)_k * kstep, voffA); \
        PG8_WAIT_V(8); PG8_WAIT_L(0); PG8_BAR; PG8_MMA(0, 0, At, B0); PG8_BAR; PG8_SCHED; } while (0)
    for (int t = 0; t < nt; t += 4) { PG8_SPQ(0, t + 3); PG8_SPQ(1, t + 4); PG8_SPQ(2, t + 5); PG8_SPQ(3, t + 6); }
#undef PG8_SPQ
    if (wr == 0) PG8_BAR;
    E(acc, aux, cur, wr, wc, fr, fq); S.done(cur);
    PG8_WAIT_V(0);
    PG8_BAR;
#undef PG8_SA
#undef PG8_SB
#undef PG8_STAGE
#undef PG8_STAGEB
#undef PG8_LDA
#undef PG8_LDB
#undef PG8_MMA
#undef PG8_WAIT_V
#undef PG8_WAIT_V1
#undef PG8_WAIT_VK
#undef PG8_STAGE_B1
#undef PG8_LDB1
#undef PG8_MMA1
#undef PG8_WAIT_L
#undef PG8_BAR
#undef PG8_SCHED
}
}
#ifndef PG8_SP2
#define PG8_SP2 true
#endif
#ifndef PG8_ALIGN
#define PG8_ALIGN true
#endif
namespace mixp {
using pg8::bf16_t; using pg8::bf16x8; using pg8::u32x4; using pg8::u32x2; using pg8::ZP; using pg8::MP; using pg8::MT; using pg8::LOG2E;
typedef float f32x16 __attribute__((ext_vector_type(16)));
typedef short v4i16_t __attribute__((ext_vector_type(4)));
#define MX_LAS __attribute__((address_space(3)))
typedef MX_LAS unsigned char* lptr;
constexpr int KR_OFF = 0, VR_OFF = 49152, OST_OFF = 98304;
constexpr int N_ATT_P = 32 * 3 * 32, N_ATT = N_ATT_P + 32 * 3, N_POOL_P = 32 * 32, N_UNITS = N_ATT + N_POOL_P + 32;
typedef float f32x2_t __attribute__((ext_vector_type(2))); typedef __bf16 bf16x2_t __attribute__((ext_vector_type(2)));
__device__ __forceinline__ unsigned pk_bf16(float lo, float hi) { f32x2_t v = {lo, hi}; bf16x2_t b = __builtin_convertvector(v, bf16x2_t); return __builtin_bit_cast(unsigned, b); }
__device__ __forceinline__ float bf_lo(unsigned w) { return __uint_as_float(w << 16); }
__device__ __forceinline__ float bf_hi(unsigned w) { return __uint_as_float(w & 0xffff0000u); }
__device__ __forceinline__ v4i16_t vtr(lptr p) { return __builtin_amdgcn_ds_read_tr16_b64_v4i16((MX_LAS v4i16_t*)p); }

struct AUnit { bool samp; int b, c, kvh, row0; };
__device__ __forceinline__ AUnit pool_decode(int j) { AUnit u; u.samp = j >= N_POOL_P; u.b = u.samp ? j - N_POOL_P : j >> 5; u.c = u.samp ? 0 : (j & 31); u.kvh = 0; u.row0 = u.samp ? MP + u.b * 64 : u.b * 2048 + 64 * u.c; return u; }
__device__ __forceinline__ void glds16(const void* gsrc, unsigned lds_dst) { unsigned keep;
    asm volatile("s_mov_b32 %0, m0\n\ts_mov_b32 m0, %2\n\ts_nop 0\n\tglobal_load_lds_dwordx4 %1, off\n\ts_mov_b32 m0, %0" : "=&s"(keep) : "v"(gsrc), "s"(lds_dst) : "memory"); }
#define MX_GLDS(src, dst) glds16((src), (unsigned)__builtin_amdgcn_readfirstlane((int)(unsigned)(uintptr_t)(dst)))

__device__ __forceinline__ void attn_issue_chunk(lptr ring, int slot, int j, const bf16_t* Z, const bf16_t* CK, const bf16_t* CV, const AUnit& u, int wid, int lane) {
    const int kkey = 8 * wid + (lane >> 3), kch = (lane & 7) ^ ((lane >> 3) & 7);
    const int vdh = wid >> 2, vkey = 16 * (wid & 3) + (lane >> 2), vch = 4 * vdh + (lane & 3);
    const bf16_t *ks, *vs;
    if (u.samp && j < 2) { const size_t o = (size_t)(u.b * 128 + 64 * j) * 192 + 64 * u.kvh; ks = CK + o + (size_t)kkey * 192 + 8 * kch; vs = CV + o + (size_t)vkey * 192 + 8 * vch; }
    else { const bool valid = u.samp || (u.c - 2 + j >= 0); const int rb = valid ? u.row0 - 128 + 64 * j : u.row0;
        ks = Z + (size_t)(16 + u.kvh) * MT * 64 + pg8::zsub_off(rb + kkey, 8 * kch); vs = Z + (size_t)(19 + u.kvh) * MT * 64 + pg8::zsub_off(rb + vkey, 8 * vch); }
    MX_GLDS(ks, ring + KR_OFF + slot * 8192 + wid * 1024);
    MX_GLDS(vs, ring + VR_OFF + slot * 8192 + wid * 1024);
}
__device__ __forceinline__ void attn_qload(bf16x8 (&q)[4], const bf16_t* Z, const AUnit& u, int wid, int lane) {
    const bf16_t* qp = Z + (size_t)(4 + 4 * u.kvh + (wid >> 1)) * MT * 64 + pg8::zsub_off(u.row0 + 32 * (wid & 1) + (lane & 31), 8 * (lane >> 5));
#pragma unroll
    for (int ks = 0; ks < 4; ++ks) q[ks] = __builtin_nontemporal_load((const bf16x8*)(qp + 512 * (ks >> 1) + 16 * (ks & 1)));
}
__device__ __forceinline__ void attn_compute(lptr ring, int sl0, int sl1, int sl2, const bf16x8 (&qr)[4], bf16_t* MIX, float sink2, const AUnit& u, int wid, int lane) {
    const int slb[3] = {sl0 * 8192, sl1 * 8192, sl2 * 8192};
    const int r32 = lane & 31, hi = lane >> 5, g = wid >> 1, qh = wid & 1, hq = 4 * u.kvh + g;
    const float slope2 = __builtin_amdgcn_exp2f(-8.0f * (float)(hq + 1) * (1.0f / 12.0f)) * LOG2E;
    const float qb = (float)(32 * qh + r32 + 128 - 4 * hi);
    const float nsq = -slope2 * qb;
    f32x16 p[6];
#pragma unroll
    for (int kb = 0; kb < 6; ++kb) {
        const bool valid = u.samp || (u.c - 2 + (kb >> 1) >= 0);
#pragma unroll
        for (int r = 0; r < 16; ++r) { const float cst = (float)(32 * kb + (r & 3) + 8 * (r >> 2));
            const float bias = kb < 4 ? __builtin_fmaf(slope2, cst, nsq) : -slope2 * __builtin_fabsf(qb - cst);
            p[kb][r] = valid ? bias : -1e30f; }
#pragma unroll
        for (int ks = 0; ks < 4; ++ks) {
            const bf16x8 kf = *(const MX_LAS bf16x8*)(ring + KR_OFF + slb[kb >> 1] + (32 * (kb & 1) + r32) * 128 + (((2 * ks + hi) ^ (r32 & 7)) << 4));
            p[kb] = __builtin_amdgcn_mfma_f32_32x32x16_bf16(kf, qr[ks], p[kb], 0, 0, 0);
        }
    }
    float sum = 0.f;
#pragma unroll
    for (int kb = 0; kb < 6; ++kb)
#pragma unroll
        for (int r = 0; r < 16; ++r) { p[kb][r] = __builtin_amdgcn_exp2f(p[kb][r]); sum += p[kb][r]; }
    sum += __shfl_xor(sum, 32);
    sum += __builtin_amdgcn_exp2f(sink2);
    const float inv = 1.0f / sum;
    f32x16 o[2];
#pragma unroll
    for (int r = 0; r < 16; ++r) { o[0][r] = 0.f; o[1][r] = 0.f; }
    const lptr vb = ring + VR_OFF + ((lane >> 4) & 1) * 32 + (lane & 3) * 8 + (4 * hi + ((lane & 15) >> 2)) * 64;
#pragma unroll
    for (int kb = 0; kb < 6; ++kb)
#pragma unroll
        for (int s = 0; s < 2; ++s) {
            u32x4 pw;
            pw.x = pk_bf16(p[kb][8 * s + 0], p[kb][8 * s + 1]); pw.y = pk_bf16(p[kb][8 * s + 2], p[kb][8 * s + 3]);
            pw.z = pk_bf16(p[kb][8 * s + 4], p[kb][8 * s + 5]); pw.w = pk_bf16(p[kb][8 * s + 6], p[kb][8 * s + 7]);
            const bf16x8 pf = __builtin_bit_cast(bf16x8, pw);
#pragma unroll
            for (int db = 0; db < 2; ++db) {
                const v4i16_t lo = vtr(vb + slb[kb >> 1] + db * 4096 + (32 * (kb & 1) + 16 * s) * 64), hh = vtr(vb + slb[kb >> 1] + db * 4096 + (32 * (kb & 1) + 16 * s + 8) * 64);
                const bf16x8 vf = (bf16x8){lo[0], lo[1], lo[2], lo[3], hh[0], hh[1], hh[2], hh[3]};
                o[db] = __builtin_amdgcn_mfma_f32_32x32x16_bf16(vf, pf, o[db], 0, 0, 0);
            }
        }
    const lptr st = ring + OST_OFF + wid * 4096;
#pragma unroll
    for (int db = 0; db < 2; ++db)
#pragma unroll
        for (int rg = 0; rg < 4; ++rg) { u32x2 w; w.x = pk_bf16(o[db][4 * rg] * inv, o[db][4 * rg + 1] * inv); w.y = pk_bf16(o[db][4 * rg + 2] * inv, o[db][4 * rg + 3] * inv);
            *(MX_LAS u32x2*)(st + r32 * 128 + (((4 * db + rg) ^ (r32 & 7)) << 4) + 8 * hi) = w; }
    asm volatile("s_waitcnt lgkmcnt(0)" ::: "memory");
    bf16_t* op = MIX + ((size_t)(u.row0 >> 8) * 16 + 4 + hq) * (256 * 64);
#pragma unroll
    for (int i = 0; i < 4; ++i) { const int row = 8 * i + (lane >> 3); const u32x4 v = *(const MX_LAS u32x4*)(st + row * 128 + (((lane & 7) ^ (row & 7)) << 4)); *(u32x4*)(op + pg8::img_off((u.row0 & 255) + 32 * qh + row, 8 * (lane & 7))) = v; }
}

__device__ __forceinline__ void pool_issue(lptr buf, const bf16_t* Z, const bf16_t* CP, const bf16_t* ZERO, const AUnit& u, int wid, int lane) {
#pragma unroll
    for (int j = 0; j < 5; ++j) {
        const int p = wid + 8 * j, ri = 2 * p + (lane >> 5), rc = ri > 78 ? 78 : ri, ch = (lane & 31) ^ (ri & 15);
        const bf16_t* src = Z + (size_t)(ch >> 3) * MT * 64 + pg8::zsub_off(u.row0 + rc - 15, 8 * (ch & 7));
        if (ri < 15) { if (u.samp) src = CP + (size_t)(u.b * 15 + ri) * 256 + 8 * ch; else if (u.c == 0) src = ZERO + 8 * (lane & 31); }
        MX_GLDS(src, buf + p * 1024);
    }
}
__device__ __forceinline__ void pool_compute(lptr buf, const bf16x8 (&wf)[2][4], bf16_t* MIX, const AUnit& u, int wid, int lane) {
    const int r32 = lane & 31, hi = lane >> 5;
    const int g = wid >> 1, hh = wid & 1, W = 2 << g, t = 32 * hh + r32;
    const int pos = u.samp ? 4096 + t : 64 * u.c + t;
    const float icnt = 1.0f / (float)((pos + 1 < W) ? pos + 1 : W);
    bf16x8 df[4];
#pragma unroll
    for (int ks = 0; ks < 4; ++ks) {
        const int chunk = 8 * g + 2 * ks + hi;
        float a[8]; u32x4 cur = (u32x4){0u, 0u, 0u, 0u};
#pragma unroll
        for (int e = 0; e < 8; ++e) a[e] = 0.f;
        for (int i = 0; i < W; ++i) {
            const int ri = t + 15 - i;
            const u32x4 v = *(const MX_LAS u32x4*)(buf + ri * 512 + ((chunk ^ (ri & 15)) << 4));
            a[0] += bf_lo(v.x); a[1] += bf_hi(v.x); a[2] += bf_lo(v.y); a[3] += bf_hi(v.y); a[4] += bf_lo(v.z); a[5] += bf_hi(v.z); a[6] += bf_lo(v.w); a[7] += bf_hi(v.w);
            if (i == 0) cur = v;
        }
        u32x4 dw;
        dw.x = pk_bf16(a[0] * icnt - bf_lo(cur.x), a[1] * icnt - bf_hi(cur.x)); dw.y = pk_bf16(a[2] * icnt - bf_lo(cur.y), a[3] * icnt - bf_hi(cur.y));
        dw.z = pk_bf16(a[4] * icnt - bf_lo(cur.z), a[5] * icnt - bf_hi(cur.z)); dw.w = pk_bf16(a[6] * icnt - bf_lo(cur.w), a[7] * icnt - bf_hi(cur.w));
        df[ks] = __builtin_bit_cast(bf16x8, dw);
    }
    bf16_t* op = MIX + ((size_t)(u.row0 >> 8) * 16 + g) * (256 * 64);
#pragma unroll
    for (int eb = 0; eb < 2; ++eb) {
        f32x16 o;
#pragma unroll
        for (int r = 0; r < 16; ++r) o[r] = 0.f;
#pragma unroll
        for (int ks = 0; ks < 4; ++ks) o = __builtin_amdgcn_mfma_f32_32x32x16_bf16(wf[eb][ks], df[ks], o, 0, 0, 0);
#pragma unroll
        for (int rg = 0; rg < 4; ++rg) { u32x2 w; w.x = pk_bf16(o[4 * rg], o[4 * rg + 1]); w.y = pk_bf16(o[4 * rg + 2], o[4 * rg + 3]); *(u32x2*)(op + pg8::img_off((u.row0 & 255) + t, 32 * eb + 8 * rg + 4 * hi)) = w; }
    }
}

#define MX_SYNC() do { asm volatile("s_waitcnt vmcnt(0) lgkmcnt(0)" ::: "memory"); __builtin_amdgcn_s_barrier(); asm volatile("" ::: "memory"); } while (0)
__device__ __forceinline__ void mix_phase(lptr lds, const bf16_t* Z, const bf16_t* CK, const bf16_t* CV, const bf16_t* CP, const bf16_t* WPt, const bf16_t* ZERO, bf16_t* MIX, const float* sinks, int first, int stride) {
    const int tid = threadIdx.x, lane = tid & 63, wid = __builtin_amdgcn_readfirstlane(tid >> 6);
    constexpr int PBUF = 40960;
    constexpr int NRUN_P = 32 * 3 * 8, NRUN = NRUN_P + 32 * 3;
    int par = 0;
    if (first < NRUN) {
        const int g = wid >> 1;
        float sk0 = sinks[g] * LOG2E, sk1 = sinks[4 + g] * LOG2E, sk2 = sinks[8 + g] * LOG2E;
        asm volatile("" : "+v"(sk0), "+v"(sk1), "+v"(sk2));
        int run = first, st = 0, head = 0;
        auto unit_of = [](int run, int st) { AUnit u; u.samp = run >= NRUN_P; const int rr = u.samp ? run : NRUN_P - 1 - run;     const int a = u.samp ? run - NRUN_P : rr >> 3; u.b = a / 3; u.kvh = a % 3; u.c = u.samp ? 0 : 4 * (rr & 7) + st;
                                              u.row0 = u.samp ? MP + u.b * 64 : u.b * 2048 + 64 * u.c; return u; };
        bf16x8 qn[4];
        AUnit u = unit_of(run, 0);
        int s0 = 0, s1 = 1, s2 = 2; head = 3;
        attn_issue_chunk(lds, 0, 0, Z, CK, CV, u, wid, lane); attn_issue_chunk(lds, 1, 1, Z, CK, CV, u, wid, lane); attn_issue_chunk(lds, 2, 2, Z, CK, CV, u, wid, lane);
        attn_qload(qn, Z, u, wid, lane);
        for (;;) {
            MX_SYNC();
            bf16x8 qr[4];
#pragma unroll
            for (int ks = 0; ks < 4; ++ks) qr[ks] = qn[ks];
            asm volatile("" : "+v"(qr[0]), "+v"(qr[1]), "+v"(qr[2]), "+v"(qr[3]));
            int nrun = run, nst = st + 1; const int len = (run >= NRUN_P) ? 1 : 4;
            if (nst == len) { nrun = run + stride; nst = 0; }
            const bool more = nrun < NRUN;
            int n0 = s1, n1 = s2, n2 = head;
            AUnit un = u;
            if (more) {
                un = unit_of(nrun, nst);
                if (nst == 0) { n0 = head; n1 = head + 1 >= 6 ? head - 5 : head + 1; n2 = head + 2 >= 6 ? head - 4 : head + 2;
                    attn_issue_chunk(lds, n0, 0, Z, CK, CV, un, wid, lane); attn_issue_chunk(lds, n1, 1, Z, CK, CV, un, wid, lane); attn_issue_chunk(lds, n2, 2, Z, CK, CV, un, wid, lane);
                    head = head + 3 >= 6 ? head - 3 : head + 3; }
                else { attn_issue_chunk(lds, n2, 2, Z, CK, CV, un, wid, lane); head = head + 1 >= 6 ? 0 : head + 1; }
                attn_qload(qn, Z, un, wid, lane);
            }
            attn_compute(lds, s0, s1, s2, qr, MIX, u.kvh == 0 ? sk0 : (u.kvh == 1 ? sk1 : sk2), u, wid, lane);
            if (!more) break;
            run = nrun; st = nst; u = un; s0 = n0; s1 = n1; s2 = n2;
        }
    }
    MX_SYNC();
    int pj = first >= 96 ? first - 96 : first + stride - 96; par = 0;
    if (pj < N_POOL_P + 32) {
        bf16x8 wf[2][4];
#pragma unroll
        for (int eb = 0; eb < 2; ++eb)
#pragma unroll
            for (int ks = 0; ks < 4; ++ks) wf[eb][ks] = *(const bf16x8*)(WPt + (size_t)(((wid >> 1) * 64 + 32 * eb + (lane & 31)) * 64 + 16 * ks + 8 * (lane >> 5)));
        pool_issue(lds, Z, CP, ZERO, pool_decode(pj), wid, lane);
        for (; pj < N_POOL_P + 32; pj += stride, par ^= 1) {
            const AUnit u = pool_decode(pj);
            MX_SYNC();
            if (pj + stride < N_POOL_P + 32) pool_issue(lds + (par ^ 1) * PBUF, Z, CP, ZERO, pool_decode(pj + stride), wid, lane);
            pool_compute(lds + par * PBUF, wf, MIX, u, wid, lane);
        }
    }
    MX_SYNC();
}
#undef MX_SYNC
#undef MX_GLDS
#undef MX_LAS
}
constexpr int NWAVES = 8;
#ifndef MK_N_LAUNCHES
#define MK_N_LAUNCHES 1
#endif
constexpr int N_LAUNCHES = MK_N_LAUNCHES;
constexpr int PER_PHASE = 6;
#ifndef MK_P5_LAG
#define MK_P5_LAG 900
#endif
constexpr int P5_LAG = MK_P5_LAG;

constexpr size_t MiB = 1u << 20;
constexpr size_t WS_CTL = 0, CTL_ZERO_BYTES = 64 * 1024, WS_ZERO = 512 * 1024, WS_SS = 1 * MiB;
constexpr size_t WS_WIN = 2 * MiB, WS_WOUT = 5 * MiB, WS_WGU = 7 * MiB, WS_WD = 18 * MiB;
constexpr size_t WS_WP = 24 * MiB, WS_CK = 25 * MiB, WS_CV = 27 * MiB, WS_CP = 29 * MiB;
constexpr size_t WS_RX = 30 * MiB;
constexpr size_t WS_XB = 32 * MiB;
constexpr size_t WS_Z = 164 * MiB;
constexpr size_t WS_MIX = 346 * MiB;
constexpr size_t WS_ACT = 478 * MiB;
constexpr size_t WS_HB = 842 * MiB;
constexpr size_t WS_END = 974 * MiB;
static_assert(WS_SS + (size_t)67584 * 4 <= WS_WIN && WS_WD + (size_t)1024 * 2816 * 2 <= WS_WP && WS_XB + (size_t)67584 * 1024 * 2 <= WS_Z && WS_Z + (size_t)67584 * 1408 * 2 <= WS_MIX &&
              WS_MIX + (size_t)67584 * 1024 * 2 <= WS_ACT && WS_ACT + (size_t)67584 * 2816 * 2 <= WS_HB && WS_HB + (size_t)67584 * 1024 * 2 <= WS_END && WS_RX + (size_t)67584 * 4 <= WS_XB, "d_ws map");
constexpr int CW_TMO = 0, CW_CODE = 1;
constexpr int CW_EARLY = 64;
constexpr int CW_BAR = 4096;
constexpr int RING_OFF = 0, RING_BYTES = 131072;
constexpr int LDSCTL_OFF = RING_BYTES, MISC_OFF = LDSCTL_OFF + 320;
constexpr int STAGE_OFF = LDSCTL_OFF + 1024;
constexpr int JUNK_OFF = STAGE_OFF + 16384;
constexpr int LDS_BYTES = STAGE_OFF + 16384;
static_assert(MISC_OFF + 128 <= LDS_BYTES, "LDS map");

#define GAS __attribute__((address_space(1)))
#define LAS __attribute__((address_space(3)))
typedef unsigned short bf16;
typedef unsigned v4u __attribute__((ext_vector_type(4)));
typedef float f32x4 __attribute__((ext_vector_type(4)));
typedef short bf16x8 __attribute__((ext_vector_type(8)));
typedef GAS unsigned gu32;
typedef GAS unsigned long long gu64;
#define RLX_AGENT __ATOMIC_RELAXED, __HIP_MEMORY_SCOPE_AGENT
#define LDS_WAIT() asm volatile("s_waitcnt lgkmcnt(0)" ::: "memory")
#define VM_WAIT() asm volatile("s_waitcnt vmcnt(0)" ::: "memory")
__device__ __forceinline__ unsigned long long rt() { return __builtin_amdgcn_s_memrealtime(); }
__device__ __forceinline__ unsigned f2bf(float f) { unsigned u = __builtin_bit_cast(unsigned, f); return (u + 0x7fffu + ((u >> 16) & 1u)) >> 16; }
__device__ __forceinline__ unsigned pk2(float lo, float hi) { return f2bf(lo) | (f2bf(hi) << 16); }

#define XB_TMO      128
#define XB_XCNT(j)  (256  + 64 * (j))
#define XB_XSUB(j)  (1280 + 64 * (j))
#define XB_XGEN(j)  (2304 + 64 * (j))
#define XB_TOP      3328
#define XB_TOPGEN   3392
#define XCD_BAR_WORDS 3456
#define XB_SPIN_CAP (1u << 18)

__device__ __forceinline__ unsigned xb_ld(unsigned* p)              { return __hip_atomic_load(p, __ATOMIC_RELAXED, __HIP_MEMORY_SCOPE_AGENT); }
__device__ __forceinline__ unsigned xb_add(unsigned* p, unsigned v) { return __hip_atomic_fetch_add(p, v, __ATOMIC_RELAXED, __HIP_MEMORY_SCOPE_AGENT); }
__device__ __forceinline__ unsigned xb_xcc_id() { return (unsigned)__builtin_amdgcn_s_getreg((3 << 11) | 20) & 0xFu; }
#define XB_SPIN(cond, bar) do { unsigned _sp = 0; while (cond) { __builtin_amdgcn_s_sleep(1); \
    if ((++_sp & 255u) == 0u) { if (xb_ld(&(bar)[XB_TMO])) break; if (_sp > XB_SPIN_CAP) { atomicAdd(&(bar)[XB_TMO], 1u); break; } } } } while (0)

struct XcdBarrier {
    unsigned* bar; unsigned x;
    volatile LAS unsigned* st;
};

__device__ __forceinline__ XcdBarrier xcd_barrier_post(unsigned* bar, volatile LAS unsigned* st) {
    XcdBarrier b; b.bar = bar; b.x = xb_xcc_id(); b.st = st;
    if (threadIdx.x == 0) (void)xb_add(&bar[XB_XCNT(b.x)], 1u);
    return b;
}
__device__ __forceinline__ void xcd_barrier_complete(unsigned* bar, unsigned x, unsigned& nloc, unsigned& nx) {
    const unsigned G = gridDim.x * gridDim.y * gridDim.z;
    unsigned sum, cnt, mine, sp = 0u;
    for (;;) {
        sum = 0u; cnt = 0u; mine = 0u;
#pragma unroll
        for (unsigned j = 0; j < 16; ++j) { const unsigned c = xb_ld(&bar[XB_XCNT(j)]); sum += c; cnt += (c > 0u) ? 1u : 0u; mine = (j == x) ? c : mine; }
        if (sum == G) break;
        __builtin_amdgcn_s_sleep(1);
        if ((++sp & 255u) == 0u) { if (xb_ld(&bar[XB_TMO])) break; if (sp > XB_SPIN_CAP) { atomicAdd(&bar[XB_TMO], 1u); break; } }
    }
    nloc = mine > 0u ? mine : 1u; nx = cnt > 0u ? cnt : 1u;
}

__device__ __forceinline__ void xcd_barrier(const XcdBarrier& b) {
    asm volatile("s_waitcnt vmcnt(0)" ::: "memory");
    __syncthreads();
    if (threadIdx.x == 0) {
        unsigned* bar = b.bar;
        __builtin_amdgcn_s_waitcnt(0);
        unsigned nloc = b.st[0], nx = b.st[1];
        if (nloc == 0u) { xcd_barrier_complete(bar, b.x, nloc, nx); b.st[0] = nloc; b.st[1] = nx; }
        const unsigned old = xb_add(&bar[XB_XSUB(b.x)], 1u);
        const unsigned gen = old / nloc;
        if (old + 1u == (gen + 1u) * nloc) {
            __builtin_amdgcn_fence(__ATOMIC_RELEASE, "agent");
            asm volatile("s_waitcnt vmcnt(0)" ::: "memory");
            const unsigned og = xb_add(&bar[XB_TOP], 1u);
            const unsigned tg = og / nx;
            if (og + 1u == (tg + 1u) * nx) xb_add(&bar[XB_TOPGEN], 1u);
            else XB_SPIN(xb_ld(&bar[XB_TOPGEN]) == tg, bar);
            __builtin_amdgcn_fence(__ATOMIC_ACQUIRE, "agent");
            xb_add(&bar[XB_XGEN(b.x)], 1u);
            asm volatile("s_waitcnt vmcnt(0)" ::: "memory");
        } else {
            XB_SPIN(xb_ld(&bar[XB_XGEN(b.x)]) == gen, bar);
            __builtin_amdgcn_fence(__ATOMIC_ACQUIRE, "agent");
            asm volatile("s_waitcnt vmcnt(0)" ::: "memory");
        }
    }
    __syncthreads();
}
struct Frame {
    LAS unsigned char* lds;
    volatile LAS unsigned* MISC;
    gu32* ctl;
    int tid, lane, wave;
    int vcu, G;
};

__device__ __forceinline__ float wave_sum(float v) {
#pragma unroll
    for (int o = 1; o < 64; o <<= 1) v += __shfl_xor(v, o);
    return v;
}
__device__ __forceinline__ int p0_drow(int mode, int n0) {
    if (mode == 1) { const int lc = n0 & 255, dd = lc & 63; return n0 >= 1280 ? n0 : (n0 & ~255) + 128 * (dd >> 5) + 32 * (lc >> 6); }
    if (mode == 2) return 256 * (n0 >> 7) + (n0 & 127);
    if (mode == 3) return 256 * (n0 >> 7) + 128 + (n0 & 127);
    return n0;
}
__device__ __forceinline__ void p0_transpose_item(const float* W, const float* gain, int K, int N, bf16* WT, int kt, int b, int n0, int mode, LAS float* scr, int lane) {
    const int k0 = 64 * kt + 32 * b;
    const GAS f32x4* src = (const GAS f32x4*)(W + (size_t)(k0 + (lane >> 5)) * N + n0) + (lane & 31);
    f32x4 v[16];
#pragma unroll
    for (int i = 0; i < 16; ++i) v[i] = __builtin_nontemporal_load(src + (size_t)(2 * i) * (N >> 2));
    const int pb = lane * 16, ob = pb ^ (((pb >> 9) & 1) << 5), rr = ob >> 6, cc = (ob & 63) >> 1;
    f32x4 g0 = (f32x4){1.f, 1.f, 1.f, 1.f}, g1 = g0;
    if (gain) { g0 = *(const GAS f32x4*)(gain + k0 + cc); g1 = *(const GAS f32x4*)(gain + k0 + cc + 4); }
#pragma unroll
    for (int i = 0; i < 16; ++i) *(LAS f32x4*)(scr + (2 * i + (lane >> 5)) * 128 + 4 * (lane & 31)) = v[i];
    LDS_WAIT(); asm volatile("" ::: "memory");
#pragma unroll
    for (int g = 0; g < 4; ++g) {
        const int drow0 = p0_drow(mode, n0 + 32 * g);
        GAS unsigned char* base = (GAS unsigned char*)WT + ((size_t)((drow0 >> 8) * (K >> 6) + kt) * 2 + ((drow0 >> 7) & 1)) * pg8::HTB + (size_t)(((drow0 & 127) >> 4) * 2 + b) * 1024 + pb;
#pragma unroll
        for (int a = 0; a < 2; ++a) { const LAS float* t = scr + cc * 128 + 32 * g + pg8::perm32(16 * a + rr);
            v4u o; o.x = pk2(t[0 * 128] * g0.x, t[1 * 128] * g0.y); o.y = pk2(t[2 * 128] * g0.z, t[3 * 128] * g0.w); o.z = pk2(t[4 * 128] * g1.x, t[5 * 128] * g1.y); o.w = pk2(t[6 * 128] * g1.z, t[7 * 128] * g1.w);
            *(GAS v4u*)(base + a * 2048) = o; }
    }
    LDS_WAIT(); asm volatile("" ::: "memory");
}
__device__ __forceinline__ void x_rows2_to_bf16(const float* xa, const float* xb, bf16* oa, bf16* ob, float* ra, float* rb, int lane) {
    const GAS f32x4* pa = (const GAS f32x4*)xa + lane; const GAS f32x4* pb = (const GAS f32x4*)xb + lane;
    f32x4 va[4], vb[4]; float sa = 0.f, sb = 0.f;
#pragma unroll
    for (int j = 0; j < 4; ++j) { va[j] = __builtin_nontemporal_load(pa + 64 * j); vb[j] = __builtin_nontemporal_load(pb + 64 * j); }
#pragma unroll
    for (int j = 0; j < 4; ++j) { sa += (va[j].x * va[j].x + va[j].y * va[j].y) + (va[j].z * va[j].z + va[j].w * va[j].w); sb += (vb[j].x * vb[j].x + vb[j].y * vb[j].y) + (vb[j].z * vb[j].z + vb[j].w * vb[j].w); }
    GAS unsigned long long* qa = (GAS unsigned long long*)oa + lane; GAS unsigned long long* qb = (GAS unsigned long long*)ob + lane;
#pragma unroll
    for (int j = 0; j < 4; ++j) { qa[64 * j] = (unsigned long long)pk2(va[j].x, va[j].y) | ((unsigned long long)pk2(va[j].z, va[j].w) << 32);
                                  qb[64 * j] = (unsigned long long)pk2(vb[j].x, vb[j].y) | ((unsigned long long)pk2(vb[j].z, vb[j].w) << 32); }
    const float r1 = 1.f / sqrtf(wave_sum(sa) * (1.f / 1024.f) + 1e-6f), r2 = 1.f / sqrtf(wave_sum(sb) * (1.f / 1024.f) + 1e-6f);
    if (lane == 0) { *ra = r1; *rb = r2; }
}
struct P0Args { const float *xp, *xs, *cpool, *ck, *cv, *norm_mix, *w_in, *w_pool, *pool_scale, *w_out, *norm_ffn, *w_gate, *w_up, *w_down; float* out;
                bf16 *Win_t, *Wout_t, *Wgu_t, *Wd_t, *WPt, *CK, *CV, *CP, *XB; float* RX; float* SS; float* ZERO; };
__device__ __forceinline__ void p0_prologue(Frame& F, const P0Args& A) {
    LAS float* scr = (LAS float*)(F.lds + RING_OFF + F.wave * 16384);
    const int gw = F.vcu * NWAVES + F.wave, NGW = F.G * NWAVES;
    constexpr int I_IN = 32 * 11, I_OUT = 32 * 8, I_G = 32 * 22, I_D = 88 * 8, NITEMS = I_IN + I_OUT + 2 * I_G + I_D;
    for (int it = gw; it < NITEMS; it += NGW) {
        int r = it;
        if (r < I_IN) { const int kh = r / 11, nb = r % 11; p0_transpose_item(A.w_in, A.norm_mix, 1024, 1408, A.Win_t, kh >> 1, kh & 1, 128 * nb, 1, scr, F.lane); continue; } r -= I_IN;
        if (r < I_OUT) { const int kh = r / 8, nb = r % 8; p0_transpose_item(A.w_out, nullptr, 1024, 1024, A.Wout_t, kh >> 1, kh & 1, 128 * nb, 0, scr, F.lane); continue; } r -= I_OUT;
        if (r < I_G) { const int kh = r / 22, nb = r % 22; p0_transpose_item(A.w_gate, A.norm_ffn, 1024, 2816, A.Wgu_t, kh >> 1, kh & 1, 128 * nb, 2, scr, F.lane); continue; } r -= I_G;
        if (r < I_G) { const int kh = r / 22, nb = r % 22; p0_transpose_item(A.w_up, A.norm_ffn, 1024, 2816, A.Wgu_t, kh >> 1, kh & 1, 128 * nb, 3, scr, F.lane); continue; } r -= I_G;
        { const int kh = r / 8, nb = r % 8; p0_transpose_item(A.w_down, nullptr, 2816, 1024, A.Wd_t, kh >> 1, kh & 1, 128 * nb, 0, scr, F.lane); }
    }
    __syncthreads();
    {
        constexpr int RS = 2112, NG = pg8::MT / 16;
        LAS unsigned char* stg = F.lds + RING_OFF;
        f32x4 va[4], vb[4];
        int grp = F.vcu;
        auto issue = [&](int g) { const int r = 16 * g + 2 * F.wave; const float* xa = r < pg8::MP ? A.xp + (size_t)r * 1024 : A.xs + (size_t)(r - pg8::MP) * 1024;
            const GAS f32x4* pa = (const GAS f32x4*)xa + F.lane;
#pragma unroll
            for (int j = 0; j < 4; ++j) { va[j] = __builtin_nontemporal_load(pa + 64 * j); vb[j] = __builtin_nontemporal_load(pa + 256 + 64 * j); } };
        if (grp < NG) issue(grp);
        for (; grp < NG; grp += F.G) {
            const int r = 16 * grp + 2 * F.wave;
            float sa = 0.f, sb = 0.f;
#pragma unroll
            for (int j = 0; j < 4; ++j) { sa += (va[j].x * va[j].x + va[j].y * va[j].y) + (va[j].z * va[j].z + va[j].w * va[j].w); sb += (vb[j].x * vb[j].x + vb[j].y * vb[j].y) + (vb[j].z * vb[j].z + vb[j].w * vb[j].w); }
            LAS unsigned long long* la = (LAS unsigned long long*)(stg + (2 * F.wave) * RS) + F.lane; LAS unsigned long long* lb = (LAS unsigned long long*)(stg + (2 * F.wave + 1) * RS) + F.lane;
#pragma unroll
            for (int j = 0; j < 4; ++j) { la[64 * j] = (unsigned long long)pk2(va[j].x, va[j].y) | ((unsigned long long)pk2(va[j].z, va[j].w) << 32);
                                          lb[64 * j] = (unsigned long long)pk2(vb[j].x, vb[j].y) | ((unsigned long long)pk2(vb[j].z, vb[j].w) << 32); }
            if (grp + F.G < NG) issue(grp + F.G);
            const float r1 = 1.f / sqrtf(wave_sum(sa) * (1.f / 1024.f) + 1e-6f), r2 = 1.f / sqrtf(wave_sum(sb) * (1.f / 1024.f) + 1e-6f);
            if (F.lane == 0) { A.RX[r] = r1; A.RX[r + 1] = r2; }
            __syncthreads();
            GAS unsigned char* blk = (GAS unsigned char*)A.XB + ((size_t)(grp >> 4) * 16 * 2 + ((grp >> 3) & 1)) * pg8::HTB + (size_t)(grp & 7) * 2048;
            const int pb = F.lane * 16, ob = pb ^ (((pb >> 9) & 1) << 5), rr = ob >> 6, cc = (ob & 63) >> 1;
#pragma unroll
            for (int q = 0; q < 4; ++q) { const int st = F.wave + 8 * q, kt = st >> 1, ch = st & 1;
                const v4u val = *(const LAS v4u*)(stg + rr * RS + (kt * 64 + ch * 32 + cc) * 2);
                *(GAS v4u*)(blk + (size_t)kt * (2 * pg8::HTB) + ch * 1024 + pb) = val; }
            __syncthreads();
        }
    }
    const int gt = gw * 64 + F.lane, NGT = NGW * 64;
    for (int i = gt; i < 4 * 64 * 64; i += NGT) { const int g = i >> 12, e = (i >> 6) & 63, c = i & 63;
        A.WPt[i] = (bf16)f2bf(A.w_pool[(g * 64 + c) * 64 + e] * A.pool_scale[64 * g + e]); }
    for (int i = gt; i < 32 * 128 * 192 / 4; i += NGT) {
        const f32x4 k4 = ((const GAS f32x4*)A.ck)[i], v4 = ((const GAS f32x4*)A.cv)[i];
        ((GAS unsigned long long*)A.CK)[i] = (unsigned long long)pk2(k4.x, k4.y) | ((unsigned long long)pk2(k4.z, k4.w) << 32);
        ((GAS unsigned long long*)A.CV)[i] = (unsigned long long)pk2(v4.x, v4.y) | ((unsigned long long)pk2(v4.z, v4.w) << 32);
        const int b = i / (128 * 48), rr = (i / 48) & 127, q = i % 48;
        if (rr >= 64) { const size_t o = ((size_t)(b * 128 + rr - 64) * 192) / 4 + q; ((GAS f32x4*)(A.out + pg8::O_K_S))[o] = k4; ((GAS f32x4*)(A.out + pg8::O_V_S))[o] = v4; }
    }
    for (int i = gt; i < 67584 / 4; i += NGT) ((GAS f32x4*)A.SS)[i] = (f32x4){0.f, 0.f, 0.f, 0.f};
    if (gt < 64) ((GAS f32x4*)A.ZERO)[gt] = (f32x4){0.f, 0.f, 0.f, 0.f};
    for (int i = gt; i < 32 * 15 * 256 / 4; i += NGT) { const f32x4 p4 = ((const GAS f32x4*)A.cpool)[i]; ((GAS unsigned long long*)A.CP)[i] = (unsigned long long)pk2(p4.x, p4.y) | ((unsigned long long)pk2(p4.z, p4.w) << 32); }
}

struct Args { const float* in[17]; float* out; unsigned char* ws; int ph_lo, ph_hi, li, pad; };
__global__ void __launch_bounds__(NWAVES * 64, 2) mk_fwd(Args args) {
    extern __shared__ __attribute__((aligned(16))) unsigned char lds[];
    Frame F;
    F.lds = (LAS unsigned char*)lds;
    F.MISC = (volatile LAS unsigned*)(F.lds + MISC_OFF);
    F.tid = threadIdx.x; F.lane = F.tid & 63; F.wave = __builtin_amdgcn_readfirstlane(F.tid >> 6);
    F.G = gridDim.x; { const int bx = blockIdx.x; F.vcu = (F.G % 8 == 0) ? (bx % 8) * (F.G / 8) + bx / 8 : bx; }
#define GRID_BAR(seam) do { if (N_LAUNCHES == PER_PHASE) { if (F.tid == 0) __hip_atomic_store(F.ctl + CW_TMO, 0xBADBA0u | (unsigned)(seam), RLX_AGENT); } \
    else { xcd_barrier(bar); } } while (0)
    unsigned char* ws = args.ws;
    F.ctl = (gu32*)(ws + WS_CTL);
    float* const out = args.out;
    bf16* const Win_t = (bf16*)(ws + WS_WIN); bf16* const Wout_t = (bf16*)(ws + WS_WOUT); bf16* const Wgu_t = (bf16*)(ws + WS_WGU); bf16* const Wd_t = (bf16*)(ws + WS_WD);
    bf16* const WPt = (bf16*)(ws + WS_WP); bf16* const CKb = (bf16*)(ws + WS_CK); bf16* const CVb = (bf16*)(ws + WS_CV); bf16* const CPb = (bf16*)(ws + WS_CP);
    bf16* const XB = (bf16*)(ws + WS_XB); bf16* const HB = (bf16*)(ws + WS_HB); bf16* const Z = (bf16*)(ws + WS_Z); bf16* const MIX = (bf16*)(ws + WS_MIX); bf16* const ACT = (bf16*)(ws + WS_ACT);
    float* const SS = (float*)(ws + WS_SS); float* const RX = (float*)(ws + WS_RX);
    for (int u = F.tid; u < (LDS_BYTES - LDSCTL_OFF) / 4; u += NWAVES * 64) ((LAS unsigned*)(F.lds + LDSCTL_OFF))[u] = 0u;
    __syncthreads();
    const int bli = (N_LAUNCHES == PER_PHASE) ? 0 : args.li;
    XcdBarrier bar; bar.bar = (unsigned*)(F.ctl + CW_BAR) + bli * XCD_BAR_WORDS; bar.x = 0; bar.st = nullptr;
    if (N_LAUNCHES != PER_PHASE)
        bar = xcd_barrier_post((unsigned*)(F.ctl + CW_BAR) + bli * XCD_BAR_WORDS, F.MISC + 8);

    const int lo = args.ph_lo, hi = args.ph_hi;
    const bool early = (N_LAUNCHES == 1) && (F.G == 256);
#define IN(k) (lo <= (k) && (k) < hi)
#define BOTH(k) (IN(k) && IN((k) + 1))

    if (IN(0)) {
        P0Args A{args.in[0], args.in[1], args.in[2], args.in[3], args.in[4], args.in[5], args.in[6], args.in[7], args.in[8], args.in[12], args.in[13], args.in[14], args.in[15], args.in[16], out,
                 Win_t, Wout_t, Wgu_t, Wd_t, WPt, CKb, CVb, CPb, XB, RX, SS, (float*)(ws + WS_ZERO)};
        p0_prologue(F, A);
        if (BOTH(0)) GRID_BAR(0);
    }
    if (IN(1)) {
        pg8::Gemm g{XB, Win_t, pg8::MT, 1536, 1024};
        pg8::StaticOrder S; S.init(pg8::MT, 1280, F.G, (int)blockIdx.x);
        { pg8::BalancedFullOrder Sb; Sb.init(pg8::MT, 1280, F.G, (int)blockIdx.x); pg8::EpiZ E{Z, args.in[9], args.in[10], out, RX, F.lds + STAGE_OFF};
          pg8::gemm_phase<pg8::EpiZ, pg8::BalancedFullOrder, PG8_ALIGN, PG8_SP2>(F.lds + RING_OFF, g, Sb, E); }
        { pg8::BalancedHalfOrder T{5, 0, (int)blockIdx.x, F.G, S.nM, S.nwg % F.G}; pg8::EpiZv E{Z, out, RX, F.lds + STAGE_OFF};
          pg8::gemm_phase<pg8::EpiZv, pg8::BalancedHalfOrder, PG8_ALIGN, PG8_SP2, true>(F.lds + RING_OFF, g, T, E); }
        if (BOTH(1)) GRID_BAR(1);
    }
    if (IN(2)) {
        mixp::mix_phase(F.lds + RING_OFF, Z, CKb, CVb, CPb, WPt, (const bf16*)(ws + WS_ZERO), MIX, args.in[11], (int)blockIdx.x, F.G);
        if (BOTH(2)) GRID_BAR(2);
    }
    if (IN(3)) {
        pg8::Gemm g{MIX, Wout_t, pg8::MT, 1024, 1024}; pg8::StaticOrder S; S.init(pg8::MT, 1024, F.G, (int)blockIdx.x);
        const int full = (S.nwg / F.G) * F.G;
        { pg8::EarlyOrder Sa; Sa.init(pg8::MT, 1024, F.G, (int)blockIdx.x); Sa.hi = full; Sa.elo = 0; Sa.ehi = early ? 8 : 0; Sa.cnt = (unsigned*)(F.ctl + CW_EARLY); Sa.scan();
          pg8::EpiH<false> E{XB, HB, SS, Sa.ehi};
          pg8::gemm_phase<pg8::EpiH<false>, pg8::EarlyOrder, PG8_ALIGN, PG8_SP2>(F.lds + RING_OFF, g, Sa, E); }
        { pg8::TailHalfOrder T{S, full, (int)blockIdx.x}; pg8::EpiH<true> E{XB, HB, SS, 0};
          pg8::gemm_phase<pg8::EpiH<true>, pg8::TailHalfOrder, PG8_ALIGN, PG8_SP2, true>(F.lds + RING_OFF, g, T, E); }
        if (early && IN(4)) {
            const int j = (int)blockIdx.x - 2 * (S.nwg - full), x = j & 7, k = j >> 3;
            pg8::OneUnitOrder T{2 * (x & 3) + (k & 1), 11 * (x >> 2) + (k >> 1), (j >= 0 && k < 22) ? 1 : 0};
            if (T.valid) {
                if (F.tid == 0) {
                    XB_SPIN(xb_ld((unsigned*)(F.ctl + CW_EARLY)) < 256u, bar.bar);
                    __builtin_amdgcn_fence(__ATOMIC_ACQUIRE, "agent"); asm volatile("s_waitcnt vmcnt(0)" ::: "memory");
                }
                __syncthreads();
                pg8::Gemm g4{HB, Wgu_t, pg8::MT, 5632, 1024}; pg8::EpiAct E4{SS, ACT, F.lds + STAGE_OFF};
                pg8::gemm_phase<pg8::EpiAct, pg8::OneUnitOrder, PG8_ALIGN, PG8_SP2>(F.lds + RING_OFF, g4, T, E4);
            }
        }
        if (BOTH(3)) GRID_BAR(3);
    }
    if (IN(4)) {
        pg8::Gemm g{HB, Wgu_t, pg8::MT, 5632, 1024}; pg8::StaticOrder S; S.init(early && IN(3) ? 65536 : pg8::MT, 5632, F.G, (int)blockIdx.x); S.pm0 = early && IN(3) ? 8 : 0;
        S.rev = 1;
        pg8::EpiAct E{SS, ACT, F.lds + STAGE_OFF};
        pg8::gemm_phase<pg8::EpiAct, pg8::StaticOrder, PG8_ALIGN, PG8_SP2>(F.lds + RING_OFF, g, S, E);
        if (BOTH(4)) GRID_BAR(4);
    }
    if (IN(5)) {
        pg8::Gemm g{ACT, Wd_t, pg8::MT, 1024, 2816}; pg8::StaticOrder S; S.init(pg8::MT, 1024, F.G, (int)blockIdx.x);
        const int full = (S.nwg / F.G) * F.G;
        { pg8::StaticOrder Sa = S; Sa.hi = full; pg8::EpiY<false> E{HB, out, F.lds + STAGE_OFF};
          pg8::gemm_phase<pg8::EpiY<false>, pg8::StaticOrder, PG8_ALIGN, PG8_SP2>(F.lds + RING_OFF, g, Sa, E); }
        { pg8::TailHalfOrder T{S, full, (int)blockIdx.x}; pg8::EpiY<true> E{HB, out, F.lds + STAGE_OFF};
          pg8::gemm_phase<pg8::EpiY<true>, pg8::TailHalfOrder, PG8_ALIGN, PG8_SP2, true>(F.lds + RING_OFF, g, T, E); }
    }
#undef IN
#undef BOTH
}

extern "C" void kernel_launch(void* const* d_in, const int* in_sizes, int n_in, void* d_out, int out_size, void* d_ws, size_t ws_size, hipStream_t stream) {
    static int grid = 0;
    if (grid == 0) {
        if (n_in != 17 || in_sizes[0] != 65536 * 1024 || out_size != (int)pg8::O_END || ws_size < WS_END) { fprintf(stderr, "kernel_launch: shape mismatch: n_in %d, in0 %d, out %d, ws %zu (need >= %zu); nothing launched\n", n_in, n_in > 0 ? in_sizes[0] : -1, out_size, ws_size, (size_t)WS_END); grid = -1; return; }
        int dev = 0, cus = 0, per_cu = 0;
        if (hipGetDevice(&dev) != hipSuccess || hipDeviceGetAttribute(&cus, hipDeviceAttributeMultiprocessorCount, dev) != hipSuccess) { fprintf(stderr, "kernel_launch: hipGetDevice / hipDeviceGetAttribute failed; nothing launched\n"); grid = -1; return; }
        if (hipFuncSetAttribute((const void*)mk_fwd, hipFuncAttributeMaxDynamicSharedMemorySize, LDS_BYTES) != hipSuccess) { fprintf(stderr, "kernel_launch: hipFuncSetAttribute failed; nothing launched\n"); grid = -1; return; }
        if (hipOccupancyMaxActiveBlocksPerMultiprocessor(&per_cu, (const void*)mk_fwd, NWAVES * 64, LDS_BYTES) != hipSuccess || per_cu < 1)
            fprintf(stderr, "kernel_launch: note: the occupancy query reports %d workgroups per CU\n", per_cu);
        (void)hipGetLastError();
        grid = cus;
    }
    if (grid < 0) return;
    if (hipMemsetAsync((char*)d_ws + WS_CTL, 0, CTL_ZERO_BYTES, stream) != hipSuccess) { fprintf(stderr, "kernel_launch: hipMemsetAsync of the control words failed; nothing launched\n"); return; }
    Args a{};
    for (int i = 0; i < 17; ++i) a.in[i] = (const float*)d_in[i];
    a.out = (float*)d_out; a.ws = (unsigned char*)d_ws;
    static_assert(((N_LAUNCHES >= 1 && N_LAUNCHES <= 3) || N_LAUNCHES == PER_PHASE) && (CW_BAR + 3 * XCD_BAR_WORDS) * 4 <= (int)CTL_ZERO_BYTES, "-DMK_N_LAUNCHES must be 1, 2, 3 or 6");
    const int cuts3[4] = {0, N_LAUNCHES == 3 ? 1 : (N_LAUNCHES == 2 ? 4 : PER_PHASE), N_LAUNCHES == 3 ? 4 : PER_PHASE, PER_PHASE};
    for (int li = 0; li < N_LAUNCHES; ++li) {
        a.ph_lo = (N_LAUNCHES == PER_PHASE) ? li : cuts3[li]; a.ph_hi = (N_LAUNCHES == PER_PHASE) ? li + 1 : cuts3[li + 1]; a.li = li;
        hipLaunchKernelGGL(mk_fwd, dim3(grid), dim3(NWAVES * 64), LDS_BYTES, stream, a);
        const hipError_t le = hipPeekAtLastError();
        if (le != hipSuccess) { fprintf(stderr, "kernel_launch: launch %d failed: %s (grid %d x %d threads, %d B LDS)\n", li, hipGetErrorName(le), grid, NWAVES * 64, LDS_BYTES); break; }
    }
}
```
